# Optimizing an MI355X kernel written in HIP

```python
import jax, jax.numpy as jnp
from jax import lax
import numpy as np

D_MODEL = 2048
BATCH = 2
SEQ = 8192
DEPTH = 2

N_A_LAYERS = DEPTH // 2
N_B_LAYERS = DEPTH - N_A_LAYERS
N_DENSE = (DEPTH + 1) // 2
N_MOE = DEPTH // 2

HG_HEADS = 16
HG_KDIM = 128
HG_VDIM = D_MODEL // HG_HEADS
HG_FDIM = HG_HEADS * HG_KDIM
HG_CHUNK = 64

MLA_HEADS = 16
Q_LORA = 512
KV_LORA = 512
QK_NOPE = 128
QK_ROPE = 64
V_HEAD = 128
MLA_SCALE = (QK_NOPE + QK_ROPE) ** -0.5
ROPE_THETA = 10000.0
Q_BLOCK = 128

D_FF = 5632
N_EXPERTS = 8
TOP_K = 2
MOE_ROWS = 256

EPS = 1e-6

kernel_name = 'hybrid_hgrn2_mla_moe_yoco'


def rms_norm(x, g):
    xf = x.astype(jnp.float32)
    y = xf * lax.rsqrt(jnp.mean(xf * xf, axis=-1, keepdims=True) + EPS)
    return (y * g.astype(jnp.float32)).astype(x.dtype)


def modulation(sc, w, b, n):
    m = sc @ w + b
    return [t[:, None, :] for t in jnp.split(m, n, axis=-1)]


def rope_tables(positions):
    inv = 1.0 / (ROPE_THETA ** (jnp.arange(0, QK_ROPE, 2, dtype=jnp.float32) / QK_ROPE))
    ang = positions.astype(jnp.float32)[..., None] * inv
    return jnp.cos(ang), jnp.sin(ang)


def apply_rope(x, cos, sin):
    x1, x2 = jnp.split(x, 2, axis=-1)
    return jnp.concatenate([x1 * cos - x2 * sin, x2 * cos + x1 * sin], axis=-1).astype(x.dtype)


def hgrn2_mixer(u, w_in, lower_bound, out_norm_g, w_out):
    B, S, _ = u.shape
    n_chunks = S // HG_CHUNK
    proj = u @ w_in
    q, f_logit, i, g = jnp.split(proj, [HG_FDIM, 2 * HG_FDIM, 2 * HG_FDIM + D_MODEL], axis=-1)
    f = lower_bound + (1.0 - lower_bound) * jax.nn.sigmoid(f_logit.astype(jnp.float32))
    k = 1.0 - f
    log_f = jnp.log(f)

    def chunks(t, d):
        return t.astype(jnp.float32).reshape(B, n_chunks, HG_CHUNK, HG_HEADS, d).transpose(1, 0, 3, 2, 4)

    xs = (chunks(q, HG_KDIM), chunks(k, HG_KDIM), chunks(log_f, HG_KDIM), chunks(i, HG_VDIM))
    causal = jnp.tril(jnp.ones((HG_CHUNK, HG_CHUNK), dtype=bool))[:, :, None]

    def step(state, inp):
        qc, kc, lfc, vc = inp
        b = jnp.cumsum(lfc, axis=2)
        o_inter = jnp.einsum('bhtk,bhkv->bhtv', qc * jnp.exp(b), state)
        rel = b[:, :, :, None, :] - b[:, :, None, :, :]
        decay = jnp.exp(jnp.where(causal, rel, -jnp.inf))
        scores = jnp.einsum('bhtk,bhsk,bhtsk->bhts', qc, kc, decay)
        o_intra = jnp.einsum('bhts,bhsv->bhtv', scores, vc)
        b_last = b[:, :, -1:, :]
        state = (jnp.exp(b_last[:, :, 0, :])[..., None] * state
                 + jnp.einsum('bhsk,bhsv->bhkv', kc * jnp.exp(b_last - b), vc))
        return state, o_inter + o_intra

    s0 = jnp.zeros((B, HG_HEADS, HG_KDIM, HG_VDIM), jnp.float32)
    _, o = lax.scan(step, s0, xs)
    o = o.transpose(1, 0, 3, 2, 4).reshape(B, S, HG_HEADS * HG_VDIM).astype(u.dtype)
    o = rms_norm(o, out_norm_g) * jax.nn.silu(g)
    return o @ w_out


def mla_shared_kv(xs, w_kv_a, kv_norm_g, w_kv_b, cos, sin):
    B, S, _ = xs.shape
    c_kv, k_rope = jnp.split(xs @ w_kv_a, [KV_LORA], axis=-1)
    kv = (rms_norm(c_kv, kv_norm_g) @ w_kv_b).reshape(B, S, MLA_HEADS, QK_NOPE + V_HEAD)
    k_nope, v = jnp.split(kv, [QK_NOPE], axis=-1)
    k_rope = apply_rope(k_rope, cos, sin)
    return k_nope, k_rope, v


def mla_attention(u, k_nope, k_rope, v, w_q_a, q_norm_g, w_q_b, w_o, cos, sin):
    B, S, _ = u.shape
    q = (rms_norm(u @ w_q_a, q_norm_g) @ w_q_b).reshape(B, S, MLA_HEADS, QK_NOPE + QK_ROPE)
    q_nope, q_rope = jnp.split(q, [QK_NOPE], axis=-1)
    q_rope = apply_rope(q_rope, cos[:, :, None, :], sin[:, :, None, :])
    n_blk = S // Q_BLOCK

    def blocks(t):
        return t.reshape(B, n_blk, Q_BLOCK, *t.shape[2:]).swapaxes(0, 1)

    key_pos = jnp.arange(S)

    def attend(inp):
        qn, qr, blk = inp
        s = (jnp.einsum('bqhd,bkhd->bhqk', qn, k_nope)
             + jnp.einsum('bqhr,bkr->bhqk', qr, k_rope)).astype(jnp.float32) * MLA_SCALE
        q_pos = blk * Q_BLOCK + jnp.arange(Q_BLOCK)
        s = jnp.where(key_pos[None, :] <= q_pos[:, None], s, -jnp.inf)
        p = jax.nn.softmax(s, axis=-1).astype(v.dtype)
        return jnp.einsum('bhqk,bkhd->bqhd', p, v)

    o = lax.map(attend, (blocks(q_nope), blocks(q_rope), jnp.arange(n_blk)))
    o = o.swapaxes(0, 1).reshape(B, S, MLA_HEADS * V_HEAD)
    return o @ w_o


def swiglu(h, w_gu, w_down):
    gt, up = jnp.split(h @ w_gu, 2, axis=-1)
    return (jax.nn.silu(gt) * up) @ w_down


def moe_swiglu(h, w_router, w_gu, w_down):
    B, S, D = h.shape
    n_tok = B * S
    hf = h.reshape(n_tok, D)
    logits = (hf @ w_router).astype(jnp.float32)
    top_logit, top_idx = lax.top_k(logits, TOP_K)
    top_w = jax.nn.softmax(top_logit, axis=-1)
    n_asg = n_tok * TOP_K
    asg_e = top_idx.reshape(n_asg)
    asg_t = jnp.arange(n_asg, dtype=jnp.int32) // TOP_K
    asg_w = top_w.reshape(n_asg)
    order = jnp.argsort(asg_e)
    sorted_e = asg_e[order]
    counts = jnp.bincount(asg_e, length=N_EXPERTS)
    padded = (counts + MOE_ROWS - 1) // MOE_ROWS * MOE_ROWS
    start = jnp.cumsum(counts) - counts
    pend = jnp.cumsum(padded)
    pstart = pend - padded
    dest = pstart[sorted_e] + (jnp.arange(n_asg) - start[sorted_e])
    n_blocks = (n_asg + N_EXPERTS * (MOE_ROWS - 1)) // MOE_ROWS
    n_rows = n_blocks * MOE_ROWS
    row_tok = jnp.zeros((n_rows,), jnp.int32).at[dest].set(asg_t[order])
    row_w = jnp.zeros((n_rows,), jnp.float32).at[dest].set(asg_w[order])
    blk_e = jnp.minimum(jnp.searchsorted(pend, jnp.arange(n_blocks) * MOE_ROWS, side='right'),
                        N_EXPERTS - 1)

    def expert_block(inp):
        tok, e = inp
        return swiglu(hf[tok], w_gu[e], w_down[e])

    y = lax.map(expert_block, (row_tok.reshape(n_blocks, MOE_ROWS), blk_e))
    y = y.reshape(n_rows, D) * row_w[:, None].astype(h.dtype)
    out = jnp.zeros_like(hf).at[row_tok].add(y)
    return out.reshape(B, S, D)


def setup_inputs(seed: int = 0) -> dict:
    key = jax.random.key(seed)
    ks = jax.random.split(key, 26)
    f32 = jnp.float32
    D = D_MODEL

    def nrm(k, shape, fan_in, gain=1.0):
        return jax.random.normal(k, shape, f32) * (gain * fan_in ** -0.5)

    def gains(k, shape):
        return 1.0 + 0.02 * jax.random.normal(k, shape, f32)

    x = jax.random.normal(ks[0], (BATCH, SEQ, D), f32)
    c = jax.random.normal(ks[1], (BATCH, D), f32)
    positions = (jax.random.randint(ks[2], (BATCH, 1), 0, 1024)
                 + jnp.arange(SEQ)[None, :]).astype(jnp.int32)
    return {
        'x': x,
        'c': c,
        'positions': positions,
        'ada_w': nrm(ks[3], (DEPTH, 2, D, 3 * D), D, 0.5),
        'ada_b': 0.02 * jax.random.normal(ks[4], (DEPTH, 2, 3 * D), f32),
        'norm_g': gains(ks[5], (DEPTH, 2, 2, D)),
        'hg_w_in': nrm(ks[6], (N_A_LAYERS, D, 2 * HG_FDIM + 2 * D), D),
        'hg_lb_logits': 0.5 * jax.random.normal(ks[7], (N_A_LAYERS + 1, HG_FDIM), f32),
        'hg_out_norm_g': gains(ks[8], (N_A_LAYERS, D)),
        'hg_w_out': nrm(ks[9], (N_A_LAYERS, D, D), D),
        'kv_src_norm_g': gains(ks[10], (D,)),
        'kv_src_ada_w': nrm(ks[11], (D, 2 * D), D, 0.5),
        'kv_src_ada_b': 0.02 * jax.random.normal(ks[12], (2 * D,), f32),
        'mla_w_kv_a': nrm(ks[13], (D, KV_LORA + QK_ROPE), D),
        'mla_kv_norm_g': gains(ks[14], (KV_LORA,)),
        'mla_w_kv_b': nrm(ks[15], (KV_LORA, MLA_HEADS * (QK_NOPE + V_HEAD)), KV_LORA),
        'mla_w_q_a': nrm(ks[16], (N_B_LAYERS, D, Q_LORA), D),
        'mla_q_norm_g': gains(ks[17], (N_B_LAYERS, Q_LORA)),
        'mla_w_q_b': nrm(ks[18], (N_B_LAYERS, Q_LORA, MLA_HEADS * (QK_NOPE + QK_ROPE)), Q_LORA),
        'mla_w_o': nrm(ks[19], (N_B_LAYERS, MLA_HEADS * V_HEAD, D), MLA_HEADS * V_HEAD),
        'ffn_w_gu': nrm(ks[20], (N_DENSE, D, 2 * D_FF), D),
        'ffn_w_down': nrm(ks[21], (N_DENSE, D_FF, D), D_FF),
        'moe_w_router': nrm(ks[22], (N_MOE, D, N_EXPERTS), D),
        'moe_w_gu': nrm(ks[23], (N_MOE, N_EXPERTS, D, 2 * D_FF), D),
        'moe_w_down': nrm(ks[24], (N_MOE, N_EXPERTS, D_FF, D), D_FF),
    }


def reference(x, c, positions, ada_w, ada_b, norm_g, hg_w_in, hg_lb_logits, hg_out_norm_g,
              hg_w_out, kv_src_norm_g, kv_src_ada_w, kv_src_ada_b, mla_w_kv_a, mla_kv_norm_g,
              mla_w_kv_b, mla_w_q_a, mla_q_norm_g, mla_w_q_b, mla_w_o, ffn_w_gu, ffn_w_down,
              moe_w_router, moe_w_gu, moe_w_down):
    lb_all = jnp.cumsum(jax.nn.softmax(hg_lb_logits.astype(jnp.float32), axis=0), axis=0)
    cos, sin = rope_tables(positions)
    sc = jax.nn.silu(c)
    h = x
    k_nope = k_rope = v = None
    for layer in range(DEPTH):
        if layer == N_A_LAYERS:
            shift, scale = modulation(sc, kv_src_ada_w, kv_src_ada_b, 2)
            xs = rms_norm(h, kv_src_norm_g) * (1.0 + scale) + shift
            k_nope, k_rope, v = mla_shared_kv(xs, mla_w_kv_a, mla_kv_norm_g, mla_w_kv_b, cos, sin)

        shift, scale, gate = modulation(sc, ada_w[layer, 0], ada_b[layer, 0], 3)
        u = rms_norm(h, norm_g[layer, 0, 0]) * (1.0 + scale) + shift
        if layer < N_A_LAYERS:
            a = layer
            y = hgrn2_mixer(u, hg_w_in[a], lb_all[a], hg_out_norm_g[a], hg_w_out[a])
        else:
            bl = layer - N_A_LAYERS
            y = mla_attention(u, k_nope, k_rope, v, mla_w_q_a[bl], mla_q_norm_g[bl],
                              mla_w_q_b[bl], mla_w_o[bl], cos, sin)
        h = h + gate * rms_norm(y, norm_g[layer, 0, 1])

        shift, scale, gate = modulation(sc, ada_w[layer, 1], ada_b[layer, 1], 3)
        u = rms_norm(h, norm_g[layer, 1, 0]) * (1.0 + scale) + shift
        j = layer // 2
        if layer % 2 == 0:
            y = swiglu(u, ffn_w_gu[j], ffn_w_down[j])
        else:
            y = moe_swiglu(u, moe_w_router[j], moe_w_gu[j], moe_w_down[j])
        h = h + gate * rms_norm(y, norm_g[layer, 1, 1])
    return h
```

```cpp
#include <hip/hip_runtime.h>
#include <cstdio>
#include <cstdint>

#ifndef MK_N_LAUNCHES
#define MK_N_LAUNCHES 1
#endif

#define LAS __attribute__((address_space(3)))
#define GAS __attribute__((address_space(1)))
typedef unsigned short bf16_t;
typedef short bf16x8 __attribute__((ext_vector_type(8)));
typedef short s16x4 __attribute__((ext_vector_type(4)));
typedef float f32x4 __attribute__((ext_vector_type(4)));
typedef float f32x2 __attribute__((ext_vector_type(2)));
typedef float f32x16 __attribute__((ext_vector_type(16)));
typedef unsigned u32x4 __attribute__((ext_vector_type(4)));
typedef unsigned u32x2 __attribute__((ext_vector_type(2)));

constexpr int D = 2048, BATCH = 2, SEQ = 8192, M = BATCH * SEQ;
constexpr int HG_H = 16, HG_K = 128, HG_C = 64, NCH = SEQ / HG_C;
constexpr int MLA_H = 16, QLORA = 512, KVLORA = 512, NOPE = 128, ROPE = 64, VH = 128;
constexpr int DFF = 5632, NEXP = 8;
constexpr float EPS = 1e-6f;
constexpr float MLA_SCALE = 0.07216878364870322f;
constexpr int NMOD = 4 * 6144 + 4096;
constexpr int MOE_MAXT = 136;
constexpr int MOE_ROWS = MOE_MAXT * 256;

constexpr size_t MiB = 1ull << 20;
constexpr size_t WS_CTL = 0;
constexpr size_t CTL_BYTES = 1 * MiB;
constexpr size_t WS_MOD = 1 * MiB;
constexpr size_t WS_LB = WS_MOD + 256 * 1024;
constexpr size_t WS_COS = 2 * MiB;
constexpr size_t WS_SIN = 4 * MiB;
constexpr size_t WS_SSO = 6 * MiB;
constexpr size_t WS_SSC = 14 * MiB;
constexpr size_t WS_SSQ = 15 * MiB;
constexpr size_t WS_TOK = 16 * MiB;
constexpr size_t WS_LIST = 17 * MiB;
constexpr size_t WS_W = 18 * MiB;
constexpr size_t W_IN = WS_W;
constexpr size_t W_OUT = W_IN + (size_t)8192 * 2048 * 2;
constexpr size_t W_GU = W_OUT + (size_t)2048 * 2048 * 2;
constexpr size_t W_DN = W_GU + (size_t)11264 * 2048 * 2;
constexpr size_t W_LAT = W_DN + (size_t)2048 * 5632 * 2;
constexpr size_t W_KVQ = W_LAT + (size_t)1280 * 2048 * 2;
constexpr size_t W_O = W_KVQ + (size_t)7168 * 512 * 2;
constexpr size_t W_MGU = W_O + (size_t)2048 * 2048 * 2;
constexpr size_t W_MDN = W_MGU + (size_t)8 * 11264 * 2048 * 2;
constexpr size_t W_END = W_MDN + (size_t)8 * 2048 * 5632 * 2;
constexpr size_t WS_U = (W_END + MiB - 1) / MiB * MiB;
constexpr size_t WS_XS = WS_U + (size_t)M * D * 2;
constexpr size_t WS_Y = WS_XS + (size_t)M * D * 2;
constexpr size_t WS_XR = WS_Y + (size_t)M * D * 2;
constexpr size_t WS_BIG = WS_Y + (size_t)M * D * 4;
constexpr size_t B_Q = WS_BIG;
constexpr size_t B_LF = B_Q + (size_t)M * D * 2;
constexpr size_t B_VI = B_LF + (size_t)M * D * 4;
constexpr size_t B_GS = B_VI + (size_t)M * D * 2;
constexpr size_t B_QH = B_GS + (size_t)M * D * 2;
constexpr size_t B_KT = B_QH + (size_t)M * D * 2;
constexpr size_t B_VT = B_KT + (size_t)M * D * 2;
constexpr size_t B_DEC = B_VT + (size_t)M * D * 2;
constexpr size_t B_OI = B_DEC + (size_t)4096 * 128 * 4;
constexpr size_t B_OG = B_Q;
constexpr size_t B_HG_END = B_OI + (size_t)M * D * 4;
constexpr size_t B_ACT = WS_BIG;
constexpr size_t B_CKV = WS_BIG;
constexpr size_t B_QLAT = B_CKV + (size_t)M * 512 * 2;
constexpr size_t B_KR = B_QLAT + (size_t)M * 512 * 2;
constexpr size_t B_KN = B_KR + (size_t)M * 64 * 2;
constexpr size_t B_V = B_KN + (size_t)M * D * 2;
constexpr size_t B_QN = B_V + (size_t)M * D * 2;
constexpr size_t B_QR = B_QN + (size_t)M * D * 2;
constexpr size_t B_O = B_QR + (size_t)M * 1024 * 2;
constexpr size_t B_MLA_END = B_O + (size_t)M * D * 2;
constexpr size_t B_ACT2 = WS_BIG;
constexpr size_t B_Y2 = B_ACT2 + (size_t)MOE_ROWS * DFF * 2;
constexpr size_t B_MOE_END = B_Y2 + (size_t)MOE_ROWS * D * 4;
constexpr size_t WS_NEED = (B_HG_END > B_MOE_END ? (B_HG_END > B_MLA_END ? B_HG_END : B_MLA_END) : (B_MOE_END > B_MLA_END ? B_MOE_END : B_MLA_END));

constexpr int CW_BAR = 4096;
constexpr int CW_CNT = 16384;
constexpr int LDS_BYTES = 147456;
constexpr int MISC_OFF = 131072 + 8192;

typedef __bf16 bf16x2_t __attribute__((ext_vector_type(2)));
__device__ __forceinline__ unsigned cvt_pk_bf16(float lo, float hi) { const f32x2 v = {lo, hi}; return __builtin_bit_cast(unsigned, __builtin_convertvector(v, bf16x2_t)); }
__device__ __forceinline__ float bf2f(bf16_t v) { return __uint_as_float(((unsigned)v) << 16); }
__device__ __forceinline__ float bflo(unsigned w) { return __uint_as_float(w << 16); }
__device__ __forceinline__ float bfhi(unsigned w) { return __uint_as_float(w & 0xffff0000u); }
__device__ __forceinline__ bf16_t f2bf(float f) { return (bf16_t)(cvt_pk_bf16(f, 0.f) & 0xffffu); }
__device__ __forceinline__ float wave_sum(float v) {
#pragma unroll
    for (int o = 1; o < 64; o <<= 1) v += __shfl_xor(v, o);
    return v;
}
__device__ __forceinline__ float sigmoidf_(float x) { return __builtin_amdgcn_rcpf(1.0f + __builtin_amdgcn_exp2f(x * -1.4426950408889634f)); }
__device__ __forceinline__ float siluf_(float x) { return x * __builtin_amdgcn_rcpf(1.0f + __builtin_amdgcn_exp2f(x * -1.4426950408889634f)); }

#define XB_TMO      128
#define XB_XCNT(j)  (256  + 64 * (j))
#define XB_XSUB(j)  (1280 + 64 * (j))
#define XB_XGEN(j)  (2304 + 64 * (j))
#define XB_TOP      3328
#define XB_TOPGEN   3392
#define XCD_BAR_WORDS 3456
#define XB_SPIN_CAP (1u << 22)

__device__ __forceinline__ unsigned xb_ld(unsigned* p)              { return __hip_atomic_load(p, __ATOMIC_RELAXED, __HIP_MEMORY_SCOPE_AGENT); }
__device__ __forceinline__ unsigned xb_add(unsigned* p, unsigned v) { return __hip_atomic_fetch_add(p, v, __ATOMIC_RELAXED, __HIP_MEMORY_SCOPE_AGENT); }
__device__ __forceinline__ unsigned xb_xcc_id() { return (unsigned)__builtin_amdgcn_s_getreg((3 << 11) | 20) & 0xFu; }
#define XB_SPIN(cond, bar) do { unsigned _sp = 0; while (cond) { __builtin_amdgcn_s_sleep(1); \
    if ((++_sp & 255u) == 0u) { if (xb_ld(&(bar)[XB_TMO])) break; if (_sp > XB_SPIN_CAP) { atomicAdd(&(bar)[XB_TMO], 1u); break; } } } } while (0)

struct XcdBarrier { unsigned* bar; unsigned x; volatile LAS unsigned* st; };

__device__ __forceinline__ XcdBarrier xcd_barrier_post(unsigned* bar, volatile LAS unsigned* st) {
    XcdBarrier b; b.bar = bar; b.x = xb_xcc_id(); b.st = st;
    if (threadIdx.x == 0) (void)xb_add(&bar[XB_XCNT(b.x)], 1u);
    return b;
}
__device__ __forceinline__ void xcd_barrier_complete(unsigned* bar, unsigned x, unsigned& nloc, unsigned& nx) {
    const unsigned G = gridDim.x * gridDim.y * gridDim.z;
    unsigned sum, cnt, mine, sp = 0u;
    for (;;) {
        sum = 0u; cnt = 0u; mine = 0u;
#pragma unroll
        for (unsigned j = 0; j < 16; ++j) { const unsigned c = xb_ld(&bar[XB_XCNT(j)]); sum += c; cnt += (c > 0u) ? 1u : 0u; mine = (j == x) ? c : mine; }
        if (sum == G) break;
        __builtin_amdgcn_s_sleep(1);
        if ((++sp & 255u) == 0u) { if (xb_ld(&bar[XB_TMO])) break; if (sp > XB_SPIN_CAP) { atomicAdd(&bar[XB_TMO], 1u); break; } }
    }
    nloc = mine > 0u ? mine : 1u; nx = cnt > 0u ? cnt : 1u;
}
__device__ __forceinline__ void xcd_barrier(const XcdBarrier& b) {
    asm volatile("s_waitcnt vmcnt(0)" ::: "memory");
    __syncthreads();
    if (threadIdx.x == 0) {
        unsigned* bar = b.bar;
        __builtin_amdgcn_s_waitcnt(0);
        unsigned nloc = b.st[0], nx = b.st[1];
        if (nloc == 0u) { xcd_barrier_complete(bar, b.x, nloc, nx); b.st[0] = nloc; b.st[1] = nx; }
        const unsigned old = xb_add(&bar[XB_XSUB(b.x)], 1u);
        const unsigned gen = old / nloc;
        if (old + 1u == (gen + 1u) * nloc) {
            __builtin_amdgcn_fence(__ATOMIC_RELEASE, "agent");
            asm volatile("s_waitcnt vmcnt(0)" ::: "memory");
            const unsigned og = xb_add(&bar[XB_TOP], 1u);
            const unsigned tg = og / nx;
            if (og + 1u == (tg + 1u) * nx) xb_add(&bar[XB_TOPGEN], 1u);
            else XB_SPIN(xb_ld(&bar[XB_TOPGEN]) == tg, bar);
            __builtin_amdgcn_fence(__ATOMIC_ACQUIRE, "agent");
            xb_add(&bar[XB_XGEN(b.x)], 1u);
            asm volatile("s_waitcnt vmcnt(0)" ::: "memory");
        } else {
            XB_SPIN(xb_ld(&bar[XB_XGEN(b.x)]) == gen, bar);
            __builtin_amdgcn_fence(__ATOMIC_ACQUIRE, "agent");
            asm volatile("s_waitcnt vmcnt(0)" ::: "memory");
        }
    }
    __syncthreads();
}

namespace pg8 {
constexpr int BM = 256, BK = 64, HALF = 128, HTB = HALF * BK * 2, STAGE_BYTES = 8 * HTB, NXCD = 8, WGM = 8;
__device__ __forceinline__ int lds_byte(int r, int c) { const int st = (r >> 4) * 2 + (c >> 5), rr = r & 15, cc = c & 31, ob = rr * 64 + cc * 2; return st * 1024 + (ob ^ (((ob >> 9) & 1) << 5)); }
__device__ __forceinline__ void stage_rc(int b, int& R, int& C) { const int st = b / 1024, sb = b % 1024, swz = sb ^ (((sb >> 9) & 1) << 5); R = (st >> 1) * 16 + swz / 64; C = (st & 1) * 32 + (swz % 64) / 2; }
__device__ __forceinline__ int perm32(int rho) { const int n = rho >> 4, i = rho & 15; return 8 * (i >> 2) + 4 * n + (i & 3); }

struct Unit { const char* a; const char* b; int pm, pn, e, nv; };

__device__ __forceinline__ void tile_of(int L, int nM, int nN, int& pm, int& pn) {
    const int nwg = nM * nN; int wgid = L;
    { const int q = nwg / NXCD, r = nwg % NXCD, xcd = wgid % NXCD, off = wgid / NXCD; wgid = (xcd < r ? xcd * (q + 1) : r * (q + 1) + (xcd - r) * q) + off; }
    const int nig = WGM * nN, gid = wgid / nig, fm = gid * WGM, gsz = (nM - fm) < WGM ? (nM - fm) : WGM;
    pm = fm + ((wgid % nig) % gsz); pn = (wgid % nig) / gsz;
}
struct DualOrder {
    static constexpr bool GATHER = false;
    const char *A1, *B1, *A2, *B2; int nM, nN1, nN2, K, G, c; bool tmA = false;
    __device__ __forceinline__ bool next(int i, Unit& u) const {
        const int nN = nN1 + nN2; const long L = (long)i * G + c; if (L >= (long)nM * nN) return false;
        int pm, pn; tile_of((int)L, nM, nN, pm, pn);
        const size_t tstep = (size_t)BM * K * 2;
        if (pn < nN1) { u.e = 0; u.pn = pn; u.a = A1 + pm * tstep; u.b = B1 + pn * tstep; }
        else { u.e = 1; u.pn = pn - nN1; u.a = A2 + pm * tstep; u.b = B2 + (pn - nN1) * tstep; }
        u.pm = pm; u.nv = 256; return true;
    }
    __device__ __forceinline__ const int* rows(const Unit&) const { return nullptr; }
};
template <bool GATHER_> struct MoeOrder {
    static constexpr bool GATHER = GATHER_;
    static constexpr bool tmA = false;
    const char* A; const char* W; size_t wstride; const int* list; int nT, nN, rb  , G, c; int tstart[NEXP + 1]; int cnt[NEXP];
    __device__ __forceinline__ void init(const unsigned* ctl) {
        int t = 0;
#pragma unroll
        for (int e = 0; e < NEXP; ++e) { const int n = (int)ctl[CW_CNT + 64 * e]; cnt[e] = n; tstart[e] = t; t += (n + 255) >> 8; }
        tstart[NEXP] = t; nT = t;
    }
    __device__ __forceinline__ bool next(int i, Unit& u) const {
        const long L = (long)i * G + c; if (L >= (long)nT * nN) return false;
        int pm, pn; tile_of((int)L, nT, nN, pm, pn);
        int e = 0;
#pragma unroll
        for (int j = 1; j < NEXP; ++j) e += (pm >= tstart[j]) ? 1 : 0;
        int ce = 0, ts = 0;
#pragma unroll
        for (int j = 0; j < NEXP; ++j) { ce = (j == e) ? cnt[j] : ce; ts = (j == e) ? tstart[j] : ts; }
        u.e = e; u.pm = pm; u.pn = pn; const int left = ce - (pm - ts) * 256; u.nv = left < 256 ? left : 256;
        u.a = GATHER ? A : A + (size_t)pm * BM * rb; u.b = W + (size_t)e * wstride + (size_t)pn * BM * rb;
        return true;
    }
    __device__ __forceinline__ const int* rows(const Unit& u) const { int ts = 0;
#pragma unroll
        for (int j = 0; j < NEXP; ++j) ts = (j == u.e) ? tstart[j] : ts;
        return list + (size_t)u.e * M + (u.pm - ts) * 256; }
};

typedef int i32x4 __attribute__((ext_vector_type(4)));
typedef int i32x8 __attribute__((ext_vector_type(8)));
constexpr float W8_SCALE = 128.0f; constexpr int W8_EXP = 0x78787878, ONE_EXP = 0x7f7f7f7f;
template <class Epi, class Sched, bool FP8 = false>
__device__ __forceinline__ void gemm_phase(LAS unsigned char* lds, const int Kel, const Sched& S, const Epi& E) {
    const int K = FP8 ? Kel / 2 : Kel;
    const int tid = threadIdx.x, wid = __builtin_amdgcn_readfirstlane(tid >> 6), lane = tid & 63, wr = wid >> 2, wc = wid & 3, fr = lane & 15, fq = lane >> 4;
    const int nt = K / BK;
    unsigned vA[2][2], vB[2]; int Rr[2], Cc[2];
#pragma unroll
    for (int i = 0; i < 2; ++i) { int R, C; stage_rc(tid * 16 + i * 8192, R, C); Rr[i] = R; Cc[i] = C; const int Rb = Epi::PERM ? ((R & ~31) + perm32(R & 31)) : R;
        vB[i] = (unsigned)(Rb * K + C) * 2u; }
    const size_t kstep = (size_t)(BK * 2), kstepA = S.tmA ? (size_t)8192 : kstep;
    const size_t hstep = (size_t)HALF * K * 2;
    const unsigned ldsw = (unsigned)wid * 1024u;
    const int aoff = lds_byte(wr * 64 + fr, fq * 8), boff = lds_byte(wc * 32 + fr, fq * 8);
#define PG8_SA(b, h) (((b) * 2 + (h)) * HTB)
#define PG8_SB(b, h) ((4 + (b) * 2 + (h)) * HTB)
#define PG8_STAGE2(bufoff, gbase, v0, v1) do { \
        __builtin_amdgcn_global_load_lds((const unsigned*)((const char*)(gbase) + (v0)), (LAS unsigned*)(lds + (bufoff) + ldsw), 16, 0, 0); \
        __builtin_amdgcn_global_load_lds((const unsigned*)((const char*)(gbase) + (v1)), (LAS unsigned*)(lds + (bufoff) + ldsw + 8192), 16, 0, 0); } while (0)
#define PG8_STAGEB(bufoff, gbase) PG8_STAGE2(bufoff, gbase, vB[0], vB[1])
#define PG8_LD8(p) __builtin_shufflevector(*(const LAS i32x4*)(p), *(const LAS i32x4*)((p) + 1024), 0, 1, 2, 3, 4, 5, 6, 7)
#define PG8_LDA(dst, b, h) do { if constexpr (FP8) { _Pragma("unroll") for (int m = 0; m < 4; ++m) dst##8[m] = PG8_LD8(lds + PG8_SA(b, h) + aoff + m * 2048); } \
        else { _Pragma("unroll") for (int m = 0; m < 4; ++m) _Pragma("unroll") for (int k = 0; k < 2; ++k) dst[m][k] = *(const LAS bf16x8*)(lds + PG8_SA(b, h) + aoff + m * 2048 + k * 1024); } } while (0)
#define PG8_LDB(dst, b, h) do { if constexpr (FP8) { _Pragma("unroll") for (int n = 0; n < 2; ++n) dst##8[n] = PG8_LD8(lds + PG8_SB(b, h) + boff + n * 2048); } \
        else { _Pragma("unroll") for (int n = 0; n < 2; ++n) _Pragma("unroll") for (int k = 0; k < 2; ++k) dst[n][k] = *(const LAS bf16x8*)(lds + PG8_SB(b, h) + boff + n * 2048 + k * 1024); } } while (0)
#define PG8_MMA(ai, bj, At, Bt) do { __builtin_amdgcn_s_setprio(1); _Pragma("unroll") for (int m = 0; m < 4; ++m) _Pragma("unroll") for (int n = 0; n < 2; ++n) { \
        if constexpr (FP8) asm volatile("v_mfma_scale_f32_16x16x128_f8f6f4 %0, %1, %2, %0, %3, %4 op_sel_hi:[0,0,0]" : "+v"(acc[ai][bj][m][n]) : "v"(Bt##8[n]), "v"(At##8[m]), "v"(sc_w8), "v"(sc_one)); \
        else { _Pragma("unroll") for (int k = 0; k < 2; ++k) acc[ai][bj][m][n] = __builtin_amdgcn_mfma_f32_16x16x32_bf16(Bt[n][k], At[m][k], acc[ai][bj][m][n], 0, 0, 0); } } \
        __builtin_amdgcn_s_setprio(0); } while (0)
#define PG8_WAIT_V(n) asm volatile("s_waitcnt vmcnt(" #n ")" ::: "memory")
#define PG8_WAIT_L(n) asm volatile("s_waitcnt lgkmcnt(" #n ")" ::: "memory")
#define PG8_BAR __builtin_amdgcn_s_barrier()
#define PG8_SCHED __builtin_amdgcn_sched_barrier(0)
    Unit cur, nxt; int ui = 0;
    if (!S.next(0, cur)) return;
    if constexpr (Sched::GATHER) { const int* rl = S.rows(cur);
#pragma unroll
        for (int h = 0; h < 2; ++h)
#pragma unroll
            for (int i = 0; i < 2; ++i) { const int j = Rr[i] + 128 * h; const int tok = (j < cur.nv) ? rl[j] : 0; vA[h][i] = (unsigned)(tok * K + Cc[i]) * 2u; } }
    else {
#pragma unroll
        for (int h = 0; h < 2; ++h)
#pragma unroll
            for (int i = 0; i < 2; ++i) { const int row = Rr[i] + 128 * h; vA[h][i] = S.tmA ? (unsigned)((row >> 6) * 262144 + (Cc[i] >> 4) * 2048 + (row & 63) * 32 + (Cc[i] & 15) * 2) : (unsigned)(row * K + Cc[i]) * 2u; } }
    LAS unsigned char* idx_lds = lds + STAGE_BYTES + wid * 1024;
    f32x4 acc[2][2][4][2];
#pragma unroll
    for (int a = 0; a < 2; ++a)
#pragma unroll
        for (int b = 0; b < 2; ++b)
#pragma unroll
            for (int m = 0; m < 4; ++m)
#pragma unroll
                for (int n = 0; n < 2; ++n) acc[a][b][m][n] = (f32x4){0.f, 0.f, 0.f, 0.f};
    bf16x8 At[4][2], B0[2][2], B1[2][2]; i32x8 At8[4], B08[2], B18[2];
    int sc_w8 = W8_EXP, sc_one = ONE_EXP; asm volatile("" : "+v"(sc_w8), "+v"(sc_one));
    const char* cA = cur.a; const char* cB = cur.b;
    PG8_STAGEB(PG8_SB(0, 0), cB); PG8_STAGEB(PG8_SB(0, 1), cB + hstep); PG8_STAGE2(PG8_SA(0, 0), cA, vA[0][0], vA[0][1]); PG8_STAGE2(PG8_SA(0, 1), cA, vA[1][0], vA[1][1]);
    if (wr == 1) PG8_BAR;
    PG8_WAIT_V(2); PG8_BAR;
    PG8_STAGEB(PG8_SB(1, 0), cB + kstep); PG8_STAGE2(PG8_SA(1, 0), cA + kstepA, vA[0][0], vA[0][1]); PG8_STAGEB(PG8_SB(1, 1), cB + hstep + kstep);
    PG8_WAIT_V(6); PG8_BAR;
    for (;;) {
        const bool has_next = S.next(ui + 1, nxt);
        const char* nA = has_next ? nxt.a : cA; const char* nB = has_next ? nxt.b : cB;
        for (int t = 0; t < nt; t += 2) {
            const bool last = (t == nt - 2);
            if constexpr (Sched::GATHER) { if (t == nt - 6 && has_next) { const int* rl = S.rows(nxt);
#pragma unroll
                for (int h = 0; h < 2; ++h)
#pragma unroll
                    for (int i = 0; i < 2; ++i) __builtin_amdgcn_global_load_lds((const unsigned*)(rl + Rr[i] + 128 * h), (LAS unsigned*)(idx_lds + (h * 2 + i) * 256), 4, 0, 0); } }
            const char* a1 = cA + (size_t)(t + 1) * kstepA;
            const char* a2 = last ? nA : cA + (size_t)(t + 2) * kstepA; const char* b2 = last ? nB : cB + (size_t)(t + 2) * kstep;
            const char* a3 = a2 + kstepA; const char* b3 = b2 + kstep;
            PG8_LDB(B0, 0, 0); PG8_LDB(B1, 0, 1); PG8_SCHED; PG8_LDA(At, 0, 0); PG8_STAGE2(PG8_SA(1, 1), a1, vA[1][0], vA[1][1]);
            if constexpr (Sched::GATHER) { if (last && has_next) {
#pragma unroll
                for (int h = 0; h < 2; ++h)
#pragma unroll
                    for (int i = 0; i < 2; ++i) { const int j = Rr[i] + 128 * h; const int tok = *(const LAS int*)(idx_lds + (h * 2 + i) * 256 + lane * 4); vA[h][i] = (unsigned)(((j < nxt.nv) ? tok : 0) * K + Cc[i]) * 2u; } } }
            PG8_WAIT_V(8); PG8_WAIT_L(0); PG8_BAR; PG8_MMA(0, 0, At, B0); PG8_MMA(0, 1, At, B1); PG8_BAR; PG8_SCHED;
            PG8_LDA(At, 0, 1); PG8_STAGEB(PG8_SB(0, 0), b2); PG8_STAGEB(PG8_SB(0, 1), b2 + hstep); PG8_STAGE2(PG8_SA(0, 0), a2, vA[0][0], vA[0][1]);
            PG8_WAIT_V(8); PG8_WAIT_L(0); PG8_BAR; PG8_MMA(1, 0, At, B0); PG8_MMA(1, 1, At, B1); PG8_BAR; PG8_SCHED;
            PG8_LDB(B0, 1, 0); PG8_LDB(B1, 1, 1); PG8_SCHED; PG8_LDA(At, 1, 0); PG8_STAGE2(PG8_SA(0, 1), a2, vA[1][0], vA[1][1]);
            PG8_WAIT_V(8); PG8_WAIT_L(0); PG8_BAR; PG8_MMA(0, 0, At, B0); PG8_MMA(0, 1, At, B1); PG8_BAR; PG8_SCHED;
            PG8_LDA(At, 1, 1); PG8_STAGEB(PG8_SB(1, 0), b3); PG8_STAGEB(PG8_SB(1, 1), b3 + hstep); PG8_STAGE2(PG8_SA(1, 0), a3, vA[0][0], vA[0][1]);
            PG8_WAIT_V(8); PG8_WAIT_L(0); PG8_BAR; PG8_MMA(1, 0, At, B0); PG8_MMA(1, 1, At, B1); PG8_BAR; PG8_SCHED;
        }
        if (wr == 0) PG8_BAR;
        if constexpr (FP8) asm volatile("s_nop 15\n\ts_nop 15" ::: "memory");
        E(acc, cur, wr, wc, fr, fq);
        if (!has_next) break;
#pragma unroll
        for (int a = 0; a < 2; ++a)
#pragma unroll
            for (int b = 0; b < 2; ++b)
#pragma unroll
                for (int m = 0; m < 4; ++m)
#pragma unroll
                    for (int n = 0; n < 2; ++n) acc[a][b][m][n] = (f32x4){0.f, 0.f, 0.f, 0.f};
        cur = nxt; cA = nA; cB = nB; ++ui;
        if (wr == 1) PG8_BAR;
    }
    PG8_WAIT_V(0);
    PG8_BAR;
#undef PG8_SA
#undef PG8_SB
#undef PG8_STAGE2
#undef PG8_STAGEB
#undef PG8_LDA
#undef PG8_LD8
#undef PG8_LDB
#undef PG8_MMA
#undef PG8_WAIT_V
#undef PG8_WAIT_L
#undef PG8_BAR
#undef PG8_SCHED
}
}
using pg8::Unit;

__device__ __forceinline__ size_t tm_off(int m, int ch) { return ((((size_t)(m >> 6) * 128 + (ch >> 4)) * 64 + (m & 63)) * 16 + (ch & 15)); }
typedef f32x4 Acc[2][2][4][2];
__device__ __forceinline__ u32x4 pack8(f32x4 a, f32x4 b) { return (u32x4){cvt_pk_bf16(a[0], a[1]), cvt_pk_bf16(a[2], a[3]), cvt_pk_bf16(b[0], b[1]), cvt_pk_bf16(b[2], b[3])}; }

__device__ __forceinline__ u32x2 pack8_fp8(f32x4 a, f32x4 b) { int w0 = 0, w1 = 0;
    w0 = __builtin_amdgcn_cvt_pk_fp8_f32(a[0], a[1], w0, false); w0 = __builtin_amdgcn_cvt_pk_fp8_f32(a[2], a[3], w0, true);
    w1 = __builtin_amdgcn_cvt_pk_fp8_f32(b[0], b[1], w1, false); w1 = __builtin_amdgcn_cvt_pk_fp8_f32(b[2], b[3], w1, true); return (u32x2){(unsigned)w0, (unsigned)w1}; }
struct EpiHgIn {
    static constexpr bool PERM = true;
    bf16_t* Q; float* LF; bf16_t* VI; bf16_t* GS; const float* lb; const float* gn;
    __device__ __forceinline__ void operator()(const Acc& acc, const Unit& u, int wr, int wc, int fr, int fq) const {
        const int type = u.pn >> 3, row0 = u.pm * 256 + wr * 64 + fr, col0 = (u.pn & 7) * 256 + wc * 32 + 8 * fq;
        if (type == 0 || type == 2) { bf16_t* O = type == 0 ? Q : VI;
#pragma unroll
            for (int ai = 0; ai < 2; ++ai)
#pragma unroll
                for (int m = 0; m < 4; ++m) { bf16_t* rowp = O + (size_t)(row0 + ai * 128 + m * 16) * D + col0;
#pragma unroll
                    for (int bj = 0; bj < 2; ++bj) *(u32x4*)(rowp + bj * 128) = pack8(acc[ai][bj][m][0], acc[ai][bj][m][1]); }
        } else if (type == 1) {
#pragma unroll
            for (int bj = 0; bj < 2; ++bj) { const f32x4 l0 = *(const f32x4*)(lb + col0 + bj * 128), l1 = *(const f32x4*)(lb + col0 + bj * 128 + 4);
#pragma unroll
                for (int ai = 0; ai < 2; ++ai)
#pragma unroll
                    for (int m = 0; m < 4; ++m) { _Float16* rowp = (_Float16*)LF + (size_t)(row0 + ai * 128 + m * 16) * D + col0 + bj * 128; f32x4 o0, o1;
#pragma unroll
                        for (int j = 0; j < 4; ++j) { o0[j] = __builtin_amdgcn_logf(1.f - (1.f - l0[j]) * sigmoidf_(-acc[ai][bj][m][0][j])) * 0.6931471805599453f; o1[j] = __builtin_amdgcn_logf(1.f - (1.f - l1[j]) * sigmoidf_(-acc[ai][bj][m][1][j])) * 0.6931471805599453f; }
                        typedef _Float16 h8 __attribute__((ext_vector_type(8)));
                        *(h8*)rowp = (h8){(_Float16)o0[0], (_Float16)o0[1], (_Float16)o0[2], (_Float16)o0[3], (_Float16)o1[0], (_Float16)o1[1], (_Float16)o1[2], (_Float16)o1[3]}; } }
        } else {
#pragma unroll
            for (int bj = 0; bj < 2; ++bj) { const f32x4 g0 = *(const f32x4*)(gn + col0 + bj * 128), g1 = *(const f32x4*)(gn + col0 + bj * 128 + 4);
#pragma unroll
                for (int ai = 0; ai < 2; ++ai)
#pragma unroll
                    for (int m = 0; m < 4; ++m) { bf16_t* rowp = GS + tm_off(row0 + ai * 128 + m * 16, col0 + bj * 128); f32x4 o0, o1;
#pragma unroll
                        for (int j = 0; j < 4; ++j) { o0[j] = siluf_(acc[ai][bj][m][0][j]) * g0[j]; o1[j] = siluf_(acc[ai][bj][m][1][j]) * g1[j]; }
                        *(u32x4*)rowp = pack8(o0, o1); } }
        }
    }
};
struct EpiNull {
    static constexpr bool PERM = false;
    __device__ __forceinline__ void operator()(const Acc& acc, const Unit& u, int wr, int wc, int fr, int fq) const {
#pragma unroll
        for (int ai = 0; ai < 2; ++ai)
#pragma unroll
            for (int bj = 0; bj < 2; ++bj)
#pragma unroll
                for (int m = 0; m < 4; ++m)
#pragma unroll
                    for (int n = 0; n < 2; ++n) asm volatile("" :: "v"(acc[ai][bj][m][n]));
    }
};
struct EpiF32 {
    static constexpr bool PERM = false;
    float* C; int ldc;
    __device__ __forceinline__ void operator()(const Acc& acc, const Unit& u, int wr, int wc, int fr, int fq) const {
        const int row0 = u.pm * 256 + wr * 64 + fr, col0 = u.pn * 256 + wc * 32 + 4 * fq;
#pragma unroll
        for (int ai = 0; ai < 2; ++ai)
#pragma unroll
            for (int m = 0; m < 4; ++m) { float* rowp = C + (size_t)(row0 + ai * 128 + m * 16) * ldc + col0;
#pragma unroll
                for (int bj = 0; bj < 2; ++bj)
#pragma unroll
                    for (int n = 0; n < 2; ++n) *(f32x4*)(rowp + bj * 128 + n * 16) = acc[ai][bj][m][n]; }
    }
};
struct EpiBf16 {
    static constexpr bool PERM = true;
    bf16_t* C; int ldc;
    __device__ __forceinline__ void operator()(const Acc& acc, const Unit& u, int wr, int wc, int fr, int fq) const {
        const int row0 = u.pm * 256 + wr * 64 + fr, col0 = u.pn * 256 + wc * 32 + 8 * fq;
#pragma unroll
        for (int ai = 0; ai < 2; ++ai)
#pragma unroll
            for (int m = 0; m < 4; ++m) { bf16_t* rowp = C + (size_t)(row0 + ai * 128 + m * 16) * ldc + col0;
#pragma unroll
                for (int bj = 0; bj < 2; ++bj) *(u32x4*)(rowp + bj * 128) = pack8(acc[ai][bj][m][0], acc[ai][bj][m][1]); }
    }
};
struct EpiGU {
    static constexpr bool PERM = true;
    bf16_t* ACT;
    __device__ __forceinline__ void operator()(const Acc& acc, const Unit& u, int wr, int wc, int fr, int fq) const {
        const int row0 = u.pm * 256 + wr * 64 + fr, col0 = u.pn * 128 + wc * 32 + 8 * fq;
#pragma unroll
        for (int ai = 0; ai < 2; ++ai)
#pragma unroll
            for (int m = 0; m < 4; ++m) { f32x4 o0, o1;
#pragma unroll
                for (int j = 0; j < 4; ++j) { o0[j] = siluf_(acc[ai][0][m][0][j]) * acc[ai][1][m][0][j]; o1[j] = siluf_(acc[ai][0][m][1][j]) * acc[ai][1][m][1][j]; }
                *(u32x4*)(ACT + (size_t)(row0 + ai * 128 + m * 16) * DFF + col0) = pack8(o0, o1); }
    }
};
struct EpiGU8 {
    static constexpr bool PERM = true;
    unsigned char* ACT;
    __device__ __forceinline__ void operator()(const Acc& acc, const Unit& u, int wr, int wc, int fr, int fq) const {
        const int row0 = u.pm * 256 + wr * 64 + fr, col0 = u.pn * 128 + wc * 32 + 8 * fq;
#pragma unroll
        for (int ai = 0; ai < 2; ++ai)
#pragma unroll
            for (int m = 0; m < 4; ++m) { f32x4 o0, o1;
#pragma unroll
                for (int j = 0; j < 4; ++j) { o0[j] = __builtin_amdgcn_fmed3f(siluf_(acc[ai][0][m][0][j]) * acc[ai][1][m][0][j], -448.f, 448.f); o1[j] = __builtin_amdgcn_fmed3f(siluf_(acc[ai][0][m][1][j]) * acc[ai][1][m][1][j], -448.f, 448.f); }
                *(u32x2*)(ACT + (size_t)(row0 + ai * 128 + m * 16) * DFF + col0) = pack8_fp8(o0, o1); }
    }
};
struct EpiLat {
    static constexpr bool PERM = true;
    bf16_t* CKV; bf16_t* QLAT; bf16_t* KR; float* SSC; float* SSQ; const float* COS; const float* SIN;
    __device__ __forceinline__ void operator()(const Acc& acc, const Unit& u, int wr, int wc, int fr, int fq) const {
        const int row0 = u.pm * 256 + wr * 64 + fr;
        if (u.e == 0 && u.pn == 2) {
            if (wc < 2) { const int j = 16 * wc + 4 * fq;
#pragma unroll
                for (int ai = 0; ai < 2; ++ai)
#pragma unroll
                    for (int m = 0; m < 4; ++m) { const int r = row0 + ai * 128 + m * 16; const f32x4 c = *(const f32x4*)(COS + (size_t)r * 32 + j), s = *(const f32x4*)(SIN + (size_t)r * 32 + j);
                        const f32x4 x1 = acc[ai][0][m][0], x2 = acc[ai][0][m][1]; const f32x4 o1 = x1 * c - x2 * s, o2 = x2 * c + x1 * s;
                        *(u32x2*)(KR + (size_t)r * 64 + j) = (u32x2){cvt_pk_bf16(o1[0], o1[1]), cvt_pk_bf16(o1[2], o1[3])};
                        *(u32x2*)(KR + (size_t)r * 64 + 32 + j) = (u32x2){cvt_pk_bf16(o2[0], o2[1]), cvt_pk_bf16(o2[2], o2[3])}; } }
            return;
        }
        bf16_t* O = u.e == 0 ? CKV : QLAT; float* SS = u.e == 0 ? SSC : SSQ;
        const int col0 = u.pn * 256 + wc * 32 + 8 * fq;
#pragma unroll
        for (int ai = 0; ai < 2; ++ai)
#pragma unroll
            for (int m = 0; m < 4; ++m) { const int r = row0 + ai * 128 + m * 16; float s = 0.f;
#pragma unroll
                for (int bj = 0; bj < 2; ++bj) { const f32x4 a = acc[ai][bj][m][0], b = acc[ai][bj][m][1];
                    s += (a[0] * a[0] + a[1] * a[1]) + (a[2] * a[2] + a[3] * a[3]) + (b[0] * b[0] + b[1] * b[1]) + (b[2] * b[2] + b[3] * b[3]);
                    *(u32x4*)(O + (size_t)r * 512 + col0 + bj * 128) = pack8(a, b); }
                s += __shfl_xor(s, 16); s += __shfl_xor(s, 32);
                if (fq == 0) SS[(size_t)r * 8 + u.pn * 4 + wc] = s; }
    }
};
struct EpiKvQ {
    static constexpr bool PERM = true;
    bf16_t* KN; bf16_t* V; bf16_t* QN; bf16_t* QR; const float* SSC; const float* SSQ; const float* COS; const float* SIN;
    __device__ __forceinline__ void operator()(const Acc& acc, const Unit& u, int wr, int wc, int fr, int fq) const {
        const int row0 = u.pm * 256 + wr * 64 + fr; const float* SS = u.e == 0 ? SSC : SSQ;
#pragma unroll
        for (int ai = 0; ai < 2; ++ai)
#pragma unroll
            for (int m = 0; m < 4; ++m) { const int r = row0 + ai * 128 + m * 16, b = r >> 13, s = r & (SEQ - 1);
                const f32x4 p0 = *(const f32x4*)(SS + (size_t)r * 8), p1 = *(const f32x4*)(SS + (size_t)r * 8 + 4);
                const float rstd = rsqrtf(((p0[0] + p0[1]) + (p0[2] + p0[3]) + (p1[0] + p1[1]) + (p1[2] + p1[3])) * (1.0f / 512.0f) + EPS);
                if (u.e == 0) { const size_t o = ((size_t)(b * MLA_H + u.pn) * SEQ + s) * 128 + wc * 32 + 8 * fq;
                    *(u32x4*)(KN + o) = pack8(acc[ai][0][m][0] * rstd, acc[ai][0][m][1] * rstd); *(u32x4*)(V + o) = pack8(acc[ai][1][m][0] * rstd, acc[ai][1][m][1] * rstd); }
                else if (u.pn < 8) {
#pragma unroll
                    for (int bj = 0; bj < 2; ++bj) { const size_t o = ((size_t)(b * MLA_H + 2 * u.pn + bj) * SEQ + s) * 128 + wc * 32 + 8 * fq;
                        *(u32x4*)(QN + o) = pack8(acc[ai][bj][m][0] * rstd, acc[ai][bj][m][1] * rstd); } }
                else { const int j = 16 * (wc & 1) + 4 * fq; const f32x4 c = *(const f32x4*)(COS + (size_t)r * 32 + j), sn = *(const f32x4*)(SIN + (size_t)r * 32 + j);
#pragma unroll
                    for (int bj = 0; bj < 2; ++bj) { const int head = 4 * (u.pn - 8) + 2 * bj + (wc >> 1); const size_t o = ((size_t)(b * MLA_H + head) * SEQ + s) * 64 + j;
                        const f32x4 x1 = acc[ai][bj][m][0] * rstd, x2 = acc[ai][bj][m][1] * rstd; const f32x4 o1 = x1 * c - x2 * sn, o2 = x2 * c + x1 * sn;
                        *(u32x2*)(QR + o) = (u32x2){cvt_pk_bf16(o1[0], o1[1]), cvt_pk_bf16(o1[2], o1[3])};
                        *(u32x2*)(QR + o + 32) = (u32x2){cvt_pk_bf16(o2[0], o2[1]), cvt_pk_bf16(o2[2], o2[3])}; } }
            }
    }
};

struct Args { const void* in[25]; float* out; unsigned char* ws; int ph_lo, ph_hi; };
enum { I_X = 0, I_C, I_POS, I_ADAW, I_ADAB, I_NORMG, I_HGWIN, I_HGLB, I_HGONG, I_HGWOUT, I_KVNG, I_KVADAW, I_KVADAB, I_WKVA, I_KVNORMG, I_WKVB, I_WQA, I_QNORMG, I_WQB, I_WO,
       I_FGU, I_FDN, I_ROUTER, I_MGU, I_MDN };
struct Frame { LAS unsigned char* lds; int tid, lane, wave, G, bid; const Args* a; unsigned char* ws; unsigned* ctl; bool probe_rep; };
#define INF(k) ((const float*)F.a->in[k])

__device__ __forceinline__ const float* modp(const Frame& F, int which, int part, int b) { return (const float*)(F.ws + WS_MOD) + (size_t)b * NMOD + (which < 4 ? which * 6144 : 24576) + part * 2048; }
__device__ __forceinline__ const float* normg(const Frame& F, int layer, int sub, int which) { return INF(I_NORMG) + ((layer * 2 + sub) * 2 + which) * 2048; }

__device__ __forceinline__ void p_mod(const Frame& F) {
    LAS float* scv = (LAS float*)F.lds;
    LAS float* red = (LAS float*)(F.lds + 16384);
    for (int it = F.bid; it < 224; it += F.G) {
        __syncthreads();
        for (int i = F.tid; i < 2 * D; i += 512) scv[i] = siluf_(INF(I_C)[i]);
        __syncthreads();
        const float* W; const float* bias; int N, col0, obase;
        if (it < 192) { const int mi = it / 48; W = INF(I_ADAW) + (size_t)mi * D * 6144; bias = INF(I_ADAB) + mi * 6144; N = 6144; col0 = (it % 48) * 128; obase = mi * 6144; }
        else { W = INF(I_KVADAW); bias = INF(I_KVADAB); N = 4096; col0 = (it - 192) * 128; obase = 24576; }
        const int half = F.lane >> 5, cq = F.lane & 31;
        const float* wp = W + (size_t)(256 * F.wave + half) * N + col0 + 4 * cq;
        f32x4 a0 = {0.f, 0.f, 0.f, 0.f}, a1 = a0;
#pragma unroll 16
        for (int i = 0; i < 128; ++i) { const f32x4 v = *(const f32x4*)(wp + (size_t)(2 * i) * N); const int k = 256 * F.wave + 2 * i + half; a0 += v * scv[k]; a1 += v * scv[D + k]; }
        const int slot = F.wave * 2 + half;
        *(LAS f32x4*)(red + (slot * 2 + 0) * 128 + 4 * cq) = a0; *(LAS f32x4*)(red + (slot * 2 + 1) * 128 + 4 * cq) = a1;
        __syncthreads();
        if (F.tid < 256) { const int b = F.tid >> 7, col = F.tid & 127; float s = bias[col0 + col];
#pragma unroll
            for (int p = 0; p < 16; ++p) s += red[(p * 2 + b) * 128 + col];
            ((float*)(F.ws + WS_MOD))[(size_t)b * NMOD + obase + col0 + col] = s; }
    }
    const int gtid = F.bid * 512 + F.tid, gn = F.G * 512;
    for (int i = gtid; i < D; i += gn) { const float l0 = INF(I_HGLB)[i], l1 = INF(I_HGLB)[D + i]; ((float*)(F.ws + WS_LB))[i] = 1.0f / (1.0f + expf(l1 - l0)); }
    for (int p = gtid; p < M * 32; p += gn) { const int m = p >> 5, j = p & 31; const float pos = (float)((const int*)F.a->in[I_POS])[m];
        const float inv = 1.0f / powf(10000.0f, (float)(2 * j) / 64.0f); const float ang = pos * inv; float s_, c_; sincosf(ang, &s_, &c_);
        ((float*)(F.ws + WS_COS))[p] = c_; ((float*)(F.ws + WS_SIN))[p] = s_; }
}

__device__ __forceinline__ int rope_dest(int p) { return 32 * ((p >> 4) & 1) + 8 * ((p >> 2) & 3) + 4 * (p >> 5) + (p & 3); }
__device__ __forceinline__ int dest_row(int kind, int c) {
    if (kind == 0) return c;
    if (kind == 1) { const int b = c >= DFF ? 1 : 0, j = c - b * DFF; return (j >> 7) * 256 + b * 128 + (j & 127); }
    if (kind == 2) return c < 512 ? c : 512 + rope_dest(c - 512);
    const int h = c / 192, j = c - h * 192; return j < 128 ? h * 128 + j : 2048 + h * 64 + rope_dest(j - 128);
}
__device__ __forceinline__ void conv_item(const float* W, int K, int N, bf16_t* WT, int kind, const float* gsc, LAS float* scr, int item, int lane) {
    const int nblk = N / 32, kb = item / nblk, nb = item % nblk, k0 = 64 * kb, n0 = 32 * nb;
#pragma unroll 8
    for (int i = 0; i < 32; ++i) { const int kk = 2 * i + (lane >> 5); float v = W[(size_t)(k0 + kk) * N + n0 + (lane & 31)]; if (gsc) v *= gsc[k0 + kk]; scr[kk * 33 + (lane & 31)] = v; }
    asm volatile("s_waitcnt lgkmcnt(0)" ::: "memory");
    const int c = lane & 7;
#pragma unroll
    for (int j = 0; j < 4; ++j) { const int n = (lane >> 3) + 8 * j; const LAS float* s = scr + (8 * c) * 33 + n;
        u32x4 o; o.x = cvt_pk_bf16(s[0 * 33], s[1 * 33]); o.y = cvt_pk_bf16(s[2 * 33], s[3 * 33]); o.z = cvt_pk_bf16(s[4 * 33], s[5 * 33]); o.w = cvt_pk_bf16(s[6 * 33], s[7 * 33]);
        *(u32x4*)(WT + (size_t)dest_row(kind, n0 + n) * K + k0 + 8 * c) = o; }
    asm volatile("s_waitcnt lgkmcnt(0)" ::: "memory");
}
__device__ __forceinline__ void conv_item8(const float* W, int K, int N, unsigned char* WT, int kind, LAS float* scr, int item, int lane) {
    const int nblk = N / 32, kb = item / nblk, nb = item % nblk, k0 = 64 * kb, n0 = 32 * nb;
#pragma unroll 8
    for (int i = 0; i < 32; ++i) { const int kk = 2 * i + (lane >> 5); scr[kk * 33 + (lane & 31)] = W[(size_t)(k0 + kk) * N + n0 + (lane & 31)] * pg8::W8_SCALE; }
    asm volatile("s_waitcnt lgkmcnt(0)" ::: "memory");
    const int c = lane & 7;
#pragma unroll
    for (int j = 0; j < 4; ++j) { const int n = (lane >> 3) + 8 * j; const LAS float* s = scr + (8 * c) * 33 + n;
        const f32x4 a = {s[0 * 33], s[1 * 33], s[2 * 33], s[3 * 33]}, b = {s[4 * 33], s[5 * 33], s[6 * 33], s[7 * 33]};
        *(u32x2*)(WT + (size_t)dest_row(kind, n0 + n) * K + k0 + 8 * c) = pack8_fp8(a, b); }
    asm volatile("s_waitcnt lgkmcnt(0)" ::: "memory");
}
constexpr int MOE_I_GU = (D / 64) * (2 * DFF / 128), MOE_I_DN = (DFF / 64) * (D / 128), MOE_I_E = MOE_I_GU + MOE_I_DN, MOE_ITEMS = NEXP * MOE_I_E;
__device__ __forceinline__ void conv_moe_item(const Frame& F, int g) {
    const int lane = F.lane, nq = lane & 31, half = lane >> 5; const int e = g / MOE_I_E; int r = g - e * MOE_I_E;
    const float* W; unsigned char* dst; int K, N, kind;
    if (r < MOE_I_GU) { W = INF(I_MGU) + (size_t)e * D * 2 * DFF; K = D; N = 2 * DFF; dst = F.ws + W_MGU + (size_t)e * 2 * DFF * D; kind = 1; }
    else { r -= MOE_I_GU; W = INF(I_MDN) + (size_t)e * DFF * D; K = DFF; N = D; dst = F.ws + W_MDN + (size_t)e * D * DFF; kind = 0; }
    const int nkb = K / 64, nb = r / nkb, kb = r - nb * nkb, k0 = 64 * kb, n0 = 128 * nb;
    const float* wp = W + (size_t)(k0 + 32 * half) * N + n0 + 4 * nq; f32x4 v[32];
#pragma unroll
    for (int i = 0; i < 32; ++i) v[i] = *(const f32x4*)(wp + (size_t)i * N);
    LAS unsigned char* t = F.lds + F.wave * 16384;
#pragma unroll
    for (int j = 0; j < 4; ++j)
#pragma unroll
        for (int c = 0; c < 4; ++c) { const f32x4 a = (f32x4){v[8 * c][j], v[8 * c + 1][j], v[8 * c + 2][j], v[8 * c + 3][j]} * pg8::W8_SCALE, b = (f32x4){v[8 * c + 4][j], v[8 * c + 5][j], v[8 * c + 6][j], v[8 * c + 7][j]} * pg8::W8_SCALE;
            *(LAS u32x2*)(t + (4 * nq + j) * 72 + 32 * half + 8 * c) = pack8_fp8(a, b); }
    asm volatile("s_waitcnt lgkmcnt(0)" ::: "memory");
    const int c8 = lane & 7;
#pragma unroll
    for (int jj = 0; jj < 16; ++jj) { const int n = (lane >> 3) + 8 * jj;
        *(u32x2*)(dst + (size_t)dest_row(kind, n0 + n) * K + k0 + 8 * c8) = *(const LAS u32x2*)(t + n * 72 + 8 * c8); }
    asm volatile("s_waitcnt lgkmcnt(0)" ::: "memory");
}
constexpr int MOE_P10_PER = 3, MOE_NA = 192 * 8 * MOE_P10_PER;
__device__ __forceinline__ void conv_moe_part(const Frame& F, int part, int nparts) {
    const int base = (F.G == 256) ? MOE_NA : 0, nit = MOE_ITEMS - base;
    const int gw = F.bid * 8 + F.wave, NGW = F.G * 8, per = (nit + NGW - 1) / NGW, chunk = (per + nparts - 1) / nparts;
    const int k0 = part * chunk, k1 = (k0 + chunk < per) ? k0 + chunk : per;
    for (int k = k0; k < k1; ++k) { const int g = gw + k * NGW; if (g < nit) conv_moe_item(F, base + g); }
}
__device__ __forceinline__ void conv_moe_idle(const Frame& F) {
    if (F.G != 256 || F.bid < 64 || F.probe_rep) return;
    __syncthreads();
    const int gw = (F.bid - 64) * 8 + F.wave;
    for (int k = 0; k < MOE_P10_PER; ++k) conv_moe_item(F, gw + k * (192 * 8));
}
__device__ __forceinline__ void p_conv(const Frame& F) {
    LAS float* scr = (LAS float*)(F.lds + F.wave * 16384);
    const long gw = (long)F.bid * 8 + F.wave, NGW = (long)F.G * 8;
    struct Mt { const float* W; int K, N; size_t dst; int kind; const float* g; };
    auto run = [&](const float* W, int K, int N, size_t dst, int kind, const float* g) { const long n = (long)(K / 64) * (N / 32);
        for (long it = gw; it < n; it += NGW) conv_item(W, K, N, (bf16_t*)(F.ws + dst), kind, g, scr, (int)it, F.lane); };
    run(INF(I_HGWIN), D, 8192, W_IN, 0, nullptr);
    run(INF(I_HGWOUT), D, D, W_OUT, 0, nullptr);
    run(INF(I_FGU), D, 2 * DFF, W_GU, 1, nullptr);
    run(INF(I_FDN), DFF, D, W_DN, 0, nullptr);
    run(INF(I_WKVA), D, 576, W_LAT, 2, nullptr);
    run(INF(I_WQA), D, 512, W_LAT + (size_t)768 * D * 2, 0, nullptr);
    run(INF(I_WKVB), 512, 4096, W_KVQ, 0, INF(I_KVNORMG));
    run(INF(I_WQB), 512, 3072, W_KVQ + (size_t)4096 * 512 * 2, 3, INF(I_QNORMG));
    run(INF(I_WO), D, D, W_O, 0, nullptr);
}

struct Row { f32x4 v[8]; };
__device__ __forceinline__ void row_ld(Row& r, const float* p, int lane) {
#pragma unroll
    for (int j = 0; j < 8; ++j) r.v[j] = *(const f32x4*)(p + 4 * lane + 256 * j);
}
__device__ __forceinline__ void row_ld_bf(Row& r, const bf16_t* p, int lane) {
#pragma unroll
    for (int j = 0; j < 8; ++j) { const u32x2 w = *(const u32x2*)(p + 4 * lane + 256 * j); r.v[j] = (f32x4){bflo(w[0]), bfhi(w[0]), bflo(w[1]), bfhi(w[1])}; }
}
__device__ __forceinline__ float row_ss(const Row& r) { float s = 0.f;
#pragma unroll
    for (int j = 0; j < 8; ++j) s += (r.v[j][0] * r.v[j][0] + r.v[j][1] * r.v[j][1]) + (r.v[j][2] * r.v[j][2] + r.v[j][3] * r.v[j][3]);
    return wave_sum(s); }
template <bool F8 = false>
__device__ __forceinline__ void row_mod_store(const Row& h, float rstd, const LAS float* gs, const LAS float* sh, bf16_t* o, int lane, Row* keep) {
#pragma unroll
    for (int j = 0; j < 8; ++j) { const int c = 4 * lane + 256 * j; const f32x4 gv = *(const LAS f32x4*)(gs + c), hv = *(const LAS f32x4*)(sh + c);
        const f32x4 u = h.v[j] * rstd * gv + hv; if (keep) keep->v[j] = u;
        if (F8) { int w = 0; w = __builtin_amdgcn_cvt_pk_fp8_f32(u[0], u[1], w, false); w = __builtin_amdgcn_cvt_pk_fp8_f32(u[2], u[3], w, true); *(int*)((unsigned char*)o + c) = w; }
        else *(u32x2*)(o + c) = (u32x2){cvt_pk_bf16(u[0], u[1]), cvt_pk_bf16(u[2], u[3])}; }
}
template <int MODE> __device__ __forceinline__ void p_thin(const Frame& F) {
    const int lane = F.lane; float* out = F.a->out;
    LAS float* T_GG = (LAS float*)F.lds; LAS float* T_GS = T_GG + 4096; LAS float* T_SH = T_GS + 4096; LAS float* T_KGS = T_SH + 4096; LAS float* T_KSH = T_KGS + 4096;
    LAS float* wr = T_SH + 4096;
    __syncthreads();
    for (int i = F.tid; i < 2 * D; i += 512) { const int b = i >> 11, c = i & (D - 1);
        if (MODE >= 1) { const int mw = MODE - 1; T_GG[i] = modp(F, mw, 2, b)[c] * normg(F, mw >> 1, mw & 1, 1)[c]; }
        if (MODE <= 3) { T_GS[i] = normg(F, MODE >> 1, MODE & 1, 0)[c] * (1.0f + modp(F, MODE, 1, b)[c]); T_SH[i] = modp(F, MODE, 0, b)[c]; }
        if (MODE == 2) { T_KGS[i] = INF(I_KVNG)[c] * (1.0f + modp(F, 4, 1, b)[c]); T_KSH[i] = modp(F, 4, 0, b)[c]; } }
    if (MODE == 3) { const float* w = INF(I_ROUTER); for (int i = F.tid; i < D * NEXP; i += 512) wr[i] = w[i]; }
    __syncthreads();
    int tst[NEXP];
    if (MODE == 4) { int t = 0;
#pragma unroll
        for (int e = 0; e < NEXP; ++e) { tst[e] = t * 256; t += ((int)F.ctl[CW_CNT + 64 * e] + 255) >> 8; } }
    for (int m = F.bid * 8 + F.wave; m < M; m += F.G * 8) {
        const int b = m >> 13, tb = b * D; Row h;
        if (MODE == 0) row_ld(h, INF(I_X) + (size_t)m * D, lane);
        else {
            Row y; float escale = EPS;
            if (MODE == 4) { const int4 tk = ((const int4*)(F.ws + WS_TOK))[m]; const float w0 = __int_as_float(tk.z), w1 = __int_as_float(tk.w);
                int o0 = 0, o1 = 0;
#pragma unroll
                for (int e = 0; e < NEXP; ++e) { o0 = ((tk.x & 15) == e) ? tst[e] : o0; o1 = ((tk.y & 15) == e) ? tst[e] : o1; }
                const bf16_t* y0 = (const bf16_t*)(F.ws + B_Y2) + (size_t)(o0 + (tk.x >> 4)) * D; const bf16_t* y1 = (const bf16_t*)(F.ws + B_Y2) + (size_t)(o1 + (tk.y >> 4)) * D;
                Row ya; row_ld_bf(ya, y0, lane); row_ld_bf(y, y1, lane);
#pragma unroll
                for (int j = 0; j < 8; ++j) y.v[j] = ya.v[j] * w0 + y.v[j] * w1;
            } else row_ld_bf(y, (const bf16_t*)(F.ws + WS_Y) + (size_t)m * D, lane);
            if (MODE == 1) { const float* ss = (const float*)(F.ws + WS_SSO) + (size_t)m * 128; const float so = wave_sum(ss[lane] + ss[64 + lane]) * (1.0f / D); escale = EPS * (so + EPS); }
            bf16_t* xr = (bf16_t*)(F.ws + WS_XR) + (size_t)m * D;
            if (MODE == 1) row_ld(h, INF(I_X) + (size_t)m * D, lane); else row_ld_bf(h, xr, lane);
            const float rstd = rsqrtf(row_ss(y) * (1.0f / D) + escale);
#pragma unroll
            for (int j = 0; j < 8; ++j) { const int c = 4 * lane + 256 * j; const f32x4 gg = *(const LAS f32x4*)(T_GG + tb + c);
                h.v[j] = h.v[j] + gg * (y.v[j] * rstd);
                if (MODE == 4) *(f32x4*)(out + (size_t)m * D + c) = h.v[j];
                else *(u32x2*)(xr + c) = (u32x2){cvt_pk_bf16(h.v[j][0], h.v[j][1]), cvt_pk_bf16(h.v[j][2], h.v[j][3])}; }
        }
        if (MODE == 4) continue;
        const float rstd = rsqrtf(row_ss(h) * (1.0f / D) + EPS);
        if (MODE == 2) row_mod_store(h, rstd, T_KGS + tb, T_KSH + tb, (bf16_t*)(F.ws + WS_XS) + (size_t)m * D, lane, nullptr);
        Row u;
        if (MODE == 3) row_mod_store<true>(h, rstd, T_GS + tb, T_SH + tb, (bf16_t*)(F.ws + WS_U + (size_t)m * D), lane, &u);
        else row_mod_store(h, rstd, T_GS + tb, T_SH + tb, (bf16_t*)(F.ws + WS_U) + (size_t)m * D, lane, nullptr);
        if (MODE == 3) {
            float lg[NEXP];
#pragma unroll
            for (int e = 0; e < NEXP; ++e) lg[e] = 0.f;
#pragma unroll
            for (int j = 0; j < 8; ++j) { asm volatile("" ::: "memory");
#pragma unroll
                for (int c = 0; c < 4; ++c) { const int i = 4 * lane + 256 * j + c; const f32x4 w0 = *(const LAS f32x4*)(wr + i * 8), w1 = *(const LAS f32x4*)(wr + i * 8 + 4); const float x = u.v[j][c];
                    lg[0] += x * w0[0]; lg[1] += x * w0[1]; lg[2] += x * w0[2]; lg[3] += x * w0[3]; lg[4] += x * w1[0]; lg[5] += x * w1[1]; lg[6] += x * w1[2]; lg[7] += x * w1[3]; } }
#pragma unroll
            for (int e = 0; e < NEXP; ++e) lg[e] = wave_sum(lg[e]);
            int e0 = 0; float v0 = lg[0];
#pragma unroll
            for (int e = 1; e < NEXP; ++e) if (lg[e] > v0) { v0 = lg[e]; e0 = e; }
            int e1 = e0 == 0 ? 1 : 0; float v1 = lg[e1];
#pragma unroll
            for (int e = 0; e < NEXP; ++e) if (e != e0 && lg[e] > v1) { v1 = lg[e]; e1 = e; }
            if (lane == 0) { const float p1 = __expf(v1 - v0), w0 = 1.0f / (1.0f + p1), w1 = p1 * w0;
                const int s0 = (int)atomicAdd(F.ctl + CW_CNT + 64 * e0, 1u), s1 = (int)atomicAdd(F.ctl + CW_CNT + 64 * e1, 1u);
                int* list = (int*)(F.ws + WS_LIST); list[(size_t)e0 * M + s0] = m; list[(size_t)e1 * M + s1] = m;
                ((int4*)(F.ws + WS_TOK))[m] = make_int4(e0 | (s0 << 4), e1 | (s1 << 4), __float_as_int(w0), __float_as_int(w1)); }
        }
    }
}

#define MFMA16(X, Y, C) __builtin_amdgcn_mfma_f32_16x16x32_bf16((X), (Y), (C), 0, 0, 0)
__device__ __forceinline__ float expc(float x) { return __expf(fminf(x, 80.0f)); }
__device__ __forceinline__ int hg_tiled(int r, int seg) { return (((r >> 4) * 2 + (seg >> 1)) * 64 + (2 * (seg & 1)) * 16 + (r & 15)) * 8; }
__device__ __forceinline__ void p_hg_chunk(const Frame& F) {
    constexpr int RS = 272, TS = 144;
    LAS unsigned char* QA = F.lds; LAS unsigned char* QB = QA + 64 * RS; LAS unsigned char* KA = QB + 32 * RS; LAS unsigned char* KB = KA + 32 * RS;
    LAS unsigned char* VS = KB + 64 * RS; LAS unsigned char* VT = VS + 64 * RS; LAS unsigned char* PS = VT + 128 * TS; LAS float* TOT = (LAS float*)(PS + 64 * TS);
    const int tid = F.tid, lane = F.lane, w = F.wave, ch = tid & 127, seg = tid >> 7, fr = lane & 15, fq = lane >> 4;
    const _Float16* LFg = (const _Float16*)(F.ws + B_LF); const bf16_t* Qg = (const bf16_t*)(F.ws + B_Q); const bf16_t* VIg = (const bf16_t*)(F.ws + B_VI);
    for (int unit = F.bid; unit < 4096; unit += F.G) {
        const int bh = unit >> 7, c = unit & 127, b = bh >> 4, h = bh & 15, m0 = b * SEQ + 64 * c, k0 = 128 * h;
        float lf[16], qv[16];
#pragma unroll
        for (int i = 0; i < 16; ++i) { const size_t o = (size_t)(m0 + 16 * seg + i) * D + k0 + ch; lf[i] = (float)LFg[o]; qv[i] = bf2f(Qg[o]); }
#pragma unroll
        for (int p = 0; p < 2; ++p) { const int piece = tid + 512 * p, s = piece >> 4, v8 = (piece & 15) * 8; *(LAS u32x4*)(VS + s * RS + v8 * 2) = *(const u32x4*)(VIg + (size_t)(m0 + s) * D + k0 + v8); }
        float bcs[16]; float run = 0.f;
#pragma unroll
        for (int i = 0; i < 16; ++i) { run += lf[i]; bcs[i] = run; }
        TOT[seg * 128 + ch] = run;
        __syncthreads();
        const float t0 = TOT[ch], t1 = TOT[128 + ch], t2 = TOT[256 + ch], t3 = TOT[384 + ch];
        const float pre = seg == 0 ? 0.f : seg == 1 ? t0 : seg == 2 ? t0 + t1 : t0 + t1 + t2, r1 = t0 + t1, bl = r1 + t2 + t3;
        unsigned kh[8];
#pragma unroll
        for (int i = 0; i < 16; i += 2) { float kv[2];
#pragma unroll
            for (int z = 0; z < 2; ++z) { const int t = 16 * seg + i + z; const float bb = bcs[i + z] + pre, kk = 1.0f - __expf(lf[i + z]), q = qv[i + z];
                *(LAS bf16_t*)(QA + t * RS + ch * 2) = f2bf(q * expc(bb));
                if (seg >= 2) *(LAS bf16_t*)(QB + (t - 32) * RS + ch * 2) = f2bf(q * expc(bb - r1));
                if (seg < 2) *(LAS bf16_t*)(KA + t * RS + ch * 2) = f2bf(kk * expc(-bb));
                *(LAS bf16_t*)(KB + t * RS + ch * 2) = f2bf(kk * expc(r1 - bb));
                kv[z] = kk * expc(bl - bb); }
            kh[i >> 1] = cvt_pk_bf16(kv[0], kv[1]); }
        { bf16_t* kt = (bf16_t*)(F.ws + B_KT) + (size_t)unit * 8192 + hg_tiled(ch, seg); *(u32x4*)kt = (u32x4){kh[0], kh[1], kh[2], kh[3]}; *(u32x4*)(kt + 128) = (u32x4){kh[4], kh[5], kh[6], kh[7]}; }
        if (seg == 3) ((float*)(F.ws + B_DEC))[(size_t)unit * 128 + ch] = expc(bl);
        { unsigned vv[8];
#pragma unroll
            for (int i = 0; i < 16; i += 2) { const unsigned lo = *(const LAS bf16_t*)(VS + (16 * seg + i) * RS + ch * 2), hi = *(const LAS bf16_t*)(VS + (16 * seg + i + 1) * RS + ch * 2); vv[i >> 1] = lo | (hi << 16); }
            const u32x4 a = {vv[0], vv[1], vv[2], vv[3]}, bq = {vv[4], vv[5], vv[6], vv[7]};
            *(LAS u32x4*)(VT + ch * TS + 32 * seg) = a; *(LAS u32x4*)(VT + ch * TS + 32 * seg + 16) = bq;
            bf16_t* vt = (bf16_t*)(F.ws + B_VT) + (size_t)unit * 8192 + hg_tiled(ch, seg); *(u32x4*)vt = a; *(u32x4*)(vt + 128) = bq; }
        __syncthreads();
#pragma unroll
        for (int p = 0; p < 2; ++p) { const int piece = tid + 512 * p, ww = piece >> 7, pp = (piece >> 6) & 1, ln = piece & 63, r_ = ln & 15, q_ = ln >> 4;
            const u32x2 lo = *(const LAS u32x2*)(QA + (32 * pp + r_) * RS + (16 * ww + 4 * q_) * 2), hi = *(const LAS u32x2*)(QA + (32 * pp + 16 + r_) * RS + (16 * ww + 4 * q_) * 2);
            *(u32x4*)((bf16_t*)(F.ws + B_QH) + (size_t)unit * 8192 + piece * 8) = (u32x4){lo[0], lo[1], hi[0], hi[1]}; }
        { const int tt = w >> 2, st = w & 3; f32x4 acc = {0.f, 0.f, 0.f, 0.f};
#pragma unroll
            for (int kb = 0; kb < 4; ++kb) acc = MFMA16(*(const LAS bf16x8*)(KB + (16 * st + fr) * RS + (32 * kb + 8 * fq) * 2), *(const LAS bf16x8*)(QB + (16 * tt + fr) * RS + (32 * kb + 8 * fq) * 2), acc);
            const int ta = 32 + 16 * tt + fr, sa = 16 * st + 4 * fq;
#pragma unroll
            for (int j = 0; j < 4; ++j) if (sa + j > ta) acc[j] = 0.f;
            *(LAS u32x2*)(PS + ta * TS + sa * 2) = (u32x2){cvt_pk_bf16(acc[0], acc[1]), cvt_pk_bf16(acc[2], acc[3])}; }
        if (w < 4) { const int tt = w >> 1, st = w & 1; f32x4 acc = {0.f, 0.f, 0.f, 0.f};
#pragma unroll
            for (int kb = 0; kb < 4; ++kb) acc = MFMA16(*(const LAS bf16x8*)(KA + (16 * st + fr) * RS + (32 * kb + 8 * fq) * 2), *(const LAS bf16x8*)(QA + (16 * tt + fr) * RS + (32 * kb + 8 * fq) * 2), acc);
            const int ta = 16 * tt + fr, sa = 16 * st + 4 * fq;
#pragma unroll
            for (int j = 0; j < 4; ++j) if (sa + j > ta) acc[j] = 0.f;
            *(LAS u32x2*)(PS + ta * TS + sa * 2) = (u32x2){cvt_pk_bf16(acc[0], acc[1]), cvt_pk_bf16(acc[2], acc[3])}; }
        __syncthreads();
#pragma unroll
        for (int tt = 0; tt < 4; ++tt) { f32x4 acc = {0.f, 0.f, 0.f, 0.f};
#pragma unroll
            for (int sb = 0; sb < 2; ++sb) if (sb == 0 || tt >= 2) acc = MFMA16(*(const LAS bf16x8*)(VT + (16 * w + fr) * TS + (32 * sb + 8 * fq) * 2), *(const LAS bf16x8*)(PS + (16 * tt + fr) * TS + (32 * sb + 8 * fq) * 2), acc);
            *(u32x2*)((bf16_t*)(F.ws + B_OI) + tm_off(m0 + 16 * tt + fr, k0 + 16 * w + 4 * fq)) = (u32x2){cvt_pk_bf16(acc[0], acc[1]), cvt_pk_bf16(acc[2], acc[3])}; }
        __syncthreads();
    }
}
__device__ __forceinline__ void p_hg_scan(const Frame& F) {
    LAS f32x4* red = (LAS f32x4*)F.lds;
    const int tid = F.tid, lane = F.lane, w = F.wave, fr = lane & 15, fq = lane >> 4;
    const bf16_t* QH = (const bf16_t*)(F.ws + B_QH); const bf16_t* KT = (const bf16_t*)(F.ws + B_KT); const bf16_t* VT = (const bf16_t*)(F.ws + B_VT); const float* DEC = (const float*)(F.ws + B_DEC);
    const bf16_t* OI = (const bf16_t*)(F.ws + B_OI); const bf16_t* GS = (const bf16_t*)(F.ws + B_GS); bf16_t* OG = (bf16_t*)(F.ws + B_OG); float* SSO = (float*)(F.ws + WS_SSO);
    for (int ui = F.bid; ui < 256; ui += F.G) {
        const int unit = (F.G == 256) ? (((ui & 7) * 4 + (ui >> 6)) * 8 + ((ui >> 3) & 7)) : ui;
        const int bh = unit >> 3, vs = unit & 7, b = bh >> 4, h = bh & 15;
        const int tt2 = (tid >> 6) & 3;
        const size_t rowoff = tm_off(b * SEQ + 16 * tt2 + fr, 128 * h + 16 * vs + 4 * fq);
        f32x4 S = {0.f, 0.f, 0.f, 0.f};
        u32x4 qA[2], qB[2]; u32x2 gsA, gsB, oiA, oiB; bf16x8 ktA[2], ktB[2], vtA[2], vtB[2]; f32x4 dA, dB;
#define HG_LOAD(q_, kt_, vt_, d_, oi_, gs_, cc) do { const size_t cu = (size_t)(bh * 128 + (cc)); \
            _Pragma("unroll") for (int pp = 0; pp < 2; ++pp) q_[pp] = *(const u32x4*)(QH + cu * 8192 + ((w * 2 + pp) * 64 + lane) * 8); \
            _Pragma("unroll") for (int sb = 0; sb < 2; ++sb) { kt_[sb] = *(const bf16x8*)(KT + cu * 8192 + ((w * 2 + sb) * 64 + lane) * 8); vt_[sb] = *(const bf16x8*)(VT + cu * 8192 + ((vs * 2 + sb) * 64 + lane) * 8); } \
            d_ = *(const f32x4*)(DEC + cu * 128 + 16 * w + 4 * fq); \
            if (tid < 256) { oi_ = *(const u32x2*)(OI + rowoff + (size_t)(cc) * 131072); gs_ = *(const u32x2*)(GS + rowoff + (size_t)(cc) * 131072); } } while (0)
#define HG_STEP(q_, kt_, vt_, d_, oi_, gs_, cc) do { \
            LAS f32x4* rb = red + ((cc) & 1) * 2048; \
            { const u32x4 sw = {cvt_pk_bf16(S[0], S[1]), cvt_pk_bf16(S[2], S[3]), 0u, 0u}; const bf16x8 Sb = *(const bf16x8*)&sw; \
                _Pragma("unroll") for (int tt = 0; tt < 4; ++tt) { const u32x4 xw = {q_[tt >> 1][2 * (tt & 1)], q_[tt >> 1][2 * (tt & 1) + 1], 0u, 0u}; const f32x4 z = {0.f, 0.f, 0.f, 0.f}; \
                    rb[(w * 4 + tt) * 64 + lane] = MFMA16(Sb, *(const bf16x8*)&xw, z); } }            \
            S = S * d_; S = MFMA16(kt_[0], vt_[0], S); S = MFMA16(kt_[1], vt_[1], S); \
            const u32x2 oiw = oi_; const f32x4 oi = {bflo(oiw[0]), bfhi(oiw[0]), bflo(oiw[1]), bfhi(oiw[1])}; const u32x2 gs = gs_; \
            if ((cc) + 2 < NCH) HG_LOAD(q_, kt_, vt_, d_, oi_, gs_, (cc) + 2); \
            __syncthreads(); \
            if (tid < 256) { f32x4 o = rb[tt2 * 64 + lane]; \
                _Pragma("unroll") for (int ww = 1; ww < 8; ++ww) o += rb[(ww * 4 + tt2) * 64 + lane]; \
                o += oi; float s2 = (o[0] * o[0] + o[1] * o[1]) + (o[2] * o[2] + o[3] * o[3]); s2 += __shfl_xor(s2, 16); s2 += __shfl_xor(s2, 32); \
                *(u32x2*)(OG + rowoff + (size_t)(cc) * 131072) = (u32x2){cvt_pk_bf16(o[0] * bflo(gs[0]), o[1] * bfhi(gs[0])), cvt_pk_bf16(o[2] * bflo(gs[1]), o[3] * bfhi(gs[1]))}; \
                if (fq == 0) SSO[(size_t)(b * SEQ + 64 * (cc) + 16 * tt2 + fr) * 128 + h * 8 + vs] = s2; } } while (0)
        HG_LOAD(qA, ktA, vtA, dA, oiA, gsA, 0);
        HG_LOAD(qB, ktB, vtB, dB, oiB, gsB, 1);
        for (int c = 0; c < NCH; c += 2) { HG_STEP(qA, ktA, vtA, dA, oiA, gsA, c); HG_STEP(qB, ktB, vtB, dB, oiB, gsB, c + 1); }
        __syncthreads();
#undef HG_LOAD
#undef HG_STEP
    }
}

namespace att {
constexpr int KROW = 384, SHM_K = 64 * KROW, SHM_V = 16384, OFF_K = 2 * SHM_V, OFF_WS = OFF_K + 2 * SHM_K;
constexpr float THR = 8.f;
__device__ __forceinline__ int v_rd_base(int lane) { return ((lane & 3) << 3) | (((lane >> 2) & 3) << 6) | (((lane >> 4) & 1) << 5) | (((lane >> 5) & 1) << 8); }
__device__ __forceinline__ int crow(int r, int hi) { return (r & 3) + 8 * (r >> 2) + 4 * hi; }
#define SBAR() __builtin_amdgcn_sched_barrier(0)
__device__ __forceinline__ void mask_tile(f32x16& p0, f32x16& p1, int dq) {
    const float NEG = -__builtin_inff();
#pragma unroll
    for (int r = 0; r < 16; ++r) { const int c = (r & 3) + 8 * (r >> 2); if (dq - c < 0) p0[r] = NEG; if (dq - c - 32 < 0) p1[r] = NEG; }
}
__device__ __forceinline__ void partialSM(f32x16& p0, f32x16& p1, float& m_reg, float& mn, float& alpha) {
    float pmax = p0[0];
#pragma unroll
    for (int r = 1; r < 16; ++r) pmax = fmaxf(pmax, p0[r]);
#pragma unroll
    for (int r = 0; r < 16; ++r) pmax = fmaxf(pmax, p1[r]);
    { auto rr = __builtin_amdgcn_permlane32_swap(__float_as_uint(pmax), __float_as_uint(pmax), false, false); pmax = fmaxf(__uint_as_float(rr[0]), __uint_as_float(rr[1])); }
    constexpr float C2 = 1.4426950408889634f * MLA_SCALE;
    if (__builtin_expect(__all((pmax - m_reg) * MLA_SCALE <= THR), 1)) { mn = m_reg; alpha = 1.f; }
    else { mn = fmaxf(m_reg, pmax); alpha = __builtin_amdgcn_exp2f((m_reg - mn) * C2); m_reg = mn; }
    const float mnL = -mn * C2;
#pragma unroll
    for (int r = 0; r < 16; ++r) p0[r] = __builtin_amdgcn_exp2f(fmaf(p0[r], C2, mnL));
#pragma unroll
    for (int r = 0; r < 16; ++r) p1[r] = __builtin_amdgcn_exp2f(fmaf(p1[r], C2, mnL));
}
__device__ __forceinline__ void finishSM(f32x16& p0, f32x16& p1, float alpha, float& l_reg, bf16x8& pa0, bf16x8& pa1, bf16x8& pa2, bf16x8& pa3) {
    float ps = 0;
#pragma unroll
    for (int r = 0; r < 16; ++r) ps += p0[r];
#pragma unroll
    for (int r = 0; r < 16; ++r) ps += p1[r];
    { auto rr = __builtin_amdgcn_permlane32_swap(__float_as_uint(ps), __float_as_uint(ps), false, false); ps = __uint_as_float(rr[0]) + __uint_as_float(rr[1]); }
    l_reg = l_reg * alpha + ps;
#define PK4(P, B_, OUT) do { unsigned a0 = cvt_pk_bf16(P[B_+0], P[B_+1]), a1 = cvt_pk_bf16(P[B_+2], P[B_+3]); unsigned b0 = cvt_pk_bf16(P[B_+4], P[B_+5]), b1 = cvt_pk_bf16(P[B_+6], P[B_+7]); \
        auto r0 = __builtin_amdgcn_permlane32_swap(a0, b0, false, false); auto r1 = __builtin_amdgcn_permlane32_swap(a1, b1, false, false); \
        u32x4 w_ = {r0[0], r1[0], r0[1], r1[1]}; OUT = *reinterpret_cast<bf16x8*>(&w_); } while (0)
    PK4(p0, 0, pa0); PK4(p0, 8, pa1); PK4(p1, 0, pa2); PK4(p1, 8, pa3);
#undef PK4
}
#define KRD2(dst0, dst1, j, imm) do { asm volatile("ds_read_b128 %0, %1 offset:%2" : "=&v"(dst0) : "v"(kb[j]), "i"(imm) : "memory"); \
                                      asm volatile("ds_read_b128 %0, %1 offset:%2" : "=&v"(dst1) : "v"(kb[j]), "i"((imm) + 32 * KROW) : "memory"); } while (0)
#define LGK(n) asm volatile("s_waitcnt lgkmcnt(%0)" :: "i"(n) : "memory")
template <int KB> __device__ __forceinline__ void qkt(f32x16& p0, f32x16& p1, const int (&kb)[4], const bf16x8* qr) {
    p0 = f32x16{}; p1 = f32x16{};
    bf16x8 ka[4], kc[4];
#define KIMM(d0) (KB * SHM_K + ((d0) >> 2) * 128)
    KRD2(ka[0], kc[0], 0, KIMM(0)); KRD2(ka[1], kc[1], 1, KIMM(1)); KRD2(ka[2], kc[2], 2, KIMM(2));
#define QK_STEP(d0) do { if ((d0) + 3 < 12) KRD2(ka[((d0) + 3) & 3], kc[((d0) + 3) & 3], ((d0) + 3) & 3, KIMM((d0) + 3)); \
        LGK(((d0) + 3 < 12) ? 6 : 2 * (11 - (d0))); SBAR(); \
        p0 = __builtin_amdgcn_mfma_f32_32x32x16_bf16(ka[(d0) & 3], qr[d0], p0, 0, 0, 0); p1 = __builtin_amdgcn_mfma_f32_32x32x16_bf16(kc[(d0) & 3], qr[d0], p1, 0, 0, 0); } while (0)
    QK_STEP(0); QK_STEP(1); QK_STEP(2); QK_STEP(3); QK_STEP(4); QK_STEP(5); QK_STEP(6); QK_STEP(7); QK_STEP(8); QK_STEP(9); QK_STEP(10); QK_STEP(11);
#undef QK_STEP
#undef KIMM
}
#define TRRD(dst, off) asm volatile("ds_read_b64_tr_b16 %0, %1 offset:%2" : "=&v"(dst) : "v"(vb0), "i"(off) : "memory")
#define VRD8(L, H, d0, VB_) do { constexpr int b_ = (VB_) * SHM_V + (d0) * 512; TRRD(L[0], b_); TRRD(H[0], b_ + 2048); TRRD(L[1], b_ + 4096); TRRD(H[1], b_ + 6144); TRRD(L[2], b_ + 8192); TRRD(H[2], b_ + 10240); TRRD(L[3], b_ + 12288); TRRD(H[3], b_ + 14336); } while (0)
#define PVMM(L, H, d0) do { \
        o[d0] = __builtin_amdgcn_mfma_f32_32x32x16_bf16(pa0, (bf16x8){L[0][0], L[0][1], L[0][2], L[0][3], H[0][0], H[0][1], H[0][2], H[0][3]}, o[d0], 0, 0, 0); \
        o[d0] = __builtin_amdgcn_mfma_f32_32x32x16_bf16(pa1, (bf16x8){L[1][0], L[1][1], L[1][2], L[1][3], H[1][0], H[1][1], H[1][2], H[1][3]}, o[d0], 0, 0, 0); \
        o[d0] = __builtin_amdgcn_mfma_f32_32x32x16_bf16(pa2, (bf16x8){L[2][0], L[2][1], L[2][2], L[2][3], H[2][0], H[2][1], H[2][2], H[2][3]}, o[d0], 0, 0, 0); \
        o[d0] = __builtin_amdgcn_mfma_f32_32x32x16_bf16(pa3, (bf16x8){L[3][0], L[3][1], L[3][2], L[3][3], H[3][0], H[3][1], H[3][2], H[3][3]}, o[d0], 0, 0, 0); } while (0)
__device__ __forceinline__ void block(const Frame& F, int bh, int qb) {
    LAS unsigned char* lds = F.lds;
    int lane = F.lane; asm volatile("" : "+v"(lane));
    const int tid = F.tid, wid = F.wave, r32 = lane & 31, hi = lane >> 5, b = bh >> 4, h = bh & 15;
    const bf16_t* KN = (const bf16_t*)(F.ws + B_KN) + (size_t)bh * SEQ * 128; const bf16_t* VV = (const bf16_t*)(F.ws + B_V) + (size_t)bh * SEQ * 128;
    const bf16_t* KR = (const bf16_t*)(F.ws + B_KR) + (size_t)b * SEQ * 64;
    const bf16_t* QN = (const bf16_t*)(F.ws + B_QN) + (size_t)bh * SEQ * 128; const bf16_t* QR = (const bf16_t*)(F.ws + B_QR) + (size_t)bh * SEQ * 64;
    const int q0 = qb * 256, NT = (q0 + 256) / 64, qlo = q0 + wid * 32, qm = qlo + r32 - 4 * hi;
    bf16x8 qr[12];
    { const size_t row = (size_t)(qlo + r32);
#pragma unroll
      for (int d0 = 0; d0 < 8; ++d0) qr[d0] = *(const bf16x8*)(QN + row * 128 + d0 * 16 + hi * 8);
#pragma unroll
      for (int d0 = 0; d0 < 4; ++d0) qr[8 + d0] = *(const bf16x8*)(QR + row * 64 + d0 * 16 + hi * 8); }
    unsigned koff[3], kstr[3], voff[2];
    const unsigned oKN = (unsigned)(B_KN + (size_t)bh * SEQ * 128 * 2), oKR = (unsigned)(B_KR + (size_t)b * SEQ * 64 * 2), oV = (unsigned)(B_V + (size_t)bh * SEQ * 128 * 2);
#pragma unroll
    for (int i = 0; i < 3; ++i) { const int p = (wid * 3 + i) * 64 + lane, r = p / 24, cs = p - r * 24, c = cs ^ ((r >> 1) & 7);
        if (c < 16) { koff[i] = oKN + (unsigned)(r * 128 + 8 * c) * 2u; kstr[i] = 64 * 128 * 2; } else { koff[i] = oKR + (unsigned)(r * 64 + 8 * (c - 16)) * 2u; kstr[i] = 64 * 64 * 2; } }
#pragma unroll
    for (int i = 0; i < 2; ++i) { const int s_ = (wid * 2 + i) * 64 + lane, sub = s_ >> 5, w_ = s_ & 31, kk = (sub >> 2) * 8 + (w_ >> 2), c = (sub & 3) * 32 + (w_ & 3) * 8, k = (kk & ~0xC) | ((kk & 4) << 1) | ((kk & 8) >> 1);
        voff[i] = oV + (unsigned)(k * 128 + c) * 2u; }
    const char* wsb = (const char*)F.ws;
#define A_DMA(t, bf) do { \
        _Pragma("unroll") for (int i = 0; i < 3; ++i) __builtin_amdgcn_global_load_lds((const unsigned*)(wsb + (koff[i] + (unsigned)(t) * kstr[i])), (LAS unsigned*)(lds + OFF_K + (bf) * SHM_K + (wid * 3 + i) * 1024), 16, 0, 0); \
        _Pragma("unroll") for (int i = 0; i < 2; ++i) __builtin_amdgcn_global_load_lds((const unsigned*)(wsb + (voff[i] + (unsigned)(t) * (64u * 128u * 2u))), (LAS unsigned*)(lds + (bf) * SHM_V + (wid * 2 + i) * 1024), 16, 0, 0); } while (0)
    int kb[4];
#pragma unroll
    for (int j = 0; j < 4; ++j) kb[j] = (int)(uintptr_t)lds + OFF_K + r32 * KROW + (((2 * j + hi) ^ ((r32 >> 1) & 7)) << 4);
    const int vb0 = (int)(uintptr_t)lds + v_rd_base(lane);
    LAS float* wsl = (LAS float*)(lds + OFF_WS) + wid * 64; LAS float* li_l = wsl; LAS float* al_l = wsl + 32;
    float m_reg = -1e30f, l_reg = 0.f; f32x16 o[4] = {};
    A_DMA(0, 0);
#define A_STEP(t, VB) do { \
        asm volatile("s_waitcnt vmcnt(0)" ::: "memory"); __syncthreads(); \
        if ((t) + 1 < NT) A_DMA((t) + 1, (VB) ^ 1); \
        const int kb_ = (t) * 64; \
        if (kb_ <= qlo + 31) { f32x16 p0, p1; float mn, alpha; bf16x8 pa0, pa1, pa2, pa3; s16x4 la[4], ha[4], lb[4], hb[4]; \
            qkt<VB>(p0, p1, kb, qr); \
            VRD8(la, ha, 0, VB); SBAR(); \
            if (kb_ + 63 > qlo) { asm volatile("; diagonal tile" ::: "memory"); mask_tile(p0, p1, qm - kb_); } \
            partialSM(p0, p1, m_reg, mn, alpha); \
            if (__any(alpha < 1.f)) { if (hi == 0) al_l[r32] = alpha; asm volatile("s_waitcnt lgkmcnt(0)" ::: "memory"); \
                _Pragma("unroll") for (int d_ = 0; d_ < 4; ++d_) _Pragma("unroll") for (int r = 0; r < 16; ++r) o[d_][r] *= al_l[crow(r, hi)]; } \
            finishSM(p0, p1, alpha, l_reg, pa0, pa1, pa2, pa3); SBAR(); \
            VRD8(lb, hb, 1, VB); LGK(8); SBAR(); PVMM(la, ha, 0); SBAR(); \
            VRD8(la, ha, 2, VB); LGK(8); SBAR(); PVMM(lb, hb, 1); SBAR(); \
            VRD8(lb, hb, 3, VB); LGK(8); SBAR(); PVMM(la, ha, 2); SBAR(); \
            LGK(0); SBAR(); PVMM(lb, hb, 3); } } while (0)
    for (int t = 0; t < NT; t += 2) { A_STEP(t, 0); A_STEP(t + 1, 1); }
    if (hi == 0) li_l[r32] = l_reg; asm volatile("s_waitcnt lgkmcnt(0)" ::: "memory");
    bf16_t* Ow = (bf16_t*)(F.ws + B_O) + (size_t)(b * SEQ + qlo) * D + h * 128;
#pragma unroll
    for (int r = 0; r < 16; ++r) { const int orow = crow(r, hi); const float rl = __builtin_amdgcn_rcpf(li_l[orow]);
#pragma unroll
        for (int d0 = 0; d0 < 4; ++d0) { const float v = o[d0][r] * rl; const float vn = __shfl_xor(v, 1);
            if ((r32 & 1) == 0) *(unsigned*)(Ow + (size_t)orow * D + d0 * 32 + r32) = cvt_pk_bf16(v, vn); } }
    __syncthreads();
#undef A_DMA
#undef A_STEP
}
#undef SBAR
#undef KRD2
#undef LGK
#undef TRRD
#undef VRD8
#undef PVMM
}
__device__ __forceinline__ void p_attn(const Frame& F) {
    const int nIt = (F.G == 256) ? 4 : (1024 - F.bid + F.G - 1) / F.G;
    for (int n = 0; n < nIt; ++n) {
        int bh, qb;
        if (F.G == 256) { const int xcd = F.bid & 7, k = F.bid >> 3, x = k & 15; bh = xcd * 4 + (n >> 1) * 2 + (k >> 4); qb = (n & 1) ? 31 - x : x; }
        else { const int L = F.bid + n * F.G; bh = L >> 5; qb = L & 31; }
        att::block(F, bh, qb);
        if (((((F.bid >> 3) + n) & 3) == 0 || nIt != 4) && !F.probe_rep) conv_moe_part(F, nIt == 4 ? 0 : n, nIt == 4 ? 1 : nIt);
        __syncthreads();
    }
}

constexpr int N_PHASES = 18;
__global__ void __launch_bounds__(512, 2) fwd_kernel(Args args) {
    extern __shared__ __attribute__((aligned(16))) unsigned char lds_raw[];
    Frame F; F.lds = (LAS unsigned char*)lds_raw; F.tid = threadIdx.x; F.lane = F.tid & 63; F.wave = __builtin_amdgcn_readfirstlane(F.tid >> 6); F.G = gridDim.x; F.bid = blockIdx.x;
    F.a = &args; F.ws = args.ws; F.ctl = (unsigned*)(args.ws + WS_CTL);
    volatile LAS unsigned* MISC = (volatile LAS unsigned*)(F.lds + MISC_OFF);
    if (F.tid < 64) MISC[F.tid] = 0u;
    __syncthreads();
    XcdBarrier bar; bar.bar = F.ctl + CW_BAR; bar.x = 0; bar.st = MISC + 8;
    if (MK_N_LAUNCHES == 1) bar = xcd_barrier_post(F.ctl + CW_BAR, MISC + 8);
    const int lo = args.ph_lo, hi = args.ph_hi & 0xffff; F.probe_rep = (args.ph_hi >> 16) != 0;
#define IN(k) (lo <= (k) && (k) < hi)
#ifndef PROBE_REPEAT
#define PROBE_REPEAT (-1)
#endif
#define NREP(k) ((k) == PROBE_REPEAT ? 2 : 1)
#define SEAM(k) do { if (IN(k) && IN((k) + 1)) xcd_barrier(bar); } while (0)
    const char* ws = (const char*)F.ws;
    if (IN(0)) for (int rep_ = 0; rep_ < NREP(0); ++rep_) { if (rep_) xcd_barrier(bar); p_mod(F); } SEAM(0);
    if (IN(1)) for (int rep_ = 0; rep_ < NREP(1); ++rep_) { if (rep_) xcd_barrier(bar); p_conv(F); __syncthreads(); p_thin<0>(F); } SEAM(1);
    if (IN(2)) for (int rep_ = 0; rep_ < NREP(2); ++rep_) { if (rep_) xcd_barrier(bar); pg8::DualOrder S{ws + WS_U, ws + W_IN, ws + WS_U, ws + W_IN, 64, 32, 0, D, F.G, F.bid};
        EpiHgIn E{(bf16_t*)(F.ws + B_Q), (float*)(F.ws + B_LF), (bf16_t*)(F.ws + B_VI), (bf16_t*)(F.ws + B_GS), (const float*)(F.ws + WS_LB), INF(I_HGONG)};
        pg8::gemm_phase(F.lds, D, S, E); } SEAM(2);
    if (IN(3)) for (int rep_ = 0; rep_ < NREP(3); ++rep_) { if (rep_) xcd_barrier(bar); p_hg_chunk(F); } SEAM(3);
    if (IN(4)) for (int rep_ = 0; rep_ < NREP(4); ++rep_) { if (rep_) xcd_barrier(bar); p_hg_scan(F); } SEAM(4);
    if (IN(5)) for (int rep_ = 0; rep_ < NREP(5); ++rep_) { if (rep_) xcd_barrier(bar); pg8::DualOrder S{ws + B_OG, ws + W_OUT, ws + B_OG, ws + W_OUT, 64, 8, 0, D, F.G, F.bid, true}; EpiBf16 E{(bf16_t*)(F.ws + WS_Y), D}; pg8::gemm_phase(F.lds, D, S, E); } SEAM(5);
    if (IN(6)) for (int rep_ = 0; rep_ < NREP(6); ++rep_) { if (rep_) xcd_barrier(bar); p_thin<1>(F); } SEAM(6);
    if (IN(7)) for (int rep_ = 0; rep_ < NREP(7); ++rep_) { if (rep_) xcd_barrier(bar); pg8::DualOrder S{ws + WS_U, ws + W_GU, ws + WS_U, ws + W_GU, 64, 44, 0, D, F.G, F.bid}; EpiGU E{(bf16_t*)(F.ws + B_ACT)}; pg8::gemm_phase(F.lds, D, S, E); } SEAM(7);
    if (IN(8)) for (int rep_ = 0; rep_ < NREP(8); ++rep_) { if (rep_) xcd_barrier(bar); pg8::DualOrder S{ws + B_ACT, ws + W_DN, ws + B_ACT, ws + W_DN, 64, 8, 0, DFF, F.G, F.bid}; EpiBf16 E{(bf16_t*)(F.ws + WS_Y), D}; pg8::gemm_phase(F.lds, DFF, S, E); } SEAM(8);
    if (IN(9)) for (int rep_ = 0; rep_ < NREP(9); ++rep_) { if (rep_) xcd_barrier(bar); p_thin<2>(F); } SEAM(9);
    if (IN(10)) for (int rep_ = 0; rep_ < NREP(10); ++rep_) { if (rep_) xcd_barrier(bar); pg8::DualOrder S{ws + WS_XS, ws + W_LAT, ws + WS_U, ws + W_LAT + (size_t)768 * D * 2, 64, 3, 2, D, F.G, F.bid};
        EpiLat E{(bf16_t*)(F.ws + B_CKV), (bf16_t*)(F.ws + B_QLAT), (bf16_t*)(F.ws + B_KR), (float*)(F.ws + WS_SSC), (float*)(F.ws + WS_SSQ), (const float*)(F.ws + WS_COS), (const float*)(F.ws + WS_SIN)};
        pg8::gemm_phase(F.lds, D, S, E); conv_moe_idle(F); } SEAM(10);
    if (IN(11)) for (int rep_ = 0; rep_ < NREP(11); ++rep_) { if (rep_) xcd_barrier(bar); pg8::DualOrder S{ws + B_CKV, ws + W_KVQ, ws + B_QLAT, ws + W_KVQ + (size_t)4096 * 512 * 2, 64, 16, 12, 512, F.G, F.bid};
        EpiKvQ E{(bf16_t*)(F.ws + B_KN), (bf16_t*)(F.ws + B_V), (bf16_t*)(F.ws + B_QN), (bf16_t*)(F.ws + B_QR), (const float*)(F.ws + WS_SSC), (const float*)(F.ws + WS_SSQ), (const float*)(F.ws + WS_COS), (const float*)(F.ws + WS_SIN)};
        pg8::gemm_phase(F.lds, 512, S, E); } SEAM(11);
    if (IN(12)) for (int rep_ = 0; rep_ < NREP(12); ++rep_) { if (rep_) xcd_barrier(bar); p_attn(F); } SEAM(12);
    if (IN(13)) for (int rep_ = 0; rep_ < NREP(13); ++rep_) { if (rep_) xcd_barrier(bar); pg8::DualOrder S{ws + B_O, ws + W_O, ws + B_O, ws + W_O, 64, 8, 0, D, F.G, F.bid}; EpiBf16 E{(bf16_t*)(F.ws + WS_Y), D}; pg8::gemm_phase(F.lds, D, S, E); } SEAM(13);
    if (IN(14)) for (int rep_ = 0; rep_ < NREP(14); ++rep_) { if (rep_) xcd_barrier(bar); p_thin<3>(F); } SEAM(14);
    if (IN(15)) for (int rep_ = 0; rep_ < NREP(15); ++rep_) { if (rep_) xcd_barrier(bar); pg8::MoeOrder<true> S; S.A = ws + WS_U; S.W = ws + W_MGU; S.wstride = (size_t)2 * DFF * D; S.list = (const int*)(ws + WS_LIST); S.nN = 44; S.rb = D; S.G = F.G; S.c = F.bid; S.init(F.ctl);
        EpiGU8 E{F.ws + B_ACT2}; pg8::gemm_phase<EpiGU8, pg8::MoeOrder<true>, true>(F.lds, D, S, E); } SEAM(15);
    if (IN(16)) for (int rep_ = 0; rep_ < NREP(16); ++rep_) { if (rep_) xcd_barrier(bar); pg8::MoeOrder<false> S; S.A = ws + B_ACT2; S.W = ws + W_MDN; S.wstride = (size_t)D * DFF; S.list = nullptr; S.nN = 8; S.rb = DFF; S.G = F.G; S.c = F.bid; S.init(F.ctl);
        EpiBf16 E{(bf16_t*)(F.ws + B_Y2), D}; pg8::gemm_phase<EpiBf16, pg8::MoeOrder<false>, true>(F.lds, DFF, S, E); } SEAM(16);
    if (IN(17)) for (int rep_ = 0; rep_ < NREP(17); ++rep_) { if (rep_) xcd_barrier(bar); p_thin<4>(F); }
#undef IN
#undef SEAM
}

extern "C" void kernel_launch(void* const* d_in, const int* in_sizes, int n_in, void* d_out, int out_size, void* d_ws, size_t ws_size, hipStream_t stream) {
    static int grid = 0;
    if (grid == 0) {
        if (n_in != 25 || out_size != M * D || ws_size < WS_NEED) { fprintf(stderr, "kernel_launch: expected 25 inputs, out %d, ws >= %zu; got n_in %d out %d ws %zu\n", M * D, (size_t)WS_NEED, n_in, out_size, ws_size); grid = -1; return; }
        int dev = 0, cus = 0;
        if (hipGetDevice(&dev) != hipSuccess || hipDeviceGetAttribute(&cus, hipDeviceAttributeMultiprocessorCount, dev) != hipSuccess) { grid = -1; return; }
        if (hipFuncSetAttribute((const void*)fwd_kernel, hipFuncAttributeMaxDynamicSharedMemorySize, LDS_BYTES) != hipSuccess) { fprintf(stderr, "kernel_launch: hipFuncSetAttribute failed\n"); grid = -1; return; }
        int per_cu = 0;
        if (hipOccupancyMaxActiveBlocksPerMultiprocessor(&per_cu, (const void*)fwd_kernel, 512, LDS_BYTES) != hipSuccess || per_cu < 1) { fprintf(stderr, "kernel_launch: occupancy query reports %d\n", per_cu); (void)hipGetLastError(); }
        grid = cus;
    }
    if (grid < 0) return;
    (void)hipMemsetAsync((char*)d_ws + WS_CTL, 0, CTL_BYTES, stream);
    Args a{};
    for (int i = 0; i < 25; ++i) a.in[i] = d_in[i];
    a.out = (float*)d_out; a.ws = (unsigned char*)d_ws;
    if (MK_N_LAUNCHES == 1) { a.ph_lo = 0; a.ph_hi = N_PHASES; hipLaunchKernelGGL(fwd_kernel, dim3(grid), dim3(512), LDS_BYTES, stream, a); }
    else for (int p = 0; p < N_PHASES; ++p) { a.ph_lo = p; a.ph_hi = p + 1; hipLaunchKernelGGL(fwd_kernel, dim3(grid), dim3(512), LDS_BYTES, stream, a);
#if defined(PROBE_HOST_REPEAT)
        if (p == PROBE_HOST_REPEAT) { a.ph_hi |= 1 << 16; hipLaunchKernelGGL(fwd_kernel, dim3(grid), dim3(512), LDS_BYTES, stream, a); }
#endif
    }
    const hipError_t le = hipPeekAtLastError();
    if (le != hipSuccess) fprintf(stderr, "kernel_launch: launch failed: %s\n", hipGetErrorName(le));
}
```

```cpp
#include <hip/hip_runtime.h>
#include <cstdio>
#include <cstdint>

#ifndef MK_N_LAUNCHES
#define MK_N_LAUNCHES 1
#endif

#define LAS __attribute__((address_space(3)))
#define GAS __attribute__((address_space(1)))
typedef unsigned short bf16_t;
typedef short bf16x8 __attribute__((ext_vector_type(8)));
typedef short s16x4 __attribute__((ext_vector_type(4)));
typedef float f32x4 __attribute__((ext_vector_type(4)));
typedef float f32x2 __attribute__((ext_vector_type(2)));
typedef float f32x16 __attribute__((ext_vector_type(16)));
typedef unsigned u32x4 __attribute__((ext_vector_type(4)));
typedef unsigned u32x2 __attribute__((ext_vector_type(2)));

constexpr int D = 2048, BATCH = 2, SEQ = 8192, M = BATCH * SEQ;
constexpr int HG_H = 16, HG_K = 128, HG_C = 64, NCH = SEQ / HG_C;
constexpr int MLA_H = 16, QLORA = 512, KVLORA = 512, NOPE = 128, ROPE = 64, VH = 128;
constexpr int DFF = 5632, NEXP = 8;
constexpr float EPS = 1e-6f;
constexpr float MLA_SCALE = 0.07216878364870322f;
constexpr int NMOD = 4 * 6144 + 4096;
constexpr int MOE_MAXT = 136;
constexpr int MOE_ROWS = MOE_MAXT * 256;

constexpr size_t MiB = 1ull << 20;
constexpr size_t WS_CTL = 0;
constexpr size_t CTL_BYTES = 1 * MiB;
constexpr size_t WS_MOD = 1 * MiB;
constexpr size_t WS_LB = WS_MOD + 256 * 1024;
constexpr size_t WS_COS = 2 * MiB;
constexpr size_t WS_SIN = 4 * MiB;
constexpr size_t WS_SSO = 6 * MiB;
constexpr size_t WS_SSC = 14 * MiB;
constexpr size_t WS_SSQ = 15 * MiB;
constexpr size_t WS_TOK = 16 * MiB;
constexpr size_t WS_LIST = 17 * MiB;
constexpr size_t WS_W = 18 * MiB;
constexpr size_t W_IN = WS_W;
constexpr size_t W_OUT = W_IN + (size_t)8192 * 2048 * 2;
constexpr size_t W_GU = W_OUT + (size_t)2048 * 2048 * 2;
constexpr size_t W_DN = W_GU + (size_t)11264 * 2048 * 2;
constexpr size_t W_LAT = W_DN + (size_t)2048 * 5632 * 2;
constexpr size_t W_KVQ = W_LAT + (size_t)1280 * 2048 * 2;
constexpr size_t W_O = W_KVQ + (size_t)7168 * 512 * 2;
constexpr size_t W_MGU = W_O + (size_t)2048 * 2048 * 2;
constexpr size_t W_MDN = W_MGU + (size_t)8 * 11264 * 2048 * 2;
constexpr size_t W_END = W_MDN + (size_t)8 * 2048 * 5632 * 2;
constexpr size_t WS_U = (W_END + MiB - 1) / MiB * MiB;
constexpr size_t WS_XS = WS_U + (size_t)M * D * 2;
constexpr size_t WS_Y = WS_XS + (size_t)M * D * 2;
constexpr size_t WS_XR = WS_Y + (size_t)M * D * 2;
constexpr size_t WS_BIG = WS_Y + (size_t)M * D * 4;
constexpr size_t B_Q = WS_BIG;
constexpr size_t B_LF = B_Q + (size_t)M * D * 2;
constexpr size_t B_VI = B_LF + (size_t)M * D * 4;
constexpr size_t B_GS = B_VI + (size_t)M * D * 2;
constexpr size_t B_QH = B_GS + (size_t)M * D * 2;
constexpr size_t B_KT = B_QH + (size_t)M * D * 2;
constexpr size_t B_VT = B_KT + (size_t)M * D * 2;
constexpr size_t B_DEC = B_VT + (size_t)M * D * 2;
constexpr size_t B_OI = B_DEC + (size_t)4096 * 128 * 4;
constexpr size_t B_OG = B_Q;
constexpr size_t B_HG_END = B_OI + (size_t)M * D * 4;
constexpr size_t B_ACT = WS_BIG;
constexpr size_t B_CKV = WS_BIG;
constexpr size_t B_QLAT = B_CKV + (size_t)M * 512 * 2;
constexpr size_t B_KR = B_QLAT + (size_t)M * 512 * 2;
constexpr size_t B_KN = B_KR + (size_t)M * 64 * 2;
constexpr size_t B_V = B_KN + (size_t)M * D * 2;
constexpr size_t B_QN = B_V + (size_t)M * D * 2;
constexpr size_t B_QR = B_QN + (size_t)M * D * 2;
constexpr size_t B_O = B_QR + (size_t)M * 1024 * 2;
constexpr size_t B_MLA_END = B_O + (size_t)M * D * 2;
constexpr size_t B_ACT2 = WS_BIG;
constexpr size_t B_Y2 = B_ACT2 + (size_t)MOE_ROWS * DFF * 2;
constexpr size_t B_MOE_END = B_Y2 + (size_t)MOE_ROWS * D * 4;
constexpr size_t PART_WS_LAT = WS_BIG + 330 * MiB;
constexpr size_t PART_WS_MOE = WS_BIG + 190 * MiB;
static_assert(PART_WS_LAT >= B_MLA_END && PART_WS_MOE >= B_ACT2 + (size_t)MOE_ROWS * DFF && PART_WS_MOE + 64 * MiB <= B_Y2, "tail-split scratch overlaps a live buffer");
constexpr size_t WS_NEED = (B_HG_END > B_MOE_END ? (B_HG_END > B_MLA_END ? B_HG_END : B_MLA_END) : (B_MOE_END > B_MLA_END ? B_MOE_END : B_MLA_END));

constexpr int CW_BAR = 4096;
constexpr int CW_CNT = 16384;
constexpr int CW_PART = 32768;
constexpr int LDS_BYTES = 147456;
constexpr int MISC_OFF = 131072 + 8192;

typedef __bf16 bf16x2_t __attribute__((ext_vector_type(2)));
__device__ __forceinline__ unsigned cvt_pk_bf16(float lo, float hi) { const f32x2 v = {lo, hi}; return __builtin_bit_cast(unsigned, __builtin_convertvector(v, bf16x2_t)); }
__device__ __forceinline__ float bf2f(bf16_t v) { return __uint_as_float(((unsigned)v) << 16); }
__device__ __forceinline__ float bflo(unsigned w) { return __uint_as_float(w << 16); }
__device__ __forceinline__ float bfhi(unsigned w) { return __uint_as_float(w & 0xffff0000u); }
__device__ __forceinline__ bf16_t f2bf(float f) { return (bf16_t)(cvt_pk_bf16(f, 0.f) & 0xffffu); }
__device__ __forceinline__ float wave_sum(float v) {
#pragma unroll
    for (int o = 1; o < 64; o <<= 1) v += __shfl_xor(v, o);
    return v;
}
__device__ __forceinline__ float sigmoidf_(float x) { return __builtin_amdgcn_rcpf(1.0f + __builtin_amdgcn_exp2f(x * -1.4426950408889634f)); }
__device__ __forceinline__ float siluf_(float x) { return x * __builtin_amdgcn_rcpf(1.0f + __builtin_amdgcn_exp2f(x * -1.4426950408889634f)); }

#define XB_TMO      128
#define XB_XCNT(j)  (256  + 64 * (j))
#define XB_XSUB(j)  (1280 + 64 * (j))
#define XB_XGEN(j)  (2304 + 64 * (j))
#define XB_TOP      3328
#define XB_TOPGEN   3392
#define XCD_BAR_WORDS 3456
#define XB_SPIN_CAP (1u << 22)

__device__ __forceinline__ unsigned xb_ld(unsigned* p)              { return __hip_atomic_load(p, __ATOMIC_RELAXED, __HIP_MEMORY_SCOPE_AGENT); }
__device__ __forceinline__ unsigned xb_add(unsigned* p, unsigned v) { return __hip_atomic_fetch_add(p, v, __ATOMIC_RELAXED, __HIP_MEMORY_SCOPE_AGENT); }
__device__ __forceinline__ unsigned xb_xcc_id() { return (unsigned)__builtin_amdgcn_s_getreg((3 << 11) | 20) & 0xFu; }
#define XB_SPIN(cond, bar) do { unsigned _sp = 0; while (cond) { __builtin_amdgcn_s_sleep(1); \
    if ((++_sp & 255u) == 0u) { if (xb_ld(&(bar)[XB_TMO])) break; if (_sp > XB_SPIN_CAP) { atomicAdd(&(bar)[XB_TMO], 1u); break; } } } } while (0)

struct XcdBarrier { unsigned* bar; unsigned x; volatile LAS unsigned* st; };

__device__ __forceinline__ XcdBarrier xcd_barrier_post(unsigned* bar, volatile LAS unsigned* st) {
    XcdBarrier b; b.bar = bar; b.x = xb_xcc_id(); b.st = st;
    if (threadIdx.x == 0) (void)xb_add(&bar[XB_XCNT(b.x)], 1u);
    return b;
}
__device__ __forceinline__ void xcd_barrier_complete(unsigned* bar, unsigned x, unsigned& nloc, unsigned& nx) {
    const unsigned G = gridDim.x * gridDim.y * gridDim.z;
    unsigned sum, cnt, mine, sp = 0u;
    for (;;) {
        sum = 0u; cnt = 0u; mine = 0u;
#pragma unroll
        for (unsigned j = 0; j < 16; ++j) { const unsigned c = xb_ld(&bar[XB_XCNT(j)]); sum += c; cnt += (c > 0u) ? 1u : 0u; mine = (j == x) ? c : mine; }
        if (sum == G) break;
        __builtin_amdgcn_s_sleep(1);
        if ((++sp & 255u) == 0u) { if (xb_ld(&bar[XB_TMO])) break; if (sp > XB_SPIN_CAP) { atomicAdd(&bar[XB_TMO], 1u); break; } }
    }
    nloc = mine > 0u ? mine : 1u; nx = cnt > 0u ? cnt : 1u;
}
__device__ __forceinline__ void xcd_barrier(const XcdBarrier& b) {
    asm volatile("s_waitcnt vmcnt(0)" ::: "memory");
    __syncthreads();
    if (threadIdx.x == 0) {
        unsigned* bar = b.bar;
        __builtin_amdgcn_s_waitcnt(0);
        unsigned nloc = b.st[0], nx = b.st[1];
        if (nloc == 0u) { xcd_barrier_complete(bar, b.x, nloc, nx); b.st[0] = nloc; b.st[1] = nx; }
        const unsigned old = xb_add(&bar[XB_XSUB(b.x)], 1u);
        const unsigned gen = old / nloc;
        if (old + 1u == (gen + 1u) * nloc) {
            __builtin_amdgcn_fence(__ATOMIC_RELEASE, "agent");
            asm volatile("s_waitcnt vmcnt(0)" ::: "memory");
            const unsigned og = xb_add(&bar[XB_TOP], 1u);
            const unsigned tg = og / nx;
            if (og + 1u == (tg + 1u) * nx) xb_add(&bar[XB_TOPGEN], 1u);
            else XB_SPIN(xb_ld(&bar[XB_TOPGEN]) == tg, bar);
            __builtin_amdgcn_fence(__ATOMIC_ACQUIRE, "agent");
            xb_add(&bar[XB_XGEN(b.x)], 1u);
            asm volatile("s_waitcnt vmcnt(0)" ::: "memory");
        } else {
            XB_SPIN(xb_ld(&bar[XB_XGEN(b.x)]) == gen, bar);
            __builtin_amdgcn_fence(__ATOMIC_ACQUIRE, "agent");
            asm volatile("s_waitcnt vmcnt(0)" ::: "memory");
        }
    }
    __syncthreads();
}

namespace pg8 {
constexpr int BM = 256, BK = 64, HALF = 128, HTB = HALF * BK * 2, STAGE_BYTES = 8 * HTB, NXCD = 8, WGM = 8;
__device__ __forceinline__ int lds_byte(int r, int c) { const int st = (r >> 4) * 2 + (c >> 5), rr = r & 15, cc = c & 31, ob = rr * 64 + cc * 2; return st * 1024 + (ob ^ (((ob >> 9) & 1) << 5)); }
__device__ __forceinline__ void stage_rc(int b, int& R, int& C) { const int st = b / 1024, sb = b % 1024, swz = sb ^ (((sb >> 9) & 1) << 5); R = (st >> 1) * 16 + swz / 64; C = (st & 1) * 32 + (swz % 64) / 2; }
__device__ __forceinline__ int perm32(int rho) { const int n = rho >> 4, i = rho & 15; return 8 * (i >> 2) + 4 * n + (i & 3); }

struct Unit { const char* a; const char* b; int pm, pn, e, nv; int ktn, part, nparts, pslot; };
__device__ __forceinline__ bool split_next(int i, int G, int c, int T, int nt, int& L, int& kt0, Unit& u) {
    const int R = T / G, rem = T - R * G;
    u.ktn = nt; u.part = 0; u.nparts = 1; u.pslot = 0; kt0 = 0;
    if (i < R) { L = i * G + c; return true; }
    if (i > R || rem == 0) return false;
    const int s = (rem * 4 <= G && nt >= 32) ? 4 : (rem * 2 <= G && nt >= 16) ? 2 : 1;
    if (c >= rem * s) return false;
    const int j = c % rem, p = c / rem; L = R * G + j;
    if (s > 1) { const int base = (nt / s) & ~1, extra = (nt - base * s) >> 1;
        u.part = p; u.nparts = s; u.pslot = j; u.ktn = base + (p < extra ? 2 : 0); kt0 = p * base + 2 * (p < extra ? p : extra); }
    return true;
}

__device__ __forceinline__ void tile_of(int L, int nM, int nN, int& pm, int& pn) {
    const int nwg = nM * nN; int wgid = L;
    { const int q = nwg / NXCD, r = nwg % NXCD, xcd = wgid % NXCD, off = wgid / NXCD; wgid = (xcd < r ? xcd * (q + 1) : r * (q + 1) + (xcd - r) * q) + off; }
    const int nig = WGM * nN, gid = wgid / nig, fm = gid * WGM, gsz = (nM - fm) < WGM ? (nM - fm) : WGM;
    pm = fm + ((wgid % nig) % gsz); pn = (wgid % nig) / gsz;
}
struct DualOrder {
    static constexpr bool GATHER = false;
    const char *A1, *B1, *A2, *B2; int nM, nN1, nN2, K, G, c; bool tmA = false;
    bool split = false; float* part_ws = nullptr; unsigned* part_cnt = nullptr;
    __device__ __forceinline__ bool next(int i, Unit& u) const {
        const int nN = nN1 + nN2; int Ls, kt0 = 0;
        if (split) { if (!split_next(i, G, c, nM * nN, K / BK, Ls, kt0, u)) return false; }
        else { const long L = (long)i * G + c; if (L >= (long)nM * nN) return false; Ls = (int)L; }
        int pm, pn; tile_of(Ls, nM, nN, pm, pn);
        const size_t tstep = (size_t)BM * K * 2;
        if (pn < nN1) { u.e = 0; u.pn = pn; u.a = A1 + pm * tstep; u.b = B1 + pn * tstep; }
        else { u.e = 1; u.pn = pn - nN1; u.a = A2 + pm * tstep; u.b = B2 + (pn - nN1) * tstep; }
        u.a += (size_t)kt0 * (BK * 2); u.b += (size_t)kt0 * (BK * 2);
        u.pm = pm; u.nv = 256; return true;
    }
    __device__ __forceinline__ const int* rows(const Unit&) const { return nullptr; }
};
template <bool GATHER_> struct MoeOrder {
    static constexpr bool GATHER = GATHER_;
    static constexpr bool tmA = false;
    const char* A; const char* W; size_t wstride; const int* list; int nT, nN, rb  , G, c; int tstart[NEXP + 1]; int cnt[NEXP];
    bool split = false; float* part_ws = nullptr; unsigned* part_cnt = nullptr;
    __device__ __forceinline__ void init(const unsigned* ctl) {
        int t = 0;
#pragma unroll
        for (int e = 0; e < NEXP; ++e) { const int n = (int)ctl[CW_CNT + 64 * e]; cnt[e] = n; tstart[e] = t; t += (n + 255) >> 8; }
        tstart[NEXP] = t; nT = t;
    }
    __device__ __forceinline__ bool next(int i, Unit& u) const {
        int Ls, kt0 = 0;
        if (split) { if (!split_next(i, G, c, nT * nN, rb / (BK * 2), Ls, kt0, u)) return false; }
        else { const long L = (long)i * G + c; if (L >= (long)nT * nN) return false; Ls = (int)L; }
        int pm, pn; tile_of(Ls, nT, nN, pm, pn);
        int e = 0;
#pragma unroll
        for (int j = 1; j < NEXP; ++j) e += (pm >= tstart[j]) ? 1 : 0;
        int ce = 0, ts = 0;
#pragma unroll
        for (int j = 0; j < NEXP; ++j) { ce = (j == e) ? cnt[j] : ce; ts = (j == e) ? tstart[j] : ts; }
        u.e = e; u.pm = pm; u.pn = pn; const int left = ce - (pm - ts) * 256; u.nv = left < 256 ? left : 256;
        u.a = GATHER ? A : A + (size_t)pm * BM * rb; u.b = W + (size_t)e * wstride + (size_t)pn * BM * rb;
        u.a += (size_t)kt0 * (BK * 2); u.b += (size_t)kt0 * (BK * 2);
        return true;
    }
    __device__ __forceinline__ const int* rows(const Unit& u) const { int ts = 0;
#pragma unroll
        for (int j = 0; j < NEXP; ++j) ts = (j == u.e) ? tstart[j] : ts;
        return list + (size_t)u.e * M + (u.pm - ts) * 256; }
};

typedef int i32x4 __attribute__((ext_vector_type(4)));
typedef int i32x8 __attribute__((ext_vector_type(8)));
constexpr float W8_SCALE = 128.0f; constexpr int W8_EXP = 0x78787878, ONE_EXP = 0x7f7f7f7f;
template <class Epi, class Sched, bool FP8 = false, bool SPLIT = false>
__device__ __forceinline__ void gemm_phase(LAS unsigned char* lds, const int Kel, const Sched& S, const Epi& E) {
    const int K = FP8 ? Kel / 2 : Kel;
    const int tid = threadIdx.x, wid = __builtin_amdgcn_readfirstlane(tid >> 6), lane = tid & 63, wr = wid >> 2, wc = wid & 3, fr = lane & 15, fq = lane >> 4;
    const int nt = K / BK;
    unsigned vA[2][2], vB[2]; int Rr[2], Cc[2];
#pragma unroll
    for (int i = 0; i < 2; ++i) { int R, C; stage_rc(tid * 16 + i * 8192, R, C); Rr[i] = R; Cc[i] = C; const int Rb = Epi::PERM ? ((R & ~31) + perm32(R & 31)) : R;
        vB[i] = (unsigned)(Rb * K + C) * 2u; }
    const size_t kstep = (size_t)(BK * 2), kstepA = S.tmA ? (size_t)8192 : kstep;
    const size_t hstep = (size_t)HALF * K * 2;
    const unsigned ldsw = (unsigned)wid * 1024u;
    const int aoff = lds_byte(wr * 64 + fr, fq * 8), boff = lds_byte(wc * 32 + fr, fq * 8);
#define PG8_SA(b, h) (((b) * 2 + (h)) * HTB)
#define PG8_SB(b, h) ((4 + (b) * 2 + (h)) * HTB)
#define PG8_STAGE2(bufoff, gbase, v0, v1) do { \
        __builtin_amdgcn_global_load_lds((const unsigned*)((const char*)(gbase) + (v0)), (LAS unsigned*)(lds + (bufoff) + ldsw), 16, 0, 0); \
        __builtin_amdgcn_global_load_lds((const unsigned*)((const char*)(gbase) + (v1)), (LAS unsigned*)(lds + (bufoff) + ldsw + 8192), 16, 0, 0); } while (0)
#define PG8_STAGEB(bufoff, gbase) PG8_STAGE2(bufoff, gbase, vB[0], vB[1])
#define PG8_LD8(p) __builtin_shufflevector(*(const LAS i32x4*)(p), *(const LAS i32x4*)((p) + 1024), 0, 1, 2, 3, 4, 5, 6, 7)
#define PG8_LDA(dst, b, h) do { if constexpr (FP8) { _Pragma("unroll") for (int m = 0; m < 4; ++m) dst##8[m] = PG8_LD8(lds + PG8_SA(b, h) + aoff + m * 2048); } \
        else { _Pragma("unroll") for (int m = 0; m < 4; ++m) _Pragma("unroll") for (int k = 0; k < 2; ++k) dst[m][k] = *(const LAS bf16x8*)(lds + PG8_SA(b, h) + aoff + m * 2048 + k * 1024); } } while (0)
#define PG8_LDB(dst, b, h) do { if constexpr (FP8) { _Pragma("unroll") for (int n = 0; n < 2; ++n) dst##8[n] = PG8_LD8(lds + PG8_SB(b, h) + boff + n * 2048); } \
        else { _Pragma("unroll") for (int n = 0; n < 2; ++n) _Pragma("unroll") for (int k = 0; k < 2; ++k) dst[n][k] = *(const LAS bf16x8*)(lds + PG8_SB(b, h) + boff + n * 2048 + k * 1024); } } while (0)
#define PG8_MMA(ai, bj, At, Bt) do { __builtin_amdgcn_s_setprio(1); _Pragma("unroll") for (int m = 0; m < 4; ++m) _Pragma("unroll") for (int n = 0; n < 2; ++n) { \
        if constexpr (FP8) asm volatile("v_mfma_scale_f32_16x16x128_f8f6f4 %0, %1, %2, %0, %3, %4 op_sel_hi:[0,0,0]" : "+v"(acc[ai][bj][m][n]) : "v"(Bt##8[n]), "v"(At##8[m]), "v"(sc_w8), "v"(sc_one)); \
        else { _Pragma("unroll") for (int k = 0; k < 2; ++k) acc[ai][bj][m][n] = __builtin_amdgcn_mfma_f32_16x16x32_bf16(Bt[n][k], At[m][k], acc[ai][bj][m][n], 0, 0, 0); } } \
        __builtin_amdgcn_s_setprio(0); } while (0)
#define PG8_WAIT_V(n) asm volatile("s_waitcnt vmcnt(" #n ")" ::: "memory")
#define PG8_WAIT_L(n) asm volatile("s_waitcnt lgkmcnt(" #n ")" ::: "memory")
#define PG8_BAR __builtin_amdgcn_s_barrier()
#define PG8_SCHED __builtin_amdgcn_sched_barrier(0)
    Unit cur, nxt; int ui = 0;
    if (!S.next(0, cur)) return;
    if constexpr (Sched::GATHER) { const int* rl = S.rows(cur);
#pragma unroll
        for (int h = 0; h < 2; ++h)
#pragma unroll
            for (int i = 0; i < 2; ++i) { const int j = Rr[i] + 128 * h; const int tok = (j < cur.nv) ? rl[j] : 0; vA[h][i] = (unsigned)(tok * K + Cc[i]) * 2u; } }
    else {
#pragma unroll
        for (int h = 0; h < 2; ++h)
#pragma unroll
            for (int i = 0; i < 2; ++i) { const int row = Rr[i] + 128 * h; vA[h][i] = S.tmA ? (unsigned)((row >> 6) * 262144 + (Cc[i] >> 4) * 2048 + (row & 63) * 32 + (Cc[i] & 15) * 2) : (unsigned)(row * K + Cc[i]) * 2u; } }
    LAS unsigned char* idx_lds = lds + STAGE_BYTES + wid * 1024;
    f32x4 acc[2][2][4][2];
#pragma unroll
    for (int a = 0; a < 2; ++a)
#pragma unroll
        for (int b = 0; b < 2; ++b)
#pragma unroll
            for (int m = 0; m < 4; ++m)
#pragma unroll
                for (int n = 0; n < 2; ++n) acc[a][b][m][n] = (f32x4){0.f, 0.f, 0.f, 0.f};
    bf16x8 At[4][2], B0[2][2], B1[2][2]; i32x8 At8[4], B08[2], B18[2];
    int sc_w8 = W8_EXP, sc_one = ONE_EXP; asm volatile("" : "+v"(sc_w8), "+v"(sc_one));
    const char* cA = cur.a; const char* cB = cur.b;
    PG8_STAGEB(PG8_SB(0, 0), cB); PG8_STAGEB(PG8_SB(0, 1), cB + hstep); PG8_STAGE2(PG8_SA(0, 0), cA, vA[0][0], vA[0][1]); PG8_STAGE2(PG8_SA(0, 1), cA, vA[1][0], vA[1][1]);
    if (wr == 1) PG8_BAR;
    PG8_WAIT_V(2); PG8_BAR;
    PG8_STAGEB(PG8_SB(1, 0), cB + kstep); PG8_STAGE2(PG8_SA(1, 0), cA + kstepA, vA[0][0], vA[0][1]); PG8_STAGEB(PG8_SB(1, 1), cB + hstep + kstep);
    PG8_WAIT_V(6); PG8_BAR;
    for (;;) {
        const bool has_next = S.next(ui + 1, nxt);
        const char* nA = has_next ? nxt.a : cA; const char* nB = has_next ? nxt.b : cB;
        const int ntc = SPLIT ? cur.ktn : nt;
        for (int t = 0; t < ntc; t += 2) {
            const bool last = (t == ntc - 2);
            if constexpr (Sched::GATHER) { if (t == ntc - 6 && has_next) { const int* rl = S.rows(nxt);
#pragma unroll
                for (int h = 0; h < 2; ++h)
#pragma unroll
                    for (int i = 0; i < 2; ++i) __builtin_amdgcn_global_load_lds((const unsigned*)(rl + Rr[i] + 128 * h), (LAS unsigned*)(idx_lds + (h * 2 + i) * 256), 4, 0, 0); } }
            const char* a1 = cA + (size_t)(t + 1) * kstepA;
            const char* a2 = last ? nA : cA + (size_t)(t + 2) * kstepA; const char* b2 = last ? nB : cB + (size_t)(t + 2) * kstep;
            const char* a3 = a2 + kstepA; const char* b3 = b2 + kstep;
            PG8_LDB(B0, 0, 0); PG8_LDB(B1, 0, 1); PG8_SCHED; PG8_LDA(At, 0, 0); PG8_STAGE2(PG8_SA(1, 1), a1, vA[1][0], vA[1][1]);
            if constexpr (Sched::GATHER) { if (last && has_next) {
#pragma unroll
                for (int h = 0; h < 2; ++h)
#pragma unroll
                    for (int i = 0; i < 2; ++i) { const int j = Rr[i] + 128 * h; const int tok = *(const LAS int*)(idx_lds + (h * 2 + i) * 256 + lane * 4); vA[h][i] = (unsigned)(((j < nxt.nv) ? tok : 0) * K + Cc[i]) * 2u; } } }
            PG8_WAIT_V(8); PG8_WAIT_L(0); PG8_BAR; PG8_MMA(0, 0, At, B0); PG8_MMA(0, 1, At, B1); PG8_BAR; PG8_SCHED;
            PG8_LDA(At, 0, 1); PG8_STAGEB(PG8_SB(0, 0), b2); PG8_STAGEB(PG8_SB(0, 1), b2 + hstep); PG8_STAGE2(PG8_SA(0, 0), a2, vA[0][0], vA[0][1]);
            PG8_WAIT_V(8); PG8_WAIT_L(0); PG8_BAR; PG8_MMA(1, 0, At, B0); PG8_MMA(1, 1, At, B1); PG8_BAR; PG8_SCHED;
            PG8_LDB(B0, 1, 0); PG8_LDB(B1, 1, 1); PG8_SCHED; PG8_LDA(At, 1, 0); PG8_STAGE2(PG8_SA(0, 1), a2, vA[1][0], vA[1][1]);
            PG8_WAIT_V(8); PG8_WAIT_L(0); PG8_BAR; PG8_MMA(0, 0, At, B0); PG8_MMA(0, 1, At, B1); PG8_BAR; PG8_SCHED;
            PG8_LDA(At, 1, 1); PG8_STAGEB(PG8_SB(1, 0), b3); PG8_STAGEB(PG8_SB(1, 1), b3 + hstep); PG8_STAGE2(PG8_SA(1, 0), a3, vA[0][0], vA[0][1]);
            PG8_WAIT_V(8); PG8_WAIT_L(0); PG8_BAR; PG8_MMA(1, 0, At, B0); PG8_MMA(1, 1, At, B1); PG8_BAR; PG8_SCHED;
        }
        if (wr == 0) PG8_BAR;
        if constexpr (FP8) asm volatile("s_nop 15\n\ts_nop 15" ::: "memory");
        bool doE = true;
        if constexpr (SPLIT) { if (cur.nparts > 1) {
            f32x4* ps = (f32x4*)S.part_ws + (size_t)cur.pslot * 4 * 16384 + tid;
#pragma unroll
            for (int a = 0; a < 2; ++a)
#pragma unroll
                for (int b = 0; b < 2; ++b)
#pragma unroll
                    for (int m = 0; m < 4; ++m)
#pragma unroll
                        for (int n = 0; n < 2; ++n) ps[(size_t)cur.part * 16384 + (((a * 2 + b) * 4 + m) * 2 + n) * 512] = acc[a][b][m][n];
            asm volatile("s_waitcnt vmcnt(0)" ::: "memory"); __syncthreads();
            LAS unsigned* flag = (LAS unsigned*)(lds + STAGE_BYTES);
            if (tid == 0) { const unsigned old = __hip_atomic_fetch_add(S.part_cnt + 16 * cur.pslot, 1u, __ATOMIC_ACQ_REL, __HIP_MEMORY_SCOPE_AGENT); *flag = old; }
            __syncthreads();
            doE = (*flag == (unsigned)(cur.nparts - 1));
            if (doE) {
                for (int p = 0; p < cur.nparts; ++p) {
#pragma unroll
                    for (int a = 0; a < 2; ++a)
#pragma unroll
                        for (int b = 0; b < 2; ++b) { f32x4 v[4][2];
#pragma unroll
                            for (int m = 0; m < 4; ++m)
#pragma unroll
                                for (int n = 0; n < 2; ++n) v[m][n] = ps[(size_t)p * 16384 + (((a * 2 + b) * 4 + m) * 2 + n) * 512];
                            asm volatile("" ::: "memory");
#pragma unroll
                            for (int m = 0; m < 4; ++m)
#pragma unroll
                                for (int n = 0; n < 2; ++n) acc[a][b][m][n] = (p == 0) ? v[m][n] : acc[a][b][m][n] + v[m][n];
                            asm volatile("" ::: "memory"); } } } } }
        if (doE) E(acc, cur, wr, wc, fr, fq);
        if (!has_next) break;
#pragma unroll
        for (int a = 0; a < 2; ++a)
#pragma unroll
            for (int b = 0; b < 2; ++b)
#pragma unroll
                for (int m = 0; m < 4; ++m)
#pragma unroll
                    for (int n = 0; n < 2; ++n) acc[a][b][m][n] = (f32x4){0.f, 0.f, 0.f, 0.f};
        cur = nxt; cA = nA; cB = nB; ++ui;
        if (wr == 1) PG8_BAR;
    }
    PG8_WAIT_V(0);
    PG8_BAR;
#undef PG8_SA
#undef PG8_SB
#undef PG8_STAGE2
#undef PG8_STAGEB
#undef PG8_LDA
#undef PG8_LD8
#undef PG8_LDB
#undef PG8_MMA
#undef PG8_WAIT_V
#undef PG8_WAIT_L
#undef PG8_BAR
#undef PG8_SCHED
}
}
using pg8::Unit;

__device__ __forceinline__ size_t tm_off(int m, int ch) { return ((((size_t)(m >> 6) * 128 + (ch >> 4)) * 64 + (m & 63)) * 16 + (ch & 15)); }
typedef f32x4 Acc[2][2][4][2];
__device__ __forceinline__ u32x4 pack8(f32x4 a, f32x4 b) { return (u32x4){cvt_pk_bf16(a[0], a[1]), cvt_pk_bf16(a[2], a[3]), cvt_pk_bf16(b[0], b[1]), cvt_pk_bf16(b[2], b[3])}; }

__device__ __forceinline__ u32x2 pack8_fp8(f32x4 a, f32x4 b) { int w0 = 0, w1 = 0;
    w0 = __builtin_amdgcn_cvt_pk_fp8_f32(a[0], a[1], w0, false); w0 = __builtin_amdgcn_cvt_pk_fp8_f32(a[2], a[3], w0, true);
    w1 = __builtin_amdgcn_cvt_pk_fp8_f32(b[0], b[1], w1, false); w1 = __builtin_amdgcn_cvt_pk_fp8_f32(b[2], b[3], w1, true); return (u32x2){(unsigned)w0, (unsigned)w1}; }
struct EpiHgIn {
    static constexpr bool PERM = true;
    bf16_t* Q; float* LF; bf16_t* VI; bf16_t* GS; const float* lb; const float* gn;
    __device__ __forceinline__ void operator()(const Acc& acc, const Unit& u, int wr, int wc, int fr, int fq) const {
        const int type = u.pn >> 3, row0 = u.pm * 256 + wr * 64 + fr, col0 = (u.pn & 7) * 256 + wc * 32 + 8 * fq;
        if (type == 0 || type == 2) { bf16_t* O = type == 0 ? Q : VI;
#pragma unroll
            for (int ai = 0; ai < 2; ++ai)
#pragma unroll
                for (int m = 0; m < 4; ++m) { bf16_t* rowp = O + (size_t)(row0 + ai * 128 + m * 16) * D + col0;
#pragma unroll
                    for (int bj = 0; bj < 2; ++bj) *(u32x4*)(rowp + bj * 128) = pack8(acc[ai][bj][m][0], acc[ai][bj][m][1]); }
        } else if (type == 1) {
#pragma unroll
            for (int bj = 0; bj < 2; ++bj) { const f32x4 l0 = *(const f32x4*)(lb + col0 + bj * 128), l1 = *(const f32x4*)(lb + col0 + bj * 128 + 4);
#pragma unroll
                for (int ai = 0; ai < 2; ++ai)
#pragma unroll
                    for (int m = 0; m < 4; ++m) { _Float16* rowp = (_Float16*)LF + (size_t)(row0 + ai * 128 + m * 16) * D + col0 + bj * 128; f32x4 o0, o1;
#pragma unroll
                        for (int j = 0; j < 4; ++j) { o0[j] = __builtin_amdgcn_logf(1.f - (1.f - l0[j]) * sigmoidf_(-acc[ai][bj][m][0][j])) * 0.6931471805599453f; o1[j] = __builtin_amdgcn_logf(1.f - (1.f - l1[j]) * sigmoidf_(-acc[ai][bj][m][1][j])) * 0.6931471805599453f; }
                        typedef _Float16 h8 __attribute__((ext_vector_type(8)));
                        *(h8*)rowp = (h8){(_Float16)o0[0], (_Float16)o0[1], (_Float16)o0[2], (_Float16)o0[3], (_Float16)o1[0], (_Float16)o1[1], (_Float16)o1[2], (_Float16)o1[3]}; } }
        } else {
#pragma unroll
            for (int bj = 0; bj < 2; ++bj) { const f32x4 g0 = *(const f32x4*)(gn + col0 + bj * 128), g1 = *(const f32x4*)(gn + col0 + bj * 128 + 4);
#pragma unroll
                for (int ai = 0; ai < 2; ++ai)
#pragma unroll
                    for (int m = 0; m < 4; ++m) { bf16_t* rowp = GS + tm_off(row0 + ai * 128 + m * 16, col0 + bj * 128); f32x4 o0, o1;
#pragma unroll
                        for (int j = 0; j < 4; ++j) { o0[j] = siluf_(acc[ai][bj][m][0][j]) * g0[j]; o1[j] = siluf_(acc[ai][bj][m][1][j]) * g1[j]; }
                        *(u32x4*)rowp = pack8(o0, o1); } }
        }
    }
};
struct EpiNull {
    static constexpr bool PERM = false;
    __device__ __forceinline__ void operator()(const Acc& acc, const Unit& u, int wr, int wc, int fr, int fq) const {
#pragma unroll
        for (int ai = 0; ai < 2; ++ai)
#pragma unroll
            for (int bj = 0; bj < 2; ++bj)
#pragma unroll
                for (int m = 0; m < 4; ++m)
#pragma unroll
                    for (int n = 0; n < 2; ++n) asm volatile("" :: "v"(acc[ai][bj][m][n]));
    }
};
struct EpiF32 {
    static constexpr bool PERM = false;
    float* C; int ldc;
    __device__ __forceinline__ void operator()(const Acc& acc, const Unit& u, int wr, int wc, int fr, int fq) const {
        const int row0 = u.pm * 256 + wr * 64 + fr, col0 = u.pn * 256 + wc * 32 + 4 * fq;
#pragma unroll
        for (int ai = 0; ai < 2; ++ai)
#pragma unroll
            for (int m = 0; m < 4; ++m) { float* rowp = C + (size_t)(row0 + ai * 128 + m * 16) * ldc + col0;
#pragma unroll
                for (int bj = 0; bj < 2; ++bj)
#pragma unroll
                    for (int n = 0; n < 2; ++n) *(f32x4*)(rowp + bj * 128 + n * 16) = acc[ai][bj][m][n]; }
    }
};
struct EpiBf16 {
    static constexpr bool PERM = true;
    bf16_t* C; int ldc;
    __device__ __forceinline__ void operator()(const Acc& acc, const Unit& u, int wr, int wc, int fr, int fq) const {
        const int row0 = u.pm * 256 + wr * 64 + fr, col0 = u.pn * 256 + wc * 32 + 8 * fq;
#pragma unroll
        for (int ai = 0; ai < 2; ++ai)
#pragma unroll
            for (int m = 0; m < 4; ++m) { bf16_t* rowp = C + (size_t)(row0 + ai * 128 + m * 16) * ldc + col0;
#pragma unroll
                for (int bj = 0; bj < 2; ++bj) *(u32x4*)(rowp + bj * 128) = pack8(acc[ai][bj][m][0], acc[ai][bj][m][1]); }
    }
};
struct EpiGU {
    static constexpr bool PERM = true;
    bf16_t* ACT;
    __device__ __forceinline__ void operator()(const Acc& acc, const Unit& u, int wr, int wc, int fr, int fq) const {
        const int row0 = u.pm * 256 + wr * 64 + fr, col0 = u.pn * 128 + wc * 32 + 8 * fq;
#pragma unroll
        for (int ai = 0; ai < 2; ++ai)
#pragma unroll
            for (int m = 0; m < 4; ++m) { f32x4 o0, o1;
#pragma unroll
                for (int j = 0; j < 4; ++j) { o0[j] = siluf_(acc[ai][0][m][0][j]) * acc[ai][1][m][0][j]; o1[j] = siluf_(acc[ai][0][m][1][j]) * acc[ai][1][m][1][j]; }
                *(u32x4*)(ACT + (size_t)(row0 + ai * 128 + m * 16) * DFF + col0) = pack8(o0, o1); }
    }
};
struct EpiGU8 {
    static constexpr bool PERM = true;
    unsigned char* ACT;
    __device__ __forceinline__ void operator()(const Acc& acc, const Unit& u, int wr, int wc, int fr, int fq) const {
        const int row0 = u.pm * 256 + wr * 64 + fr, col0 = u.pn * 128 + wc * 32 + 8 * fq;
#pragma unroll
        for (int ai = 0; ai < 2; ++ai)
#pragma unroll
            for (int m = 0; m < 4; ++m) { f32x4 o0, o1;
#pragma unroll
                for (int j = 0; j < 4; ++j) { o0[j] = __builtin_amdgcn_fmed3f(siluf_(acc[ai][0][m][0][j]) * acc[ai][1][m][0][j], -448.f, 448.f); o1[j] = __builtin_amdgcn_fmed3f(siluf_(acc[ai][0][m][1][j]) * acc[ai][1][m][1][j], -448.f, 448.f); }
                *(u32x2*)(ACT + (size_t)(row0 + ai * 128 + m * 16) * DFF + col0) = pack8_fp8(o0, o1); }
    }
};
struct EpiLat {
    static constexpr bool PERM = true;
    bf16_t* CKV; bf16_t* QLAT; bf16_t* KR; float* SSC; float* SSQ; const float* COS; const float* SIN;
    __device__ __forceinline__ void operator()(const Acc& acc, const Unit& u, int wr, int wc, int fr, int fq) const {
        const int row0 = u.pm * 256 + wr * 64 + fr;
        if (u.e == 0 && u.pn == 2) {
            if (wc < 2) { const int j = 16 * wc + 4 * fq;
#pragma unroll
                for (int ai = 0; ai < 2; ++ai)
#pragma unroll
                    for (int m = 0; m < 4; ++m) { const int r = row0 + ai * 128 + m * 16; const f32x4 c = *(const f32x4*)(COS + (size_t)r * 32 + j), s = *(const f32x4*)(SIN + (size_t)r * 32 + j);
                        const f32x4 x1 = acc[ai][0][m][0], x2 = acc[ai][0][m][1]; const f32x4 o1 = x1 * c - x2 * s, o2 = x2 * c + x1 * s;
                        *(u32x2*)(KR + (size_t)r * 64 + j) = (u32x2){cvt_pk_bf16(o1[0], o1[1]), cvt_pk_bf16(o1[2], o1[3])};
                        *(u32x2*)(KR + (size_t)r * 64 + 32 + j) = (u32x2){cvt_pk_bf16(o2[0], o2[1]), cvt_pk_bf16(o2[2], o2[3])}; } }
            return;
        }
        bf16_t* O = u.e == 0 ? CKV : QLAT; float* SS = u.e == 0 ? SSC : SSQ;
        const int col0 = u.pn * 256 + wc * 32 + 8 * fq;
#pragma unroll
        for (int ai = 0; ai < 2; ++ai)
#pragma unroll
            for (int m = 0; m < 4; ++m) { const int r = row0 + ai * 128 + m * 16; float s = 0.f;
#pragma unroll
                for (int bj = 0; bj < 2; ++bj) { const f32x4 a = acc[ai][bj][m][0], b = acc[ai][bj][m][1];
                    s += (a[0] * a[0] + a[1] * a[1]) + (a[2] * a[2] + a[3] * a[3]) + (b[0] * b[0] + b[1] * b[1]) + (b[2] * b[2] + b[3] * b[3]);
                    *(u32x4*)(O + (size_t)r * 512 + col0 + bj * 128) = pack8(a, b); }
                s += __shfl_xor(s, 16); s += __shfl_xor(s, 32);
                if (fq == 0) SS[(size_t)r * 8 + u.pn * 4 + wc] = s; }
    }
};
struct EpiKvQ {
    static constexpr bool PERM = true;
    bf16_t* KN; bf16_t* V; bf16_t* QN; bf16_t* QR; const float* SSC; const float* SSQ; const float* COS; const float* SIN;
    __device__ __forceinline__ void operator()(const Acc& acc, const Unit& u, int wr, int wc, int fr, int fq) const {
        const int row0 = u.pm * 256 + wr * 64 + fr; const float* SS = u.e == 0 ? SSC : SSQ;
#pragma unroll
        for (int ai = 0; ai < 2; ++ai)
#pragma unroll
            for (int m = 0; m < 4; ++m) { const int r = row0 + ai * 128 + m * 16, b = r >> 13, s = r & (SEQ - 1);
                const f32x4 p0 = *(const f32x4*)(SS + (size_t)r * 8), p1 = *(const f32x4*)(SS + (size_t)r * 8 + 4);
                const float rstd = rsqrtf(((p0[0] + p0[1]) + (p0[2] + p0[3]) + (p1[0] + p1[1]) + (p1[2] + p1[3])) * (1.0f / 512.0f) + EPS);
                if (u.e == 0) { const size_t o = ((size_t)(b * MLA_H + u.pn) * SEQ + s) * 128 + wc * 32 + 8 * fq;
                    *(u32x4*)(KN + o) = pack8(acc[ai][0][m][0] * rstd, acc[ai][0][m][1] * rstd); *(u32x4*)(V + o) = pack8(acc[ai][1][m][0] * rstd, acc[ai][1][m][1] * rstd); }
                else if (u.pn < 8) {
#pragma unroll
                    for (int bj = 0; bj < 2; ++bj) { const size_t o = ((size_t)(b * MLA_H + 2 * u.pn + bj) * SEQ + s) * 128 + wc * 32 + 8 * fq;
                        *(u32x4*)(QN + o) = pack8(acc[ai][bj][m][0] * rstd, acc[ai][bj][m][1] * rstd); } }
                else { const int j = 16 * (wc & 1) + 4 * fq; const f32x4 c = *(const f32x4*)(COS + (size_t)r * 32 + j), sn = *(const f32x4*)(SIN + (size_t)r * 32 + j);
#pragma unroll
                    for (int bj = 0; bj < 2; ++bj) { const int head = 4 * (u.pn - 8) + 2 * bj + (wc >> 1); const size_t o = ((size_t)(b * MLA_H + head) * SEQ + s) * 64 + j;
                        const f32x4 x1 = acc[ai][bj][m][0] * rstd, x2 = acc[ai][bj][m][1] * rstd; const f32x4 o1 = x1 * c - x2 * sn, o2 = x2 * c + x1 * sn;
                        *(u32x2*)(QR + o) = (u32x2){cvt_pk_bf16(o1[0], o1[1]), cvt_pk_bf16(o1[2], o1[3])};
                        *(u32x2*)(QR + o + 32) = (u32x2){cvt_pk_bf16(o2[0], o2[1]), cvt_pk_bf16(o2[2], o2[3])}; } }
            }
    }
};

struct Args { const void* in[25]; float* out; unsigned char* ws; int ph_lo, ph_hi; };
enum { I_X = 0, I_C, I_POS, I_ADAW, I_ADAB, I_NORMG, I_HGWIN, I_HGLB, I_HGONG, I_HGWOUT, I_KVNG, I_KVADAW, I_KVADAB, I_WKVA, I_KVNORMG, I_WKVB, I_WQA, I_QNORMG, I_WQB, I_WO,
       I_FGU, I_FDN, I_ROUTER, I_MGU, I_MDN };
struct Frame { LAS unsigned char* lds; int tid, lane, wave, G, bid; const Args* a; unsigned char* ws; unsigned* ctl; bool probe_rep; };
#define INF(k) ((const float*)F.a->in[k])

__device__ __forceinline__ const float* modp(const Frame& F, int which, int part, int b) { return (const float*)(F.ws + WS_MOD) + (size_t)b * NMOD + (which < 4 ? which * 6144 : 24576) + part * 2048; }
__device__ __forceinline__ const float* normg(const Frame& F, int layer, int sub, int which) { return INF(I_NORMG) + ((layer * 2 + sub) * 2 + which) * 2048; }

__device__ __forceinline__ void p_mod(const Frame& F) {
    LAS float* scv = (LAS float*)F.lds;
    LAS float* red = (LAS float*)(F.lds + 16384);
    for (int it = F.bid; it < 224; it += F.G) {
        __syncthreads();
        for (int i = F.tid; i < 2 * D; i += 512) scv[i] = siluf_(INF(I_C)[i]);
        __syncthreads();
        const float* W; const float* bias; int N, col0, obase;
        if (it < 192) { const int mi = it / 48; W = INF(I_ADAW) + (size_t)mi * D * 6144; bias = INF(I_ADAB) + mi * 6144; N = 6144; col0 = (it % 48) * 128; obase = mi * 6144; }
        else { W = INF(I_KVADAW); bias = INF(I_KVADAB); N = 4096; col0 = (it - 192) * 128; obase = 24576; }
        const int half = F.lane >> 5, cq = F.lane & 31;
        const float* wp = W + (size_t)(256 * F.wave + half) * N + col0 + 4 * cq;
        f32x4 a0 = {0.f, 0.f, 0.f, 0.f}, a1 = a0;
#pragma unroll 16
        for (int i = 0; i < 128; ++i) { const f32x4 v = *(const f32x4*)(wp + (size_t)(2 * i) * N); const int k = 256 * F.wave + 2 * i + half; a0 += v * scv[k]; a1 += v * scv[D + k]; }
        const int slot = F.wave * 2 + half;
        *(LAS f32x4*)(red + (slot * 2 + 0) * 128 + 4 * cq) = a0; *(LAS f32x4*)(red + (slot * 2 + 1) * 128 + 4 * cq) = a1;
        __syncthreads();
        if (F.tid < 256) { const int b = F.tid >> 7, col = F.tid & 127; float s = bias[col0 + col];
#pragma unroll
            for (int p = 0; p < 16; ++p) s += red[(p * 2 + b) * 128 + col];
            ((float*)(F.ws + WS_MOD))[(size_t)b * NMOD + obase + col0 + col] = s; }
    }
    const int gtid = F.bid * 512 + F.tid, gn = F.G * 512;
    for (int i = gtid; i < D; i += gn) { const float l0 = INF(I_HGLB)[i], l1 = INF(I_HGLB)[D + i]; ((float*)(F.ws + WS_LB))[i] = 1.0f / (1.0f + expf(l1 - l0)); }
    for (int p = gtid; p < M * 32; p += gn) { const int m = p >> 5, j = p & 31; const float pos = (float)((const int*)F.a->in[I_POS])[m];
        const float inv = 1.0f / powf(10000.0f, (float)(2 * j) / 64.0f); const float ang = pos * inv; float s_, c_; sincosf(ang, &s_, &c_);
        ((float*)(F.ws + WS_COS))[p] = c_; ((float*)(F.ws + WS_SIN))[p] = s_; }
}

__device__ __forceinline__ int rope_dest(int p) { return 32 * ((p >> 4) & 1) + 8 * ((p >> 2) & 3) + 4 * (p >> 5) + (p & 3); }
__device__ __forceinline__ int dest_row(int kind, int c) {
    if (kind == 0) return c;
    if (kind == 1) { const int b = c >= DFF ? 1 : 0, j = c - b * DFF; return (j >> 7) * 256 + b * 128 + (j & 127); }
    if (kind == 2) return c < 512 ? c : 512 + rope_dest(c - 512);
    const int h = c / 192, j = c - h * 192; return j < 128 ? h * 128 + j : 2048 + h * 64 + rope_dest(j - 128);
}
__device__ __forceinline__ void conv_item(const float* W, int K, int N, bf16_t* WT, int kind, const float* gsc, LAS float* scr, int item, int lane) {
    const int nblk = N / 32, kb = item / nblk, nb = item % nblk, k0 = 64 * kb, n0 = 32 * nb;
#pragma unroll 8
    for (int i = 0; i < 32; ++i) { const int kk = 2 * i + (lane >> 5); float v = W[(size_t)(k0 + kk) * N + n0 + (lane & 31)]; if (gsc) v *= gsc[k0 + kk]; scr[kk * 33 + (lane & 31)] = v; }
    asm volatile("s_waitcnt lgkmcnt(0)" ::: "memory");
    const int c = lane & 7;
#pragma unroll
    for (int j = 0; j < 4; ++j) { const int n = (lane >> 3) + 8 * j; const LAS float* s = scr + (8 * c) * 33 + n;
        u32x4 o; o.x = cvt_pk_bf16(s[0 * 33], s[1 * 33]); o.y = cvt_pk_bf16(s[2 * 33], s[3 * 33]); o.z = cvt_pk_bf16(s[4 * 33], s[5 * 33]); o.w = cvt_pk_bf16(s[6 * 33], s[7 * 33]);
        *(u32x4*)(WT + (size_t)dest_row(kind, n0 + n) * K + k0 + 8 * c) = o; }
    asm volatile("s_waitcnt lgkmcnt(0)" ::: "memory");
}
__device__ __forceinline__ void conv_item8(const float* W, int K, int N, unsigned char* WT, int kind, LAS float* scr, int item, int lane) {
    const int nblk = N / 32, kb = item / nblk, nb = item % nblk, k0 = 64 * kb, n0 = 32 * nb;
#pragma unroll 8
    for (int i = 0; i < 32; ++i) { const int kk = 2 * i + (lane >> 5); scr[kk * 33 + (lane & 31)] = W[(size_t)(k0 + kk) * N + n0 + (lane & 31)] * pg8::W8_SCALE; }
    asm volatile("s_waitcnt lgkmcnt(0)" ::: "memory");
    const int c = lane & 7;
#pragma unroll
    for (int j = 0; j < 4; ++j) { const int n = (lane >> 3) + 8 * j; const LAS float* s = scr + (8 * c) * 33 + n;
        const f32x4 a = {s[0 * 33], s[1 * 33], s[2 * 33], s[3 * 33]}, b = {s[4 * 33], s[5 * 33], s[6 * 33], s[7 * 33]};
        *(u32x2*)(WT + (size_t)dest_row(kind, n0 + n) * K + k0 + 8 * c) = pack8_fp8(a, b); }
    asm volatile("s_waitcnt lgkmcnt(0)" ::: "memory");
}
constexpr int MOE_I_GU = (D / 64) * (2 * DFF / 128), MOE_I_DN = (DFF / 64) * (D / 128), MOE_I_E = MOE_I_GU + MOE_I_DN, MOE_ITEMS = NEXP * MOE_I_E;
__device__ __forceinline__ void conv_moe_item(const Frame& F, int g) {
    const int lane = F.lane, nq = lane & 31, half = lane >> 5; const int e = g / MOE_I_E; int r = g - e * MOE_I_E;
    const float* W; unsigned char* dst; int K, N, kind;
    if (r < MOE_I_GU) { W = INF(I_MGU) + (size_t)e * D * 2 * DFF; K = D; N = 2 * DFF; dst = F.ws + W_MGU + (size_t)e * 2 * DFF * D; kind = 1; }
    else { r -= MOE_I_GU; W = INF(I_MDN) + (size_t)e * DFF * D; K = DFF; N = D; dst = F.ws + W_MDN + (size_t)e * D * DFF; kind = 0; }
    const int nkb = K / 64, nb = r / nkb, kb = r - nb * nkb, k0 = 64 * kb, n0 = 128 * nb;
    const float* wp = W + (size_t)(k0 + 32 * half) * N + n0 + 4 * nq; f32x4 v[32];
#pragma unroll
    for (int i = 0; i < 32; ++i) v[i] = *(const f32x4*)(wp + (size_t)i * N);
    LAS unsigned char* t = F.lds + F.wave * 16384;
#pragma unroll
    for (int j = 0; j < 4; ++j)
#pragma unroll
        for (int c = 0; c < 4; ++c) { const f32x4 a = (f32x4){v[8 * c][j], v[8 * c + 1][j], v[8 * c + 2][j], v[8 * c + 3][j]} * pg8::W8_SCALE, b = (f32x4){v[8 * c + 4][j], v[8 * c + 5][j], v[8 * c + 6][j], v[8 * c + 7][j]} * pg8::W8_SCALE;
            *(LAS u32x2*)(t + (4 * nq + j) * 72 + 32 * half + 8 * c) = pack8_fp8(a, b); }
    asm volatile("s_waitcnt lgkmcnt(0)" ::: "memory");
    const int c8 = lane & 7;
#pragma unroll
    for (int jj = 0; jj < 16; ++jj) { const int n = (lane >> 3) + 8 * jj;
        *(u32x2*)(dst + (size_t)dest_row(kind, n0 + n) * K + k0 + 8 * c8) = *(const LAS u32x2*)(t + n * 72 + 8 * c8); }
    asm volatile("s_waitcnt lgkmcnt(0)" ::: "memory");
}
__device__ __forceinline__ void conv_moe_part(const Frame& F, int part, int nparts) {
    const int gw = F.bid * 8 + F.wave, NGW = F.G * 8, per = (MOE_ITEMS + NGW - 1) / NGW, chunk = (per + nparts - 1) / nparts;
    const int k0 = part * chunk, k1 = (k0 + chunk < per) ? k0 + chunk : per;
    for (int k = k0; k < k1; ++k) { const int g = gw + k * NGW; if (g < MOE_ITEMS) conv_moe_item(F, g); }
}
__device__ __forceinline__ void p_conv(const Frame& F) {
    LAS float* scr = (LAS float*)(F.lds + F.wave * 16384);
    const long gw = (long)F.bid * 8 + F.wave, NGW = (long)F.G * 8;
    struct Mt { const float* W; int K, N; size_t dst; int kind; const float* g; };
    auto run = [&](const float* W, int K, int N, size_t dst, int kind, const float* g) { const long n = (long)(K / 64) * (N / 32);
        for (long it = gw; it < n; it += NGW) conv_item(W, K, N, (bf16_t*)(F.ws + dst), kind, g, scr, (int)it, F.lane); };
    run(INF(I_HGWIN), D, 8192, W_IN, 0, nullptr);
    run(INF(I_HGWOUT), D, D, W_OUT, 0, nullptr);
    run(INF(I_FGU), D, 2 * DFF, W_GU, 1, nullptr);
    run(INF(I_FDN), DFF, D, W_DN, 0, nullptr);
    run(INF(I_WKVA), D, 576, W_LAT, 2, nullptr);
    run(INF(I_WQA), D, 512, W_LAT + (size_t)768 * D * 2, 0, nullptr);
    run(INF(I_WKVB), 512, 4096, W_KVQ, 0, INF(I_KVNORMG));
    run(INF(I_WQB), 512, 3072, W_KVQ + (size_t)4096 * 512 * 2, 3, INF(I_QNORMG));
    run(INF(I_WO), D, D, W_O, 0, nullptr);
}

struct Row { f32x4 v[8]; };
__device__ __forceinline__ void row_ld(Row& r, const float* p, int lane) {
#pragma unroll
    for (int j = 0; j < 8; ++j) r.v[j] = *(const f32x4*)(p + 4 * lane + 256 * j);
}
__device__ __forceinline__ void row_ld_bf(Row& r, const bf16_t* p, int lane) {
#pragma unroll
    for (int j = 0; j < 8; ++j) { const u32x2 w = *(const u32x2*)(p + 4 * lane + 256 * j); r.v[j] = (f32x4){bflo(w[0]), bfhi(w[0]), bflo(w[1]), bfhi(w[1])}; }
}
__device__ __forceinline__ float row_ss(const Row& r) { float s = 0.f;
#pragma unroll
    for (int j = 0; j < 8; ++j) s += (r.v[j][0] * r.v[j][0] + r.v[j][1] * r.v[j][1]) + (r.v[j][2] * r.v[j][2] + r.v[j][3] * r.v[j][3]);
    return wave_sum(s); }
template <bool F8 = false>
__device__ __forceinline__ void row_mod_store(const Row& h, float rstd, const LAS float* gs, const LAS float* sh, bf16_t* o, int lane, Row* keep) {
#pragma unroll
    for (int j = 0; j < 8; ++j) { const int c = 4 * lane + 256 * j; const f32x4 gv = *(const LAS f32x4*)(gs + c), hv = *(const LAS f32x4*)(sh + c);
        const f32x4 u = h.v[j] * rstd * gv + hv; if (keep) keep->v[j] = u;
        if (F8) { int w = 0; w = __builtin_amdgcn_cvt_pk_fp8_f32(u[0], u[1], w, false); w = __builtin_amdgcn_cvt_pk_fp8_f32(u[2], u[3], w, true); *(int*)((unsigned char*)o + c) = w; }
        else *(u32x2*)(o + c) = (u32x2){cvt_pk_bf16(u[0], u[1]), cvt_pk_bf16(u[2], u[3])}; }
}
template <int MODE> __device__ __forceinline__ void p_thin(const Frame& F) {
    const int lane = F.lane; float* out = F.a->out;
    LAS float* T_GG = (LAS float*)F.lds; LAS float* T_GS = T_GG + 4096; LAS float* T_SH = T_GS + 4096; LAS float* T_KGS = T_SH + 4096; LAS float* T_KSH = T_KGS + 4096;
    LAS float* wr = T_SH + 4096;
    __syncthreads();
    for (int i = F.tid; i < 2 * D; i += 512) { const int b = i >> 11, c = i & (D - 1);
        if (MODE >= 1) { const int mw = MODE - 1; T_GG[i] = modp(F, mw, 2, b)[c] * normg(F, mw >> 1, mw & 1, 1)[c]; }
        if (MODE <= 3) { T_GS[i] = normg(F, MODE >> 1, MODE & 1, 0)[c] * (1.0f + modp(F, MODE, 1, b)[c]); T_SH[i] = modp(F, MODE, 0, b)[c]; }
        if (MODE == 2) { T_KGS[i] = INF(I_KVNG)[c] * (1.0f + modp(F, 4, 1, b)[c]); T_KSH[i] = modp(F, 4, 0, b)[c]; } }
    if (MODE == 3) { const float* w = INF(I_ROUTER); for (int i = F.tid; i < D * NEXP; i += 512) wr[i] = w[i]; }
    __syncthreads();
    int tst[NEXP];
    if (MODE == 4) { int t = 0;
#pragma unroll
        for (int e = 0; e < NEXP; ++e) { tst[e] = t * 256; t += ((int)F.ctl[CW_CNT + 64 * e] + 255) >> 8; } }
    for (int m = F.bid * 8 + F.wave; m < M; m += F.G * 8) {
        const int b = m >> 13, tb = b * D; Row h;
        if (MODE == 0) row_ld(h, INF(I_X) + (size_t)m * D, lane);
        else {
            Row y; float escale = EPS;
            if (MODE == 4) { const int4 tk = ((const int4*)(F.ws + WS_TOK))[m]; const float w0 = __int_as_float(tk.z), w1 = __int_as_float(tk.w);
                int o0 = 0, o1 = 0;
#pragma unroll
                for (int e = 0; e < NEXP; ++e) { o0 = ((tk.x & 15) == e) ? tst[e] : o0; o1 = ((tk.y & 15) == e) ? tst[e] : o1; }
                const bf16_t* y0 = (const bf16_t*)(F.ws + B_Y2) + (size_t)(o0 + (tk.x >> 4)) * D; const bf16_t* y1 = (const bf16_t*)(F.ws + B_Y2) + (size_t)(o1 + (tk.y >> 4)) * D;
                Row ya; row_ld_bf(ya, y0, lane); row_ld_bf(y, y1, lane);
#pragma unroll
                for (int j = 0; j < 8; ++j) y.v[j] = ya.v[j] * w0 + y.v[j] * w1;
            } else row_ld_bf(y, (const bf16_t*)(F.ws + WS_Y) + (size_t)m * D, lane);
            if (MODE == 1) { const float* ss = (const float*)(F.ws + WS_SSO) + (size_t)m * 128; const float so = wave_sum(ss[lane] + ss[64 + lane]) * (1.0f / D); escale = EPS * (so + EPS); }
            bf16_t* xr = (bf16_t*)(F.ws + WS_XR) + (size_t)m * D;
            if (MODE == 1) row_ld(h, INF(I_X) + (size_t)m * D, lane); else row_ld_bf(h, xr, lane);
            const float rstd = rsqrtf(row_ss(y) * (1.0f / D) + escale);
#pragma unroll
            for (int j = 0; j < 8; ++j) { const int c = 4 * lane + 256 * j; const f32x4 gg = *(const LAS f32x4*)(T_GG + tb + c);
                h.v[j] = h.v[j] + gg * (y.v[j] * rstd);
                if (MODE == 4) *(f32x4*)(out + (size_t)m * D + c) = h.v[j];
                else *(u32x2*)(xr + c) = (u32x2){cvt_pk_bf16(h.v[j][0], h.v[j][1]), cvt_pk_bf16(h.v[j][2], h.v[j][3])}; }
        }
        if (MODE == 4) continue;
        const float rstd = rsqrtf(row_ss(h) * (1.0f / D) + EPS);
        if (MODE == 2) row_mod_store(h, rstd, T_KGS + tb, T_KSH + tb, (bf16_t*)(F.ws + WS_XS) + (size_t)m * D, lane, nullptr);
        Row u;
        if (MODE == 3) row_mod_store<true>(h, rstd, T_GS + tb, T_SH + tb, (bf16_t*)(F.ws + WS_U + (size_t)m * D), lane, &u);
        else row_mod_store(h, rstd, T_GS + tb, T_SH + tb, (bf16_t*)(F.ws + WS_U) + (size_t)m * D, lane, nullptr);
        if (MODE == 3) {
            float lg[NEXP];
#pragma unroll
            for (int e = 0; e < NEXP; ++e) lg[e] = 0.f;
#pragma unroll
            for (int j = 0; j < 8; ++j) { asm volatile("" ::: "memory");
#pragma unroll
                for (int c = 0; c < 4; ++c) { const int i = 4 * lane + 256 * j + c; const f32x4 w0 = *(const LAS f32x4*)(wr + i * 8), w1 = *(const LAS f32x4*)(wr + i * 8 + 4); const float x = u.v[j][c];
                    lg[0] += x * w0[0]; lg[1] += x * w0[1]; lg[2] += x * w0[2]; lg[3] += x * w0[3]; lg[4] += x * w1[0]; lg[5] += x * w1[1]; lg[6] += x * w1[2]; lg[7] += x * w1[3]; } }
#pragma unroll
            for (int e = 0; e < NEXP; ++e) lg[e] = wave_sum(lg[e]);
            int e0 = 0; float v0 = lg[0];
#pragma unroll
            for (int e = 1; e < NEXP; ++e) if (lg[e] > v0) { v0 = lg[e]; e0 = e; }
            int e1 = e0 == 0 ? 1 : 0; float v1 = lg[e1];
#pragma unroll
            for (int e = 0; e < NEXP; ++e) if (e != e0 && lg[e] > v1) { v1 = lg[e]; e1 = e; }
            if (lane == 0) { const float p1 = __expf(v1 - v0), w0 = 1.0f / (1.0f + p1), w1 = p1 * w0;
                const int s0 = (int)atomicAdd(F.ctl + CW_CNT + 64 * e0, 1u), s1 = (int)atomicAdd(F.ctl + CW_CNT + 64 * e1, 1u);
                int* list = (int*)(F.ws + WS_LIST); list[(size_t)e0 * M + s0] = m; list[(size_t)e1 * M + s1] = m;
                ((int4*)(F.ws + WS_TOK))[m] = make_int4(e0 | (s0 << 4), e1 | (s1 << 4), __float_as_int(w0), __float_as_int(w1)); }
        }
    }
}

#define MFMA16(X, Y, C) __builtin_amdgcn_mfma_f32_16x16x32_bf16((X), (Y), (C), 0, 0, 0)
__device__ __forceinline__ float expc(float x) { return __expf(fminf(x, 80.0f)); }
__device__ __forceinline__ int hg_tiled(int r, int seg) { return (((r >> 4) * 2 + (seg >> 1)) * 64 + (2 * (seg & 1)) * 16 + (r & 15)) * 8; }
__device__ __forceinline__ void p_hg_chunk(const Frame& F) {
    constexpr int RS = 272, TS = 144;
    LAS unsigned char* QA = F.lds; LAS unsigned char* QB = QA + 64 * RS; LAS unsigned char* KA = QB + 32 * RS; LAS unsigned char* KB = KA + 32 * RS;
    LAS unsigned char* VS = KB + 64 * RS; LAS unsigned char* VT = VS + 64 * RS; LAS unsigned char* PS = VT + 128 * TS; LAS float* TOT = (LAS float*)(PS + 64 * TS);
    const int tid = F.tid, lane = F.lane, w = F.wave, ch = tid & 127, seg = tid >> 7, fr = lane & 15, fq = lane >> 4;
    const _Float16* LFg = (const _Float16*)(F.ws + B_LF); const bf16_t* Qg = (const bf16_t*)(F.ws + B_Q); const bf16_t* VIg = (const bf16_t*)(F.ws + B_VI);
    for (int unit = F.bid; unit < 4096; unit += F.G) {
        const int bh = unit >> 7, c = unit & 127, b = bh >> 4, h = bh & 15, m0 = b * SEQ + 64 * c, k0 = 128 * h;
        float lf[16], qv[16];
#pragma unroll
        for (int i = 0; i < 16; ++i) { const size_t o = (size_t)(m0 + 16 * seg + i) * D + k0 + ch; lf[i] = (float)LFg[o]; qv[i] = bf2f(Qg[o]); }
#pragma unroll
        for (int p = 0; p < 2; ++p) { const int piece = tid + 512 * p, s = piece >> 4, v8 = (piece & 15) * 8; *(LAS u32x4*)(VS + s * RS + v8 * 2) = *(const u32x4*)(VIg + (size_t)(m0 + s) * D + k0 + v8); }
        float bcs[16]; float run = 0.f;
#pragma unroll
        for (int i = 0; i < 16; ++i) { run += lf[i]; bcs[i] = run; }
        TOT[seg * 128 + ch] = run;
        __syncthreads();
        const float t0 = TOT[ch], t1 = TOT[128 + ch], t2 = TOT[256 + ch], t3 = TOT[384 + ch];
        const float pre = seg == 0 ? 0.f : seg == 1 ? t0 : seg == 2 ? t0 + t1 : t0 + t1 + t2, r1 = t0 + t1, bl = r1 + t2 + t3;
        unsigned kh[8];
#pragma unroll
        for (int i = 0; i < 16; i += 2) { float kv[2];
#pragma unroll
            for (int z = 0; z < 2; ++z) { const int t = 16 * seg + i + z; const float bb = bcs[i + z] + pre, kk = 1.0f - __expf(lf[i + z]), q = qv[i + z];
                *(LAS bf16_t*)(QA + t * RS + ch * 2) = f2bf(q * expc(bb));
                if (seg >= 2) *(LAS bf16_t*)(QB + (t - 32) * RS + ch * 2) = f2bf(q * expc(bb - r1));
                if (seg < 2) *(LAS bf16_t*)(KA + t * RS + ch * 2) = f2bf(kk * expc(-bb));
                *(LAS bf16_t*)(KB + t * RS + ch * 2) = f2bf(kk * expc(r1 - bb));
                kv[z] = kk * expc(bl - bb); }
            kh[i >> 1] = cvt_pk_bf16(kv[0], kv[1]); }
        { bf16_t* kt = (bf16_t*)(F.ws + B_KT) + (size_t)unit * 8192 + hg_tiled(ch, seg); *(u32x4*)kt = (u32x4){kh[0], kh[1], kh[2], kh[3]}; *(u32x4*)(kt + 128) = (u32x4){kh[4], kh[5], kh[6], kh[7]}; }
        if (seg == 3) ((float*)(F.ws + B_DEC))[(size_t)unit * 128 + ch] = expc(bl);
        { unsigned vv[8];
#pragma unroll
            for (int i = 0; i < 16; i += 2) { const unsigned lo = *(const LAS bf16_t*)(VS + (16 * seg + i) * RS + ch * 2), hi = *(const LAS bf16_t*)(VS + (16 * seg + i + 1) * RS + ch * 2); vv[i >> 1] = lo | (hi << 16); }
            const u32x4 a = {vv[0], vv[1], vv[2], vv[3]}, bq = {vv[4], vv[5], vv[6], vv[7]};
            *(LAS u32x4*)(VT + ch * TS + 32 * seg) = a; *(LAS u32x4*)(VT + ch * TS + 32 * seg + 16) = bq;
            bf16_t* vt = (bf16_t*)(F.ws + B_VT) + (size_t)unit * 8192 + hg_tiled(ch, seg); *(u32x4*)vt = a; *(u32x4*)(vt + 128) = bq; }
        __syncthreads();
#pragma unroll
        for (int p = 0; p < 2; ++p) { const int piece = tid + 512 * p, ww = piece >> 7, pp = (piece >> 6) & 1, ln = piece & 63, r_ = ln & 15, q_ = ln >> 4;
            const u32x2 lo = *(const LAS u32x2*)(QA + (32 * pp + r_) * RS + (16 * ww + 4 * q_) * 2), hi = *(const LAS u32x2*)(QA + (32 * pp + 16 + r_) * RS + (16 * ww + 4 * q_) * 2);
            *(u32x4*)((bf16_t*)(F.ws + B_QH) + (size_t)unit * 8192 + piece * 8) = (u32x4){lo[0], lo[1], hi[0], hi[1]}; }
        { const int tt = w >> 2, st = w & 3; f32x4 acc = {0.f, 0.f, 0.f, 0.f};
#pragma unroll
            for (int kb = 0; kb < 4; ++kb) acc = MFMA16(*(const LAS bf16x8*)(KB + (16 * st + fr) * RS + (32 * kb + 8 * fq) * 2), *(const LAS bf16x8*)(QB + (16 * tt + fr) * RS + (32 * kb + 8 * fq) * 2), acc);
            const int ta = 32 + 16 * tt + fr, sa = 16 * st + 4 * fq;
#pragma unroll
            for (int j = 0; j < 4; ++j) if (sa + j > ta) acc[j] = 0.f;
            *(LAS u32x2*)(PS + ta * TS + sa * 2) = (u32x2){cvt_pk_bf16(acc[0], acc[1]), cvt_pk_bf16(acc[2], acc[3])}; }
        if (w < 4) { const int tt = w >> 1, st = w & 1; f32x4 acc = {0.f, 0.f, 0.f, 0.f};
#pragma unroll
            for (int kb = 0; kb < 4; ++kb) acc = MFMA16(*(const LAS bf16x8*)(KA + (16 * st + fr) * RS + (32 * kb + 8 * fq) * 2), *(const LAS bf16x8*)(QA + (16 * tt + fr) * RS + (32 * kb + 8 * fq) * 2), acc);
            const int ta = 16 * tt + fr, sa = 16 * st + 4 * fq;
#pragma unroll
            for (int j = 0; j < 4; ++j) if (sa + j > ta) acc[j] = 0.f;
            *(LAS u32x2*)(PS + ta * TS + sa * 2) = (u32x2){cvt_pk_bf16(acc[0], acc[1]), cvt_pk_bf16(acc[2], acc[3])}; }
        __syncthreads();
#pragma unroll
        for (int tt = 0; tt < 4; ++tt) { f32x4 acc = {0.f, 0.f, 0.f, 0.f};
#pragma unroll
            for (int sb = 0; sb < 2; ++sb) if (sb == 0 || tt >= 2) acc = MFMA16(*(const LAS bf16x8*)(VT + (16 * w + fr) * TS + (32 * sb + 8 * fq) * 2), *(const LAS bf16x8*)(PS + (16 * tt + fr) * TS + (32 * sb + 8 * fq) * 2), acc);
            *(u32x2*)((bf16_t*)(F.ws + B_OI) + tm_off(m0 + 16 * tt + fr, k0 + 16 * w + 4 * fq)) = (u32x2){cvt_pk_bf16(acc[0], acc[1]), cvt_pk_bf16(acc[2], acc[3])}; }
        __syncthreads();
    }
}
__device__ __forceinline__ void p_hg_scan(const Frame& F) {
    LAS f32x4* red = (LAS f32x4*)F.lds;
    const int tid = F.tid, lane = F.lane, w = F.wave, fr = lane & 15, fq = lane >> 4;
    const bf16_t* QH = (const bf16_t*)(F.ws + B_QH); const bf16_t* KT = (const bf16_t*)(F.ws + B_KT); const bf16_t* VT = (const bf16_t*)(F.ws + B_VT); const float* DEC = (const float*)(F.ws + B_DEC);
    const bf16_t* OI = (const bf16_t*)(F.ws + B_OI); const bf16_t* GS = (const bf16_t*)(F.ws + B_GS); bf16_t* OG = (bf16_t*)(F.ws + B_OG); float* SSO = (float*)(F.ws + WS_SSO);
    for (int ui = F.bid; ui < 256; ui += F.G) {
        const int unit = (F.G == 256) ? (((ui & 7) * 4 + (ui >> 6)) * 8 + ((ui >> 3) & 7)) : ui;
        const int bh = unit >> 3, vs = unit & 7, b = bh >> 4, h = bh & 15;
        const int tt2 = (tid >> 6) & 3;
        const size_t rowoff = tm_off(b * SEQ + 16 * tt2 + fr, 128 * h + 16 * vs + 4 * fq);
        f32x4 S = {0.f, 0.f, 0.f, 0.f};
        u32x4 qA[2], qB[2]; u32x2 gsA, gsB, oiA, oiB; bf16x8 ktA[2], ktB[2], vtA[2], vtB[2]; f32x4 dA, dB;
#define HG_LOAD(q_, kt_, vt_, d_, oi_, gs_, cc) do { const size_t cu = (size_t)(bh * 128 + (cc)); \
            _Pragma("unroll") for (int pp = 0; pp < 2; ++pp) q_[pp] = *(const u32x4*)(QH + cu * 8192 + ((w * 2 + pp) * 64 + lane) * 8); \
            _Pragma("unroll") for (int sb = 0; sb < 2; ++sb) { kt_[sb] = *(const bf16x8*)(KT + cu * 8192 + ((w * 2 + sb) * 64 + lane) * 8); vt_[sb] = *(const bf16x8*)(VT + cu * 8192 + ((vs * 2 + sb) * 64 + lane) * 8); } \
            d_ = *(const f32x4*)(DEC + cu * 128 + 16 * w + 4 * fq); \
            if (tid < 256) { oi_ = *(const u32x2*)(OI + rowoff + (size_t)(cc) * 131072); gs_ = *(const u32x2*)(GS + rowoff + (size_t)(cc) * 131072); } } while (0)
#define HG_STEP(q_, kt_, vt_, d_, oi_, gs_, cc) do { \
            LAS f32x4* rb = red + ((cc) & 1) * 2048; \
            { const u32x4 sw = {cvt_pk_bf16(S[0], S[1]), cvt_pk_bf16(S[2], S[3]), 0u, 0u}; const bf16x8 Sb = *(const bf16x8*)&sw; \
                _Pragma("unroll") for (int tt = 0; tt < 4; ++tt) { const u32x4 xw = {q_[tt >> 1][2 * (tt & 1)], q_[tt >> 1][2 * (tt & 1) + 1], 0u, 0u}; const f32x4 z = {0.f, 0.f, 0.f, 0.f}; \
                    rb[(w * 4 + tt) * 64 + lane] = MFMA16(Sb, *(const bf16x8*)&xw, z); } }            \
            S = S * d_; S = MFMA16(kt_[0], vt_[0], S); S = MFMA16(kt_[1], vt_[1], S); \
            const u32x2 oiw = oi_; const f32x4 oi = {bflo(oiw[0]), bfhi(oiw[0]), bflo(oiw[1]), bfhi(oiw[1])}; const u32x2 gs = gs_; \
            if ((cc) + 2 < NCH) HG_LOAD(q_, kt_, vt_, d_, oi_, gs_, (cc) + 2); \
            __syncthreads(); \
            if (tid < 256) { f32x4 o = rb[tt2 * 64 + lane]; \
                _Pragma("unroll") for (int ww = 1; ww < 8; ++ww) o += rb[(ww * 4 + tt2) * 64 + lane]; \
                o += oi; float s2 = (o[0] * o[0] + o[1] * o[1]) + (o[2] * o[2] + o[3] * o[3]); s2 += __shfl_xor(s2, 16); s2 += __shfl_xor(s2, 32); \
                *(u32x2*)(OG + rowoff + (size_t)(cc) * 131072) = (u32x2){cvt_pk_bf16(o[0] * bflo(gs[0]), o[1] * bfhi(gs[0])), cvt_pk_bf16(o[2] * bflo(gs[1]), o[3] * bfhi(gs[1]))}; \
                if (fq == 0) SSO[(size_t)(b * SEQ + 64 * (cc) + 16 * tt2 + fr) * 128 + h * 8 + vs] = s2; } } while (0)
        HG_LOAD(qA, ktA, vtA, dA, oiA, gsA, 0);
        HG_LOAD(qB, ktB, vtB, dB, oiB, gsB, 1);
        for (int c = 0; c < NCH; c += 2) { HG_STEP(qA, ktA, vtA, dA, oiA, gsA, c); HG_STEP(qB, ktB, vtB, dB, oiB, gsB, c + 1); }
        __syncthreads();
#undef HG_LOAD
#undef HG_STEP
    }
}

namespace att {
constexpr int KROW = 384, SHM_K = 64 * KROW, SHM_V = 16384, OFF_K = 2 * SHM_V, OFF_WS = OFF_K + 2 * SHM_K;
constexpr float THR = 8.f;
__device__ __forceinline__ int v_rd_base(int lane) { return ((lane & 3) << 3) | (((lane >> 2) & 3) << 6) | (((lane >> 4) & 1) << 5) | (((lane >> 5) & 1) << 8); }
__device__ __forceinline__ int crow(int r, int hi) { return (r & 3) + 8 * (r >> 2) + 4 * hi; }
#define SBAR() __builtin_amdgcn_sched_barrier(0)
__device__ __forceinline__ void mask_tile(f32x16& p0, f32x16& p1, int dq) {
    const float NEG = -__builtin_inff();
#pragma unroll
    for (int r = 0; r < 16; ++r) { const int c = (r & 3) + 8 * (r >> 2); if (dq - c < 0) p0[r] = NEG; if (dq - c - 32 < 0) p1[r] = NEG; }
}
__device__ __forceinline__ void partialSM(f32x16& p0, f32x16& p1, float& m_reg, float& mn, float& alpha) {
    float pmax = p0[0];
#pragma unroll
    for (int r = 1; r < 16; ++r) pmax = fmaxf(pmax, p0[r]);
#pragma unroll
    for (int r = 0; r < 16; ++r) pmax = fmaxf(pmax, p1[r]);
    { auto rr = __builtin_amdgcn_permlane32_swap(__float_as_uint(pmax), __float_as_uint(pmax), false, false); pmax = fmaxf(__uint_as_float(rr[0]), __uint_as_float(rr[1])); }
    constexpr float C2 = 1.4426950408889634f * MLA_SCALE;
    if (__builtin_expect(__all((pmax - m_reg) * MLA_SCALE <= THR), 1)) { mn = m_reg; alpha = 1.f; }
    else { mn = fmaxf(m_reg, pmax); alpha = __builtin_amdgcn_exp2f((m_reg - mn) * C2); m_reg = mn; }
    const float mnL = -mn * C2;
#pragma unroll
    for (int r = 0; r < 16; ++r) p0[r] = __builtin_amdgcn_exp2f(fmaf(p0[r], C2, mnL));
#pragma unroll
    for (int r = 0; r < 16; ++r) p1[r] = __builtin_amdgcn_exp2f(fmaf(p1[r], C2, mnL));
}
__device__ __forceinline__ void finishSM(f32x16& p0, f32x16& p1, float alpha, float& l_reg, bf16x8& pa0, bf16x8& pa1, bf16x8& pa2, bf16x8& pa3) {
    float ps = 0;
#pragma unroll
    for (int r = 0; r < 16; ++r) ps += p0[r];
#pragma unroll
    for (int r = 0; r < 16; ++r) ps += p1[r];
    { auto rr = __builtin_amdgcn_permlane32_swap(__float_as_uint(ps), __float_as_uint(ps), false, false); ps = __uint_as_float(rr[0]) + __uint_as_float(rr[1]); }
    l_reg = l_reg * alpha + ps;
#define PK4(P, B_, OUT) do { unsigned a0 = cvt_pk_bf16(P[B_+0], P[B_+1]), a1 = cvt_pk_bf16(P[B_+2], P[B_+3]); unsigned b0 = cvt_pk_bf16(P[B_+4], P[B_+5]), b1 = cvt_pk_bf16(P[B_+6], P[B_+7]); \
        auto r0 = __builtin_amdgcn_permlane32_swap(a0, b0, false, false); auto r1 = __builtin_amdgcn_permlane32_swap(a1, b1, false, false); \
        u32x4 w_ = {r0[0], r1[0], r0[1], r1[1]}; OUT = *reinterpret_cast<bf16x8*>(&w_); } while (0)
    PK4(p0, 0, pa0); PK4(p0, 8, pa1); PK4(p1, 0, pa2); PK4(p1, 8, pa3);
#undef PK4
}
#define KRD2(dst0, dst1, j, imm) do { asm volatile("ds_read_b128 %0, %1 offset:%2" : "=&v"(dst0) : "v"(kb[j]), "i"(imm) : "memory"); \
                                      asm volatile("ds_read_b128 %0, %1 offset:%2" : "=&v"(dst1) : "v"(kb[j]), "i"((imm) + 32 * KROW) : "memory"); } while (0)
#define LGK(n) asm volatile("s_waitcnt lgkmcnt(%0)" :: "i"(n) : "memory")
template <int KB> __device__ __forceinline__ void qkt(f32x16& p0, f32x16& p1, const int (&kb)[4], const bf16x8* qr) {
    p0 = f32x16{}; p1 = f32x16{};
    bf16x8 ka[4], kc[4];
#define KIMM(d0) (KB * SHM_K + ((d0) >> 2) * 128)
    KRD2(ka[0], kc[0], 0, KIMM(0)); KRD2(ka[1], kc[1], 1, KIMM(1)); KRD2(ka[2], kc[2], 2, KIMM(2));
#define QK_STEP(d0) do { if ((d0) + 3 < 12) KRD2(ka[((d0) + 3) & 3], kc[((d0) + 3) & 3], ((d0) + 3) & 3, KIMM((d0) + 3)); \
        LGK(((d0) + 3 < 12) ? 6 : 2 * (11 - (d0))); SBAR(); \
        p0 = __builtin_amdgcn_mfma_f32_32x32x16_bf16(ka[(d0) & 3], qr[d0], p0, 0, 0, 0); p1 = __builtin_amdgcn_mfma_f32_32x32x16_bf16(kc[(d0) & 3], qr[d0], p1, 0, 0, 0); } while (0)
    QK_STEP(0); QK_STEP(1); QK_STEP(2); QK_STEP(3); QK_STEP(4); QK_STEP(5); QK_STEP(6); QK_STEP(7); QK_STEP(8); QK_STEP(9); QK_STEP(10); QK_STEP(11);
#undef QK_STEP
#undef KIMM
}
#define TRRD(dst, off) asm volatile("ds_read_b64_tr_b16 %0, %1 offset:%2" : "=&v"(dst) : "v"(vb0), "i"(off) : "memory")
#define VRD8(L, H, d0, VB_) do { constexpr int b_ = (VB_) * SHM_V + (d0) * 512; TRRD(L[0], b_); TRRD(H[0], b_ + 2048); TRRD(L[1], b_ + 4096); TRRD(H[1], b_ + 6144); TRRD(L[2], b_ + 8192); TRRD(H[2], b_ + 10240); TRRD(L[3], b_ + 12288); TRRD(H[3], b_ + 14336); } while (0)
#define PVMM(L, H, d0) do { \
        o[d0] = __builtin_amdgcn_mfma_f32_32x32x16_bf16(pa0, (bf16x8){L[0][0], L[0][1], L[0][2], L[0][3], H[0][0], H[0][1], H[0][2], H[0][3]}, o[d0], 0, 0, 0); \
        o[d0] = __builtin_amdgcn_mfma_f32_32x32x16_bf16(pa1, (bf16x8){L[1][0], L[1][1], L[1][2], L[1][3], H[1][0], H[1][1], H[1][2], H[1][3]}, o[d0], 0, 0, 0); \
        o[d0] = __builtin_amdgcn_mfma_f32_32x32x16_bf16(pa2, (bf16x8){L[2][0], L[2][1], L[2][2], L[2][3], H[2][0], H[2][1], H[2][2], H[2][3]}, o[d0], 0, 0, 0); \
        o[d0] = __builtin_amdgcn_mfma_f32_32x32x16_bf16(pa3, (bf16x8){L[3][0], L[3][1], L[3][2], L[3][3], H[3][0], H[3][1], H[3][2], H[3][3]}, o[d0], 0, 0, 0); } while (0)
__device__ __forceinline__ void block(const Frame& F, int bh, int qb) {
    LAS unsigned char* lds = F.lds;
    int lane = F.lane; asm volatile("" : "+v"(lane));
    const int tid = F.tid, wid = F.wave, r32 = lane & 31, hi = lane >> 5, b = bh >> 4, h = bh & 15;
    const bf16_t* KN = (const bf16_t*)(F.ws + B_KN) + (size_t)bh * SEQ * 128; const bf16_t* VV = (const bf16_t*)(F.ws + B_V) + (size_t)bh * SEQ * 128;
    const bf16_t* KR = (const bf16_t*)(F.ws + B_KR) + (size_t)b * SEQ * 64;
    const bf16_t* QN = (const bf16_t*)(F.ws + B_QN) + (size_t)bh * SEQ * 128; const bf16_t* QR = (const bf16_t*)(F.ws + B_QR) + (size_t)bh * SEQ * 64;
    const int q0 = qb * 256, NT = (q0 + 256) / 64, qlo = q0 + wid * 32, qm = qlo + r32 - 4 * hi;
    bf16x8 qr[12];
    { const size_t row = (size_t)(qlo + r32);
#pragma unroll
      for (int d0 = 0; d0 < 8; ++d0) qr[d0] = *(const bf16x8*)(QN + row * 128 + d0 * 16 + hi * 8);
#pragma unroll
      for (int d0 = 0; d0 < 4; ++d0) qr[8 + d0] = *(const bf16x8*)(QR + row * 64 + d0 * 16 + hi * 8); }
    unsigned koff[3], kstr[3], voff[2];
    const unsigned oKN = (unsigned)(B_KN + (size_t)bh * SEQ * 128 * 2), oKR = (unsigned)(B_KR + (size_t)b * SEQ * 64 * 2), oV = (unsigned)(B_V + (size_t)bh * SEQ * 128 * 2);
#pragma unroll
    for (int i = 0; i < 3; ++i) { const int p = (wid * 3 + i) * 64 + lane, r = p / 24, cs = p - r * 24, c = cs ^ ((r >> 1) & 7);
        if (c < 16) { koff[i] = oKN + (unsigned)(r * 128 + 8 * c) * 2u; kstr[i] = 64 * 128 * 2; } else { koff[i] = oKR + (unsigned)(r * 64 + 8 * (c - 16)) * 2u; kstr[i] = 64 * 64 * 2; } }
#pragma unroll
    for (int i = 0; i < 2; ++i) { const int s_ = (wid * 2 + i) * 64 + lane, sub = s_ >> 5, w_ = s_ & 31, kk = (sub >> 2) * 8 + (w_ >> 2), c = (sub & 3) * 32 + (w_ & 3) * 8, k = (kk & ~0xC) | ((kk & 4) << 1) | ((kk & 8) >> 1);
        voff[i] = oV + (unsigned)(k * 128 + c) * 2u; }
    const char* wsb = (const char*)F.ws;
#define A_DMA(t, bf) do { \
        _Pragma("unroll") for (int i = 0; i < 3; ++i) __builtin_amdgcn_global_load_lds((const unsigned*)(wsb + (koff[i] + (unsigned)(t) * kstr[i])), (LAS unsigned*)(lds + OFF_K + (bf) * SHM_K + (wid * 3 + i) * 1024), 16, 0, 0); \
        _Pragma("unroll") for (int i = 0; i < 2; ++i) __builtin_amdgcn_global_load_lds((const unsigned*)(wsb + (voff[i] + (unsigned)(t) * (64u * 128u * 2u))), (LAS unsigned*)(lds + (bf) * SHM_V + (wid * 2 + i) * 1024), 16, 0, 0); } while (0)
    int kb[4];
#pragma unroll
    for (int j = 0; j < 4; ++j) kb[j] = (int)(uintptr_t)lds + OFF_K + r32 * KROW + (((2 * j + hi) ^ ((r32 >> 1) & 7)) << 4);
    const int vb0 = (int)(uintptr_t)lds + v_rd_base(lane);
    LAS float* wsl = (LAS float*)(lds + OFF_WS) + wid * 64; LAS float* li_l = wsl; LAS float* al_l = wsl + 32;
    float m_reg = -1e30f, l_reg = 0.f; f32x16 o[4] = {};
    A_DMA(0, 0);
#define A_STEP(t, VB) do { \
        asm volatile("s_waitcnt vmcnt(0)" ::: "memory"); __syncthreads(); \
        if ((t) + 1 < NT) A_DMA((t) + 1, (VB) ^ 1); \
        const int kb_ = (t) * 64; \
        if (kb_ <= qlo + 31) { f32x16 p0, p1; float mn, alpha; bf16x8 pa0, pa1, pa2, pa3; s16x4 la[4], ha[4], lb[4], hb[4]; \
            qkt<VB>(p0, p1, kb, qr); \
            VRD8(la, ha, 0, VB); SBAR(); \
            if (kb_ + 63 > qlo) { asm volatile("; diagonal tile" ::: "memory"); mask_tile(p0, p1, qm - kb_); } \
            partialSM(p0, p1, m_reg, mn, alpha); \
            if (__any(alpha < 1.f)) { if (hi == 0) al_l[r32] = alpha; asm volatile("s_waitcnt lgkmcnt(0)" ::: "memory"); \
                _Pragma("unroll") for (int d_ = 0; d_ < 4; ++d_) _Pragma("unroll") for (int r = 0; r < 16; ++r) o[d_][r] *= al_l[crow(r, hi)]; } \
            finishSM(p0, p1, alpha, l_reg, pa0, pa1, pa2, pa3); SBAR(); \
            VRD8(lb, hb, 1, VB); LGK(8); SBAR(); PVMM(la, ha, 0); SBAR(); \
            VRD8(la, ha, 2, VB); LGK(8); SBAR(); PVMM(lb, hb, 1); SBAR(); \
            VRD8(lb, hb, 3, VB); LGK(8); SBAR(); PVMM(la, ha, 2); SBAR(); \
            LGK(0); SBAR(); PVMM(lb, hb, 3); } } while (0)
    for (int t = 0; t < NT; t += 2) { A_STEP(t, 0); A_STEP(t + 1, 1); }
    if (hi == 0) li_l[r32] = l_reg; asm volatile("s_waitcnt lgkmcnt(0)" ::: "memory");
    bf16_t* Ow = (bf16_t*)(F.ws + B_O) + (size_t)(b * SEQ + qlo) * D + h * 128;
#pragma unroll
    for (int r = 0; r < 16; ++r) { const int orow = crow(r, hi); const float rl = __builtin_amdgcn_rcpf(li_l[orow]);
#pragma unroll
        for (int d0 = 0; d0 < 4; ++d0) { const float v = o[d0][r] * rl; const float vn = __shfl_xor(v, 1);
            if ((r32 & 1) == 0) *(unsigned*)(Ow + (size_t)orow * D + d0 * 32 + r32) = cvt_pk_bf16(v, vn); } }
    __syncthreads();
#undef A_DMA
#undef A_STEP
}
#undef SBAR
#undef KRD2
#undef LGK
#undef TRRD
#undef VRD8
#undef PVMM
}
__device__ __forceinline__ void p_attn(const Frame& F) {
    const int nIt = (F.G == 256) ? 4 : (1024 - F.bid + F.G - 1) / F.G;
    for (int n = 0; n < nIt; ++n) {
        int bh, qb;
        if (F.G == 256) { const int xcd = F.bid & 7, k = F.bid >> 3, x = k & 15; bh = xcd * 4 + (n >> 1) * 2 + (k >> 4); qb = (n & 1) ? 31 - x : x; }
        else { const int L = F.bid + n * F.G; bh = L >> 5; qb = L & 31; }
        att::block(F, bh, qb);
        if (((((F.bid >> 3) + n) & 3) == 0 || nIt != 4) && !F.probe_rep) conv_moe_part(F, nIt == 4 ? 0 : n, nIt == 4 ? 1 : nIt);
        __syncthreads();
    }
}

constexpr int N_PHASES = 18;
__global__ void __launch_bounds__(512, 2) fwd_kernel(Args args) {
    extern __shared__ __attribute__((aligned(16))) unsigned char lds_raw[];
    Frame F; F.lds = (LAS unsigned char*)lds_raw; F.tid = threadIdx.x; F.lane = F.tid & 63; F.wave = __builtin_amdgcn_readfirstlane(F.tid >> 6); F.G = gridDim.x; F.bid = blockIdx.x;
    F.a = &args; F.ws = args.ws; F.ctl = (unsigned*)(args.ws + WS_CTL);
    volatile LAS unsigned* MISC = (volatile LAS unsigned*)(F.lds + MISC_OFF);
    if (F.tid < 64) MISC[F.tid] = 0u;
    __syncthreads();
    XcdBarrier bar; bar.bar = F.ctl + CW_BAR; bar.x = 0; bar.st = MISC + 8;
    if (MK_N_LAUNCHES == 1) bar = xcd_barrier_post(F.ctl + CW_BAR, MISC + 8);
    const int lo = args.ph_lo, hi = args.ph_hi & 0xffff; F.probe_rep = (args.ph_hi >> 16) != 0;
#define IN(k) (lo <= (k) && (k) < hi)
#ifndef PROBE_REPEAT
#define PROBE_REPEAT (-1)
#endif
#define NREP(k) ((k) == PROBE_REPEAT ? 2 : 1)
#define SEAM(k) do { if (IN(k) && IN((k) + 1)) xcd_barrier(bar); } while (0)
    const char* ws = (const char*)F.ws;
    if (IN(0)) for (int rep_ = 0; rep_ < NREP(0); ++rep_) { if (rep_) xcd_barrier(bar); p_mod(F); } SEAM(0);
    if (IN(1)) for (int rep_ = 0; rep_ < NREP(1); ++rep_) { if (rep_) xcd_barrier(bar); p_conv(F); __syncthreads(); p_thin<0>(F); } SEAM(1);
    if (IN(2)) for (int rep_ = 0; rep_ < NREP(2); ++rep_) { if (rep_) xcd_barrier(bar); pg8::DualOrder S{ws + WS_U, ws + W_IN, ws + WS_U, ws + W_IN, 64, 32, 0, D, F.G, F.bid};
        EpiHgIn E{(bf16_t*)(F.ws + B_Q), (float*)(F.ws + B_LF), (bf16_t*)(F.ws + B_VI), (bf16_t*)(F.ws + B_GS), (const float*)(F.ws + WS_LB), INF(I_HGONG)};
        pg8::gemm_phase(F.lds, D, S, E); } SEAM(2);
    if (IN(3)) for (int rep_ = 0; rep_ < NREP(3); ++rep_) { if (rep_) xcd_barrier(bar); p_hg_chunk(F); } SEAM(3);
    if (IN(4)) for (int rep_ = 0; rep_ < NREP(4); ++rep_) { if (rep_) xcd_barrier(bar); p_hg_scan(F); } SEAM(4);
    if (IN(5)) for (int rep_ = 0; rep_ < NREP(5); ++rep_) { if (rep_) xcd_barrier(bar); pg8::DualOrder S{ws + B_OG, ws + W_OUT, ws + B_OG, ws + W_OUT, 64, 8, 0, D, F.G, F.bid, true}; EpiBf16 E{(bf16_t*)(F.ws + WS_Y), D}; pg8::gemm_phase(F.lds, D, S, E); } SEAM(5);
    if (IN(6)) for (int rep_ = 0; rep_ < NREP(6); ++rep_) { if (rep_) xcd_barrier(bar); p_thin<1>(F); } SEAM(6);
    if (IN(7)) for (int rep_ = 0; rep_ < NREP(7); ++rep_) { if (rep_) xcd_barrier(bar); pg8::DualOrder S{ws + WS_U, ws + W_GU, ws + WS_U, ws + W_GU, 64, 44, 0, D, F.G, F.bid}; EpiGU E{(bf16_t*)(F.ws + B_ACT)}; pg8::gemm_phase(F.lds, D, S, E); } SEAM(7);
    if (IN(8)) for (int rep_ = 0; rep_ < NREP(8); ++rep_) { if (rep_) xcd_barrier(bar); pg8::DualOrder S{ws + B_ACT, ws + W_DN, ws + B_ACT, ws + W_DN, 64, 8, 0, DFF, F.G, F.bid}; EpiBf16 E{(bf16_t*)(F.ws + WS_Y), D}; pg8::gemm_phase(F.lds, DFF, S, E); } SEAM(8);
    if (IN(9)) for (int rep_ = 0; rep_ < NREP(9); ++rep_) { if (rep_) xcd_barrier(bar); p_thin<2>(F); } SEAM(9);
    if (IN(10)) for (int rep_ = 0; rep_ < NREP(10); ++rep_) { if (rep_) xcd_barrier(bar); pg8::DualOrder S{ws + WS_XS, ws + W_LAT, ws + WS_U, ws + W_LAT + (size_t)768 * D * 2, 64, 3, 2, D, F.G, F.bid}; S.split = true; S.part_ws = (float*)(F.ws + PART_WS_LAT); S.part_cnt = F.ctl + CW_PART;
        EpiLat E{(bf16_t*)(F.ws + B_CKV), (bf16_t*)(F.ws + B_QLAT), (bf16_t*)(F.ws + B_KR), (float*)(F.ws + WS_SSC), (float*)(F.ws + WS_SSQ), (const float*)(F.ws + WS_COS), (const float*)(F.ws + WS_SIN)};
        pg8::gemm_phase<EpiLat, pg8::DualOrder, false, true>(F.lds, D, S, E); } SEAM(10);
    if (IN(11)) for (int rep_ = 0; rep_ < NREP(11); ++rep_) { if (rep_) xcd_barrier(bar); pg8::DualOrder S{ws + B_CKV, ws + W_KVQ, ws + B_QLAT, ws + W_KVQ + (size_t)4096 * 512 * 2, 64, 16, 12, 512, F.G, F.bid};
        EpiKvQ E{(bf16_t*)(F.ws + B_KN), (bf16_t*)(F.ws + B_V), (bf16_t*)(F.ws + B_QN), (bf16_t*)(F.ws + B_QR), (const float*)(F.ws + WS_SSC), (const float*)(F.ws + WS_SSQ), (const float*)(F.ws + WS_COS), (const float*)(F.ws + WS_SIN)};
        pg8::gemm_phase(F.lds, 512, S, E); } SEAM(11);
    if (IN(12)) for (int rep_ = 0; rep_ < NREP(12); ++rep_) { if (rep_) xcd_barrier(bar); p_attn(F); } SEAM(12);
    if (IN(13)) for (int rep_ = 0; rep_ < NREP(13); ++rep_) { if (rep_) xcd_barrier(bar); pg8::DualOrder S{ws + B_O, ws + W_O, ws + B_O, ws + W_O, 64, 8, 0, D, F.G, F.bid}; EpiBf16 E{(bf16_t*)(F.ws + WS_Y), D}; pg8::gemm_phase(F.lds, D, S, E); } SEAM(13);
    if (IN(14)) for (int rep_ = 0; rep_ < NREP(14); ++rep_) { if (rep_) xcd_barrier(bar); p_thin<3>(F); } SEAM(14);
    if (IN(15)) for (int rep_ = 0; rep_ < NREP(15); ++rep_) { if (rep_) xcd_barrier(bar); pg8::MoeOrder<true> S; S.A = ws + WS_U; S.W = ws + W_MGU; S.wstride = (size_t)2 * DFF * D; S.list = (const int*)(ws + WS_LIST); S.nN = 44; S.rb = D; S.G = F.G; S.c = F.bid; S.init(F.ctl);
        EpiGU8 E{F.ws + B_ACT2}; pg8::gemm_phase<EpiGU8, pg8::MoeOrder<true>, true>(F.lds, D, S, E); } SEAM(15);
    if (IN(16)) for (int rep_ = 0; rep_ < NREP(16); ++rep_) { if (rep_) xcd_barrier(bar); pg8::MoeOrder<false> S; S.A = ws + B_ACT2; S.W = ws + W_MDN; S.wstride = (size_t)D * DFF; S.list = nullptr; S.nN = 8; S.rb = DFF; S.G = F.G; S.c = F.bid; S.init(F.ctl); S.split = true; S.part_ws = (float*)(F.ws + PART_WS_MOE); S.part_cnt = F.ctl + CW_PART + 2048;
        EpiBf16 E{(bf16_t*)(F.ws + B_Y2), D}; pg8::gemm_phase<EpiBf16, pg8::MoeOrder<false>, true, true>(F.lds, DFF, S, E); } SEAM(16);
    if (IN(17)) for (int rep_ = 0; rep_ < NREP(17); ++rep_) { if (rep_) xcd_barrier(bar); p_thin<4>(F); }
#undef IN
#undef SEAM
}

extern "C" void kernel_launch(void* const* d_in, const int* in_sizes, int n_in, void* d_out, int out_size, void* d_ws, size_t ws_size, hipStream_t stream) {
    static int grid = 0;
    if (grid == 0) {
        if (n_in != 25 || out_size != M * D || ws_size < WS_NEED) { fprintf(stderr, "kernel_launch: expected 25 inputs, out %d, ws >= %zu; got n_in %d out %d ws %zu\n", M * D, (size_t)WS_NEED, n_in, out_size, ws_size); grid = -1; return; }
        int dev = 0, cus = 0;
        if (hipGetDevice(&dev) != hipSuccess || hipDeviceGetAttribute(&cus, hipDeviceAttributeMultiprocessorCount, dev) != hipSuccess) { grid = -1; return; }
        if (hipFuncSetAttribute((const void*)fwd_kernel, hipFuncAttributeMaxDynamicSharedMemorySize, LDS_BYTES) != hipSuccess) { fprintf(stderr, "kernel_launch: hipFuncSetAttribute failed\n"); grid = -1; return; }
        int per_cu = 0;
        if (hipOccupancyMaxActiveBlocksPerMultiprocessor(&per_cu, (const void*)fwd_kernel, 512, LDS_BYTES) != hipSuccess || per_cu < 1) { fprintf(stderr, "kernel_launch: occupancy query reports %d\n", per_cu); (void)hipGetLastError(); }
        grid = cus;
    }
    if (grid < 0) return;
    (void)hipMemsetAsync((char*)d_ws + WS_CTL, 0, CTL_BYTES, stream);
    Args a{};
    for (int i = 0; i < 25; ++i) a.in[i] = d_in[i];
    a.out = (float*)d_out; a.ws = (unsigned char*)d_ws;
    if (MK_N_LAUNCHES == 1) { a.ph_lo = 0; a.ph_hi = N_PHASES; hipLaunchKernelGGL(fwd_kernel, dim3(grid), dim3(512), LDS_BYTES, stream, a); }
    else for (int p = 0; p < N_PHASES; ++p) { a.ph_lo = p; a.ph_hi = p + 1; hipLaunchKernelGGL(fwd_kernel, dim3(grid), dim3(512), LDS_BYTES, stream, a);
#if defined(PROBE_HOST_REPEAT)
        if (p == PROBE_HOST_REPEAT) { a.ph_hi |= 1 << 16; hipLaunchKernelGGL(fwd_kernel, dim3(grid), dim3(512), LDS_BYTES, stream, a); }
#endif
    }
    const hipError_t le = hipPeekAtLastError();
    if (le != hipSuccess) fprintf(stderr, "kernel_launch: launch failed: %s\n", hipGetErrorName(le));
}
```

```cpp
#include <hip/hip_runtime.h>
#include <cstdio>
#include <cstdint>

#ifndef MK_N_LAUNCHES
#define MK_N_LAUNCHES 1
#endif

#define LAS __attribute__((address_space(3)))
#define GAS __attribute__((address_space(1)))
typedef unsigned short bf16_t;
typedef short bf16x8 __attribute__((ext_vector_type(8)));
typedef short s16x4 __attribute__((ext_vector_type(4)));
typedef float f32x4 __attribute__((ext_vector_type(4)));
typedef float f32x2 __attribute__((ext_vector_type(2)));
typedef float f32x16 __attribute__((ext_vector_type(16)));
typedef unsigned u32x4 __attribute__((ext_vector_type(4)));
typedef unsigned u32x2 __attribute__((ext_vector_type(2)));

constexpr int D = 2048, BATCH = 2, SEQ = 8192, M = BATCH * SEQ;
constexpr int HG_H = 16, HG_K = 128, HG_C = 64, NCH = SEQ / HG_C;
constexpr int MLA_H = 16, QLORA = 512, KVLORA = 512, NOPE = 128, ROPE = 64, VH = 128;
constexpr int DFF = 5632, NEXP = 8;
constexpr float EPS = 1e-6f;
constexpr float MLA_SCALE = 0.07216878364870322f;
constexpr int NMOD = 4 * 6144 + 4096;
constexpr int MOE_MAXT = 136;
constexpr int MOE_ROWS = MOE_MAXT * 256;

constexpr size_t MiB = 1ull << 20;
constexpr size_t WS_CTL = 0;
constexpr size_t CTL_BYTES = 1 * MiB;
constexpr size_t WS_MOD = 1 * MiB;
constexpr size_t WS_LB = WS_MOD + 256 * 1024;
constexpr size_t WS_COS = 2 * MiB;
constexpr size_t WS_SIN = 4 * MiB;
constexpr size_t WS_SSO = 6 * MiB;
constexpr size_t WS_SSC = 14 * MiB;
constexpr size_t WS_SSQ = 15 * MiB;
constexpr size_t WS_TOK = 16 * MiB;
constexpr size_t WS_LIST = 17 * MiB;
constexpr size_t WS_W = 18 * MiB;
constexpr size_t W_IN = WS_W;
constexpr size_t W_OUT = W_IN + (size_t)8192 * 2048 * 2;
constexpr size_t W_GU = W_OUT + (size_t)2048 * 2048 * 2;
constexpr size_t W_DN = W_GU + (size_t)11264 * 2048 * 2;
constexpr size_t W_LAT = W_DN + (size_t)2048 * 5632 * 2;
constexpr size_t W_KVQ = W_LAT + (size_t)1280 * 2048 * 2;
constexpr size_t W_O = W_KVQ + (size_t)7168 * 512 * 2;
constexpr size_t W_MGU = W_O + (size_t)2048 * 2048 * 2;
constexpr size_t W_MDN = W_MGU + (size_t)8 * 11264 * 2048 * 2;
constexpr size_t W_END = W_MDN + (size_t)8 * 2048 * 5632 * 2;
constexpr size_t WS_U = (W_END + MiB - 1) / MiB * MiB;
constexpr size_t WS_XS = WS_U + (size_t)M * D * 2;
constexpr size_t WS_Y = WS_XS + (size_t)M * D * 2;
constexpr size_t WS_XR = WS_Y + (size_t)M * D * 2;
constexpr size_t WS_BIG = WS_Y + (size_t)M * D * 4;
constexpr size_t B_Q = WS_BIG;
constexpr size_t B_LF = B_Q + (size_t)M * D * 2;
constexpr size_t B_VI = B_LF + (size_t)M * D * 4;
constexpr size_t B_GS = B_VI + (size_t)M * D * 2;
constexpr size_t B_QH = B_GS + (size_t)M * D * 2;
constexpr size_t B_KT = B_QH + (size_t)M * D * 2;
constexpr size_t B_VT = B_KT + (size_t)M * D * 2;
constexpr size_t B_DEC = B_VT + (size_t)M * D * 2;
constexpr size_t B_OI = B_DEC + (size_t)4096 * 128 * 4;
constexpr size_t B_OG = B_Q;
constexpr size_t B_HG_END = B_OI + (size_t)M * D * 4;
constexpr size_t B_ACT = WS_BIG;
constexpr size_t B_CKV = WS_BIG;
constexpr size_t B_QLAT = B_CKV + (size_t)M * 512 * 2;
constexpr size_t B_KR = B_QLAT + (size_t)M * 512 * 2;
constexpr size_t B_KN = B_KR + (size_t)M * 64 * 2;
constexpr size_t B_V = B_KN + (size_t)M * D * 2;
constexpr size_t B_QN = B_V + (size_t)M * D * 2;
constexpr size_t B_QR = B_QN + (size_t)M * D * 2;
constexpr size_t B_O = B_QR + (size_t)M * 1024 * 2;
constexpr size_t B_MLA_END = B_O + (size_t)M * D * 2;
constexpr size_t B_ACT2 = WS_BIG;
constexpr size_t B_Y2 = B_ACT2 + (size_t)MOE_ROWS * DFF * 2;
constexpr size_t B_MOE_END = B_Y2 + (size_t)MOE_ROWS * D * 4;
constexpr size_t WS_NEED = (B_HG_END > B_MOE_END ? (B_HG_END > B_MLA_END ? B_HG_END : B_MLA_END) : (B_MOE_END > B_MLA_END ? B_MOE_END : B_MLA_END));

constexpr int CW_BAR = 4096;
constexpr int CW_CNT = 16384;
constexpr int LDS_BYTES = 147456;
constexpr int MISC_OFF = 131072 + 8192;

typedef __bf16 bf16x2_t __attribute__((ext_vector_type(2)));
__device__ __forceinline__ unsigned cvt_pk_bf16(float lo, float hi) { const f32x2 v = {lo, hi}; return __builtin_bit_cast(unsigned, __builtin_convertvector(v, bf16x2_t)); }
__device__ __forceinline__ float bf2f(bf16_t v) { return __uint_as_float(((unsigned)v) << 16); }
__device__ __forceinline__ float bflo(unsigned w) { return __uint_as_float(w << 16); }
__device__ __forceinline__ float bfhi(unsigned w) { return __uint_as_float(w & 0xffff0000u); }
__device__ __forceinline__ bf16_t f2bf(float f) { return (bf16_t)(cvt_pk_bf16(f, 0.f) & 0xffffu); }
__device__ __forceinline__ float wave_sum(float v) {
#pragma unroll
    for (int o = 1; o < 64; o <<= 1) v += __shfl_xor(v, o);
    return v;
}
__device__ __forceinline__ float sigmoidf_(float x) { return __builtin_amdgcn_rcpf(1.0f + __builtin_amdgcn_exp2f(x * -1.4426950408889634f)); }
__device__ __forceinline__ float siluf_(float x) { return x * __builtin_amdgcn_rcpf(1.0f + __builtin_amdgcn_exp2f(x * -1.4426950408889634f)); }

#define XB_TMO      128
#define XB_XCNT(j)  (256  + 64 * (j))
#define XB_XSUB(j)  (1280 + 64 * (j))
#define XB_XGEN(j)  (2304 + 64 * (j))
#define XB_TOP      3328
#define XB_TOPGEN   3392
#define XCD_BAR_WORDS 3456
#define XB_SPIN_CAP (1u << 22)

__device__ __forceinline__ unsigned xb_ld(unsigned* p)              { return __hip_atomic_load(p, __ATOMIC_RELAXED, __HIP_MEMORY_SCOPE_AGENT); }
__device__ __forceinline__ unsigned xb_add(unsigned* p, unsigned v) { return __hip_atomic_fetch_add(p, v, __ATOMIC_RELAXED, __HIP_MEMORY_SCOPE_AGENT); }
__device__ __forceinline__ unsigned xb_xcc_id() { return (unsigned)__builtin_amdgcn_s_getreg((3 << 11) | 20) & 0xFu; }
#define XB_SPIN(cond, bar) do { unsigned _sp = 0; while (cond) { __builtin_amdgcn_s_sleep(1); \
    if ((++_sp & 255u) == 0u) { if (xb_ld(&(bar)[XB_TMO])) break; if (_sp > XB_SPIN_CAP) { atomicAdd(&(bar)[XB_TMO], 1u); break; } } } } while (0)

struct XcdBarrier { unsigned* bar; unsigned x; volatile LAS unsigned* st; };

__device__ __forceinline__ XcdBarrier xcd_barrier_post(unsigned* bar, volatile LAS unsigned* st) {
    XcdBarrier b; b.bar = bar; b.x = xb_xcc_id(); b.st = st;
    if (threadIdx.x == 0) (void)xb_add(&bar[XB_XCNT(b.x)], 1u);
    return b;
}
__device__ __forceinline__ void xcd_barrier_complete(unsigned* bar, unsigned x, unsigned& nloc, unsigned& nx) {
    const unsigned G = gridDim.x * gridDim.y * gridDim.z;
    unsigned sum, cnt, mine, sp = 0u;
    for (;;) {
        sum = 0u; cnt = 0u; mine = 0u;
#pragma unroll
        for (unsigned j = 0; j < 16; ++j) { const unsigned c = xb_ld(&bar[XB_XCNT(j)]); sum += c; cnt += (c > 0u) ? 1u : 0u; mine = (j == x) ? c : mine; }
        if (sum == G) break;
        __builtin_amdgcn_s_sleep(1);
        if ((++sp & 255u) == 0u) { if (xb_ld(&bar[XB_TMO])) break; if (sp > XB_SPIN_CAP) { atomicAdd(&bar[XB_TMO], 1u); break; } }
    }
    nloc = mine > 0u ? mine : 1u; nx = cnt > 0u ? cnt : 1u;
}
__device__ __forceinline__ void xcd_barrier(const XcdBarrier& b) {
    asm volatile("s_waitcnt vmcnt(0)" ::: "memory");
    __syncthreads();
    if (threadIdx.x == 0) {
        unsigned* bar = b.bar;
        __builtin_amdgcn_s_waitcnt(0);
        unsigned nloc = b.st[0], nx = b.st[1];
        if (nloc == 0u) { xcd_barrier_complete(bar, b.x, nloc, nx); b.st[0] = nloc; b.st[1] = nx; }
        const unsigned old = xb_add(&bar[XB_XSUB(b.x)], 1u);
        const unsigned gen = old / nloc;
        if (old + 1u == (gen + 1u) * nloc) {
            __builtin_amdgcn_fence(__ATOMIC_RELEASE, "agent");
            asm volatile("s_waitcnt vmcnt(0)" ::: "memory");
            const unsigned og = xb_add(&bar[XB_TOP], 1u);
            const unsigned tg = og / nx;
            if (og + 1u == (tg + 1u) * nx) xb_add(&bar[XB_TOPGEN], 1u);
            else XB_SPIN(xb_ld(&bar[XB_TOPGEN]) == tg, bar);
            __builtin_amdgcn_fence(__ATOMIC_ACQUIRE, "agent");
            xb_add(&bar[XB_XGEN(b.x)], 1u);
            asm volatile("s_waitcnt vmcnt(0)" ::: "memory");
        } else {
            XB_SPIN(xb_ld(&bar[XB_XGEN(b.x)]) == gen, bar);
            __builtin_amdgcn_fence(__ATOMIC_ACQUIRE, "agent");
            asm volatile("s_waitcnt vmcnt(0)" ::: "memory");
        }
    }
    __syncthreads();
}

namespace pg8 {
constexpr int BM = 256, BK = 64, HALF = 128, HTB = HALF * BK * 2, STAGE_BYTES = 8 * HTB, NXCD = 8, WGM = 8;
__device__ __forceinline__ int lds_byte(int r, int c) { const int st = (r >> 4) * 2 + (c >> 5), rr = r & 15, cc = c & 31, ob = rr * 64 + cc * 2; return st * 1024 + (ob ^ (((ob >> 9) & 1) << 5)); }
__device__ __forceinline__ void stage_rc(int b, int& R, int& C) { const int st = b / 1024, sb = b % 1024, swz = sb ^ (((sb >> 9) & 1) << 5); R = (st >> 1) * 16 + swz / 64; C = (st & 1) * 32 + (swz % 64) / 2; }
__device__ __forceinline__ int perm32(int rho) { const int n = rho >> 4, i = rho & 15; return 8 * (i >> 2) + 4 * n + (i & 3); }

struct Unit { const char* a; const char* b; int pm, pn, e, nv; };

__device__ __forceinline__ void tile_of(int L, int nM, int nN, int& pm, int& pn) {
    const int nwg = nM * nN; int wgid = L;
    { const int q = nwg / NXCD, r = nwg % NXCD, xcd = wgid % NXCD, off = wgid / NXCD; wgid = (xcd < r ? xcd * (q + 1) : r * (q + 1) + (xcd - r) * q) + off; }
    const int nig = WGM * nN, gid = wgid / nig, fm = gid * WGM, gsz = (nM - fm) < WGM ? (nM - fm) : WGM;
    pm = fm + ((wgid % nig) % gsz); pn = (wgid % nig) / gsz;
}
struct DualOrder {
    static constexpr bool GATHER = false;
    const char *A1, *B1, *A2, *B2; int nM, nN1, nN2, K, G, c; bool tmA = false;
    __device__ __forceinline__ bool next(int i, Unit& u) const {
        const int nN = nN1 + nN2; const long L = (long)i * G + c; if (L >= (long)nM * nN) return false;
        int pm, pn; tile_of((int)L, nM, nN, pm, pn);
        const size_t tstep = (size_t)BM * K * 2;
        if (pn < nN1) { u.e = 0; u.pn = pn; u.a = A1 + pm * tstep; u.b = B1 + pn * tstep; }
        else { u.e = 1; u.pn = pn - nN1; u.a = A2 + pm * tstep; u.b = B2 + (pn - nN1) * tstep; }
        u.pm = pm; u.nv = 256; return true;
    }
    __device__ __forceinline__ const int* rows(const Unit&) const { return nullptr; }
};
template <bool GATHER_> struct MoeOrder {
    static constexpr bool GATHER = GATHER_;
    static constexpr bool tmA = false;
    const char* A; const char* W; size_t wstride; const int* list; int nT, nN, rb  , G, c; int tstart[NEXP + 1]; int cnt[NEXP];
    __device__ __forceinline__ void init(const unsigned* ctl) {
        int t = 0;
#pragma unroll
        for (int e = 0; e < NEXP; ++e) { const int n = (int)ctl[CW_CNT + 64 * e]; cnt[e] = n; tstart[e] = t; t += (n + 255) >> 8; }
        tstart[NEXP] = t; nT = t;
    }
    __device__ __forceinline__ bool next(int i, Unit& u) const {
        const long L = (long)i * G + c; if (L >= (long)nT * nN) return false;
        int pm, pn; tile_of((int)L, nT, nN, pm, pn);
        int e = 0;
#pragma unroll
        for (int j = 1; j < NEXP; ++j) e += (pm >= tstart[j]) ? 1 : 0;
        int ce = 0, ts = 0;
#pragma unroll
        for (int j = 0; j < NEXP; ++j) { ce = (j == e) ? cnt[j] : ce; ts = (j == e) ? tstart[j] : ts; }
        u.e = e; u.pm = pm; u.pn = pn; const int left = ce - (pm - ts) * 256; u.nv = left < 256 ? left : 256;
        u.a = GATHER ? A : A + (size_t)pm * BM * rb; u.b = W + (size_t)e * wstride + (size_t)pn * BM * rb;
        return true;
    }
    __device__ __forceinline__ const int* rows(const Unit& u) const { int ts = 0;
#pragma unroll
        for (int j = 0; j < NEXP; ++j) ts = (j == u.e) ? tstart[j] : ts;
        return list + (size_t)u.e * M + (u.pm - ts) * 256; }
};

typedef int i32x4 __attribute__((ext_vector_type(4)));
typedef int i32x8 __attribute__((ext_vector_type(8)));
constexpr float W8_SCALE = 128.0f; constexpr int W8_EXP = 0x78787878, ONE_EXP = 0x7f7f7f7f;
template <class Epi, class Sched, bool FP8 = false>
__device__ __forceinline__ void gemm_phase(LAS unsigned char* lds, const int Kel, const Sched& S, const Epi& E) {
    const int K = FP8 ? Kel / 2 : Kel;
    const int tid = threadIdx.x, wid = __builtin_amdgcn_readfirstlane(tid >> 6), lane = tid & 63, wr = wid >> 2, wc = wid & 3, fr = lane & 15, fq = lane >> 4;
    const int nt = K / BK;
    unsigned vA[2][2], vB[2]; int Rr[2], Cc[2];
#pragma unroll
    for (int i = 0; i < 2; ++i) { int R, C; stage_rc(tid * 16 + i * 8192, R, C); Rr[i] = R; Cc[i] = C; const int Rb = Epi::PERM ? ((R & ~31) + perm32(R & 31)) : R;
        vB[i] = (unsigned)(Rb * K + C) * 2u; }
    const size_t kstep = (size_t)(BK * 2), kstepA = S.tmA ? (size_t)8192 : kstep;
    const size_t hstep = (size_t)HALF * K * 2;
    const unsigned ldsw = (unsigned)wid * 1024u;
    const int aoff = lds_byte(wr * 64 + fr, fq * 8), boff = lds_byte(wc * 32 + fr, fq * 8);
#define PG8_SA(b, h) (((b) * 2 + (h)) * HTB)
#define PG8_SB(b, h) ((4 + (b) * 2 + (h)) * HTB)
#define PG8_STAGE2(bufoff, gbase, v0, v1) do { \
        __builtin_amdgcn_global_load_lds((const unsigned*)((const char*)(gbase) + (v0)), (LAS unsigned*)(lds + (bufoff) + ldsw), 16, 0, 0); \
        __builtin_amdgcn_global_load_lds((const unsigned*)((const char*)(gbase) + (v1)), (LAS unsigned*)(lds + (bufoff) + ldsw + 8192), 16, 0, 0); } while (0)
#define PG8_STAGEB(bufoff, gbase) PG8_STAGE2(bufoff, gbase, vB[0], vB[1])
#define PG8_LD8(p) __builtin_shufflevector(*(const LAS i32x4*)(p), *(const LAS i32x4*)((p) + 1024), 0, 1, 2, 3, 4, 5, 6, 7)
#define PG8_LDA(dst, b, h) do { if constexpr (FP8) { _Pragma("unroll") for (int m = 0; m < 4; ++m) dst##8[m] = PG8_LD8(lds + PG8_SA(b, h) + aoff + m * 2048); } \
        else { _Pragma("unroll") for (int m = 0; m < 4; ++m) _Pragma("unroll") for (int k = 0; k < 2; ++k) dst[m][k] = *(const LAS bf16x8*)(lds + PG8_SA(b, h) + aoff + m * 2048 + k * 1024); } } while (0)
#define PG8_LDB(dst, b, h) do { if constexpr (FP8) { _Pragma("unroll") for (int n = 0; n < 2; ++n) dst##8[n] = PG8_LD8(lds + PG8_SB(b, h) + boff + n * 2048); } \
        else { _Pragma("unroll") for (int n = 0; n < 2; ++n) _Pragma("unroll") for (int k = 0; k < 2; ++k) dst[n][k] = *(const LAS bf16x8*)(lds + PG8_SB(b, h) + boff + n * 2048 + k * 1024); } } while (0)
#define PG8_MMA(ai, bj, At, Bt) do { __builtin_amdgcn_s_setprio(1); _Pragma("unroll") for (int m = 0; m < 4; ++m) _Pragma("unroll") for (int n = 0; n < 2; ++n) { \
        if constexpr (FP8) asm volatile("v_mfma_scale_f32_16x16x128_f8f6f4 %0, %1, %2, %0, %3, %4 op_sel_hi:[0,0,0]" : "+v"(acc[ai][bj][m][n]) : "v"(Bt##8[n]), "v"(At##8[m]), "v"(sc_w8), "v"(sc_one)); \
        else { _Pragma("unroll") for (int k = 0; k < 2; ++k) acc[ai][bj][m][n] = __builtin_amdgcn_mfma_f32_16x16x32_bf16(Bt[n][k], At[m][k], acc[ai][bj][m][n], 0, 0, 0); } } \
        __builtin_amdgcn_s_setprio(0); } while (0)
#define PG8_WAIT_V(n) asm volatile("s_waitcnt vmcnt(" #n ")" ::: "memory")
#define PG8_WAIT_L(n) asm volatile("s_waitcnt lgkmcnt(" #n ")" ::: "memory")
#define PG8_BAR __builtin_amdgcn_s_barrier()
#define PG8_SCHED __builtin_amdgcn_sched_barrier(0)
    Unit cur, nxt; int ui = 0;
    if (!S.next(0, cur)) return;
    if constexpr (Sched::GATHER) { const int* rl = S.rows(cur);
#pragma unroll
        for (int h = 0; h < 2; ++h)
#pragma unroll
            for (int i = 0; i < 2; ++i) { const int j = Rr[i] + 128 * h; const int tok = (j < cur.nv) ? rl[j] : 0; vA[h][i] = (unsigned)(tok * K + Cc[i]) * 2u; } }
    else {
#pragma unroll
        for (int h = 0; h < 2; ++h)
#pragma unroll
            for (int i = 0; i < 2; ++i) { const int row = Rr[i] + 128 * h; vA[h][i] = S.tmA ? (unsigned)((row >> 6) * 262144 + (Cc[i] >> 4) * 2048 + (row & 63) * 32 + (Cc[i] & 15) * 2) : (unsigned)(row * K + Cc[i]) * 2u; } }
    LAS unsigned char* idx_lds = lds + STAGE_BYTES + wid * 1024;
    f32x4 acc[2][2][4][2];
#pragma unroll
    for (int a = 0; a < 2; ++a)
#pragma unroll
        for (int b = 0; b < 2; ++b)
#pragma unroll
            for (int m = 0; m < 4; ++m)
#pragma unroll
                for (int n = 0; n < 2; ++n) acc[a][b][m][n] = (f32x4){0.f, 0.f, 0.f, 0.f};
    bf16x8 At[4][2], B0[2][2], B1[2][2]; i32x8 At8[4], B08[2], B18[2];
    int sc_w8 = W8_EXP, sc_one = ONE_EXP; asm volatile("" : "+v"(sc_w8), "+v"(sc_one));
    const char* cA = cur.a; const char* cB = cur.b;
    PG8_STAGEB(PG8_SB(0, 0), cB); PG8_STAGEB(PG8_SB(0, 1), cB + hstep); PG8_STAGE2(PG8_SA(0, 0), cA, vA[0][0], vA[0][1]); PG8_STAGE2(PG8_SA(0, 1), cA, vA[1][0], vA[1][1]);
    if (wr == 1) PG8_BAR;
    PG8_WAIT_V(2); PG8_BAR;
    PG8_STAGEB(PG8_SB(1, 0), cB + kstep); PG8_STAGE2(PG8_SA(1, 0), cA + kstepA, vA[0][0], vA[0][1]); PG8_STAGEB(PG8_SB(1, 1), cB + hstep + kstep);
    PG8_WAIT_V(6); PG8_BAR;
    for (;;) {
        const bool has_next = S.next(ui + 1, nxt);
        const char* nA = has_next ? nxt.a : cA; const char* nB = has_next ? nxt.b : cB;
        for (int t = 0; t < nt; t += 2) {
            const bool last = (t == nt - 2);
            if constexpr (Sched::GATHER) { if (t == nt - 6 && has_next) { const int* rl = S.rows(nxt);
#pragma unroll
                for (int h = 0; h < 2; ++h)
#pragma unroll
                    for (int i = 0; i < 2; ++i) __builtin_amdgcn_global_load_lds((const unsigned*)(rl + Rr[i] + 128 * h), (LAS unsigned*)(idx_lds + (h * 2 + i) * 256), 4, 0, 0); } }
            const char* a1 = cA + (size_t)(t + 1) * kstepA;
            const char* a2 = last ? nA : cA + (size_t)(t + 2) * kstepA; const char* b2 = last ? nB : cB + (size_t)(t + 2) * kstep;
            const char* a3 = a2 + kstepA; const char* b3 = b2 + kstep;
            PG8_LDB(B0, 0, 0); PG8_LDB(B1, 0, 1); PG8_SCHED; PG8_LDA(At, 0, 0); PG8_STAGE2(PG8_SA(1, 1), a1, vA[1][0], vA[1][1]);
            if constexpr (Sched::GATHER) { if (last && has_next) {
#pragma unroll
                for (int h = 0; h < 2; ++h)
#pragma unroll
                    for (int i = 0; i < 2; ++i) { const int j = Rr[i] + 128 * h; const int tok = *(const LAS int*)(idx_lds + (h * 2 + i) * 256 + lane * 4); vA[h][i] = (unsigned)(((j < nxt.nv) ? tok : 0) * K + Cc[i]) * 2u; } } }
            PG8_WAIT_V(8); PG8_WAIT_L(0); PG8_BAR; PG8_MMA(0, 0, At, B0); PG8_MMA(0, 1, At, B1); PG8_BAR; PG8_SCHED;
            PG8_LDA(At, 0, 1); PG8_STAGEB(PG8_SB(0, 0), b2); PG8_STAGEB(PG8_SB(0, 1), b2 + hstep); PG8_STAGE2(PG8_SA(0, 0), a2, vA[0][0], vA[0][1]);
            PG8_WAIT_V(8); PG8_WAIT_L(0); PG8_BAR; PG8_MMA(1, 0, At, B0); PG8_MMA(1, 1, At, B1); PG8_BAR; PG8_SCHED;
            PG8_LDB(B0, 1, 0); PG8_LDB(B1, 1, 1); PG8_SCHED; PG8_LDA(At, 1, 0); PG8_STAGE2(PG8_SA(0, 1), a2, vA[1][0], vA[1][1]);
            PG8_WAIT_V(8); PG8_WAIT_L(0); PG8_BAR; PG8_MMA(0, 0, At, B0); PG8_MMA(0, 1, At, B1); PG8_BAR; PG8_SCHED;
            PG8_LDA(At, 1, 1); PG8_STAGEB(PG8_SB(1, 0), b3); PG8_STAGEB(PG8_SB(1, 1), b3 + hstep); PG8_STAGE2(PG8_SA(1, 0), a3, vA[0][0], vA[0][1]);
            PG8_WAIT_V(8); PG8_WAIT_L(0); PG8_BAR; PG8_MMA(1, 0, At, B0); PG8_MMA(1, 1, At, B1); PG8_BAR; PG8_SCHED;
        }
        if (wr == 0) PG8_BAR;
        if constexpr (FP8) asm volatile("s_nop 15\n\ts_nop 15" ::: "memory");
        E(acc, cur, wr, wc, fr, fq);
        if (!has_next) break;
#pragma unroll
        for (int a = 0; a < 2; ++a)
#pragma unroll
            for (int b = 0; b < 2; ++b)
#pragma unroll
                for (int m = 0; m < 4; ++m)
#pragma unroll
                    for (int n = 0; n < 2; ++n) acc[a][b][m][n] = (f32x4){0.f, 0.f, 0.f, 0.f};
        cur = nxt; cA = nA; cB = nB; ++ui;
        if (wr == 1) PG8_BAR;
    }
    PG8_WAIT_V(0);
    PG8_BAR;
#undef PG8_SA
#undef PG8_SB
#undef PG8_STAGE2
#undef PG8_STAGEB
#undef PG8_LDA
#undef PG8_LD8
#undef PG8_LDB
#undef PG8_MMA
#undef PG8_WAIT_V
#undef PG8_WAIT_L
#undef PG8_BAR
#undef PG8_SCHED
}
}
using pg8::Unit;

__device__ __forceinline__ size_t tm_off(int m, int ch) { return ((((size_t)(m >> 6) * 128 + (ch >> 4)) * 64 + (m & 63)) * 16 + (ch & 15)); }
typedef f32x4 Acc[2][2][4][2];
__device__ __forceinline__ u32x4 pack8(f32x4 a, f32x4 b) { return (u32x4){cvt_pk_bf16(a[0], a[1]), cvt_pk_bf16(a[2], a[3]), cvt_pk_bf16(b[0], b[1]), cvt_pk_bf16(b[2], b[3])}; }

__device__ __forceinline__ u32x2 pack8_fp8(f32x4 a, f32x4 b) { int w0 = 0, w1 = 0;
    w0 = __builtin_amdgcn_cvt_pk_fp8_f32(a[0], a[1], w0, false); w0 = __builtin_amdgcn_cvt_pk_fp8_f32(a[2], a[3], w0, true);
    w1 = __builtin_amdgcn_cvt_pk_fp8_f32(b[0], b[1], w1, false); w1 = __builtin_amdgcn_cvt_pk_fp8_f32(b[2], b[3], w1, true); return (u32x2){(unsigned)w0, (unsigned)w1}; }
struct EpiHgIn {
    static constexpr bool PERM = true;
    bf16_t* Q; float* LF; bf16_t* VI; bf16_t* GS; const float* lb; const float* gn;
    __device__ __forceinline__ void operator()(const Acc& acc, const Unit& u, int wr, int wc, int fr, int fq) const {
        const int type = u.pn >> 3, row0 = u.pm * 256 + wr * 64 + fr, col0 = (u.pn & 7) * 256 + wc * 32 + 8 * fq;
        if (type == 0 || type == 2) { bf16_t* O = type == 0 ? Q : VI;
#pragma unroll
            for (int ai = 0; ai < 2; ++ai)
#pragma unroll
                for (int m = 0; m < 4; ++m) { bf16_t* rowp = O + (size_t)(row0 + ai * 128 + m * 16) * D + col0;
#pragma unroll
                    for (int bj = 0; bj < 2; ++bj) *(u32x4*)(rowp + bj * 128) = pack8(acc[ai][bj][m][0], acc[ai][bj][m][1]); }
        } else if (type == 1) {
#pragma unroll
            for (int bj = 0; bj < 2; ++bj) { const f32x4 l0 = *(const f32x4*)(lb + col0 + bj * 128), l1 = *(const f32x4*)(lb + col0 + bj * 128 + 4);
#pragma unroll
                for (int ai = 0; ai < 2; ++ai)
#pragma unroll
                    for (int m = 0; m < 4; ++m) { _Float16* rowp = (_Float16*)LF + (size_t)(row0 + ai * 128 + m * 16) * D + col0 + bj * 128; f32x4 o0, o1;
#pragma unroll
                        for (int j = 0; j < 4; ++j) { o0[j] = __builtin_amdgcn_logf(1.f - (1.f - l0[j]) * sigmoidf_(-acc[ai][bj][m][0][j])) * 0.6931471805599453f; o1[j] = __builtin_amdgcn_logf(1.f - (1.f - l1[j]) * sigmoidf_(-acc[ai][bj][m][1][j])) * 0.6931471805599453f; }
                        typedef _Float16 h8 __attribute__((ext_vector_type(8)));
                        *(h8*)rowp = (h8){(_Float16)o0[0], (_Float16)o0[1], (_Float16)o0[2], (_Float16)o0[3], (_Float16)o1[0], (_Float16)o1[1], (_Float16)o1[2], (_Float16)o1[3]}; } }
        } else {
#pragma unroll
            for (int bj = 0; bj < 2; ++bj) { const f32x4 g0 = *(const f32x4*)(gn + col0 + bj * 128), g1 = *(const f32x4*)(gn + col0 + bj * 128 + 4);
#pragma unroll
                for (int ai = 0; ai < 2; ++ai)
#pragma unroll
                    for (int m = 0; m < 4; ++m) { bf16_t* rowp = GS + tm_off(row0 + ai * 128 + m * 16, col0 + bj * 128); f32x4 o0, o1;
#pragma unroll
                        for (int j = 0; j < 4; ++j) { o0[j] = siluf_(acc[ai][bj][m][0][j]) * g0[j]; o1[j] = siluf_(acc[ai][bj][m][1][j]) * g1[j]; }
                        *(u32x4*)rowp = pack8(o0, o1); } }
        }
    }
};
struct EpiNull {
    static constexpr bool PERM = false;
    __device__ __forceinline__ void operator()(const Acc& acc, const Unit& u, int wr, int wc, int fr, int fq) const {
#pragma unroll
        for (int ai = 0; ai < 2; ++ai)
#pragma unroll
            for (int bj = 0; bj < 2; ++bj)
#pragma unroll
                for (int m = 0; m < 4; ++m)
#pragma unroll
                    for (int n = 0; n < 2; ++n) asm volatile("" :: "v"(acc[ai][bj][m][n]));
    }
};
struct EpiF32 {
    static constexpr bool PERM = false;
    float* C; int ldc;
    __device__ __forceinline__ void operator()(const Acc& acc, const Unit& u, int wr, int wc, int fr, int fq) const {
        const int row0 = u.pm * 256 + wr * 64 + fr, col0 = u.pn * 256 + wc * 32 + 4 * fq;
#pragma unroll
        for (int ai = 0; ai < 2; ++ai)
#pragma unroll
            for (int m = 0; m < 4; ++m) { float* rowp = C + (size_t)(row0 + ai * 128 + m * 16) * ldc + col0;
#pragma unroll
                for (int bj = 0; bj < 2; ++bj)
#pragma unroll
                    for (int n = 0; n < 2; ++n) *(f32x4*)(rowp + bj * 128 + n * 16) = acc[ai][bj][m][n]; }
    }
};
struct EpiBf16 {
    static constexpr bool PERM = true;
    bf16_t* C; int ldc;
    __device__ __forceinline__ void operator()(const Acc& acc, const Unit& u, int wr, int wc, int fr, int fq) const {
        const int row0 = u.pm * 256 + wr * 64 + fr, col0 = u.pn * 256 + wc * 32 + 8 * fq;
#pragma unroll
        for (int ai = 0; ai < 2; ++ai)
#pragma unroll
            for (int m = 0; m < 4; ++m) { bf16_t* rowp = C + (size_t)(row0 + ai * 128 + m * 16) * ldc + col0;
#pragma unroll
                for (int bj = 0; bj < 2; ++bj) *(u32x4*)(rowp + bj * 128) = pack8(acc[ai][bj][m][0], acc[ai][bj][m][1]); }
    }
};
struct EpiGU {
    static constexpr bool PERM = true;
    bf16_t* ACT;
    __device__ __forceinline__ void operator()(const Acc& acc, const Unit& u, int wr, int wc, int fr, int fq) const {
        const int row0 = u.pm * 256 + wr * 64 + fr, col0 = u.pn * 128 + wc * 32 + 8 * fq;
#pragma unroll
        for (int ai = 0; ai < 2; ++ai)
#pragma unroll
            for (int m = 0; m < 4; ++m) { f32x4 o0, o1;
#pragma unroll
                for (int j = 0; j < 4; ++j) { o0[j] = siluf_(acc[ai][0][m][0][j]) * acc[ai][1][m][0][j]; o1[j] = siluf_(acc[ai][0][m][1][j]) * acc[ai][1][m][1][j]; }
                *(u32x4*)(ACT + (size_t)(row0 + ai * 128 + m * 16) * DFF + col0) = pack8(o0, o1); }
    }
};
struct EpiGU8 {
    static constexpr bool PERM = true;
    unsigned char* ACT;
    __device__ __forceinline__ void operator()(const Acc& acc, const Unit& u, int wr, int wc, int fr, int fq) const {
        const int row0 = u.pm * 256 + wr * 64 + fr, col0 = u.pn * 128 + wc * 32 + 8 * fq;
#pragma unroll
        for (int ai = 0; ai < 2; ++ai)
#pragma unroll
            for (int m = 0; m < 4; ++m) { f32x4 o0, o1;
#pragma unroll
                for (int j = 0; j < 4; ++j) { o0[j] = __builtin_amdgcn_fmed3f(siluf_(acc[ai][0][m][0][j]) * acc[ai][1][m][0][j], -448.f, 448.f); o1[j] = __builtin_amdgcn_fmed3f(siluf_(acc[ai][0][m][1][j]) * acc[ai][1][m][1][j], -448.f, 448.f); }
                *(u32x2*)(ACT + (size_t)(row0 + ai * 128 + m * 16) * DFF + col0) = pack8_fp8(o0, o1); }
    }
};
struct EpiLat {
    static constexpr bool PERM = true;
    bf16_t* CKV; bf16_t* QLAT; bf16_t* KR; float* SSC; float* SSQ; const float* COS; const float* SIN;
    __device__ __forceinline__ void operator()(const Acc& acc, const Unit& u, int wr, int wc, int fr, int fq) const {
        const int row0 = u.pm * 256 + wr * 64 + fr;
        if (u.e == 0 && u.pn == 2) {
            if (wc < 2) { const int j = 16 * wc + 4 * fq;
#pragma unroll
                for (int ai = 0; ai < 2; ++ai)
#pragma unroll
                    for (int m = 0; m < 4; ++m) { const int r = row0 + ai * 128 + m * 16; const f32x4 c = *(const f32x4*)(COS + (size_t)r * 32 + j), s = *(const f32x4*)(SIN + (size_t)r * 32 + j);
                        const f32x4 x1 = acc[ai][0][m][0], x2 = acc[ai][0][m][1]; const f32x4 o1 = x1 * c - x2 * s, o2 = x2 * c + x1 * s;
                        *(u32x2*)(KR + (size_t)r * 64 + j) = (u32x2){cvt_pk_bf16(o1[0], o1[1]), cvt_pk_bf16(o1[2], o1[3])};
                        *(u32x2*)(KR + (size_t)r * 64 + 32 + j) = (u32x2){cvt_pk_bf16(o2[0], o2[1]), cvt_pk_bf16(o2[2], o2[3])}; } }
            return;
        }
        bf16_t* O = u.e == 0 ? CKV : QLAT; float* SS = u.e == 0 ? SSC : SSQ;
        const int col0 = u.pn * 256 + wc * 32 + 8 * fq;
#pragma unroll
        for (int ai = 0; ai < 2; ++ai)
#pragma unroll
            for (int m = 0; m < 4; ++m) { const int r = row0 + ai * 128 + m * 16; float s = 0.f;
#pragma unroll
                for (int bj = 0; bj < 2; ++bj) { const f32x4 a = acc[ai][bj][m][0], b = acc[ai][bj][m][1];
                    s += (a[0] * a[0] + a[1] * a[1]) + (a[2] * a[2] + a[3] * a[3]) + (b[0] * b[0] + b[1] * b[1]) + (b[2] * b[2] + b[3] * b[3]);
                    *(u32x4*)(O + (size_t)r * 512 + col0 + bj * 128) = pack8(a, b); }
                s += __shfl_xor(s, 16); s += __shfl_xor(s, 32);
                if (fq == 0) SS[(size_t)r * 8 + u.pn * 4 + wc] = s; }
    }
};
struct EpiKvQ {
    static constexpr bool PERM = true;
    bf16_t* KN; bf16_t* V; bf16_t* QN; bf16_t* QR; const float* SSC; const float* SSQ; const float* COS; const float* SIN;
    __device__ __forceinline__ void operator()(const Acc& acc, const Unit& u, int wr, int wc, int fr, int fq) const {
        const int row0 = u.pm * 256 + wr * 64 + fr; const float* SS = u.e == 0 ? SSC : SSQ;
#pragma unroll
        for (int ai = 0; ai < 2; ++ai)
#pragma unroll
            for (int m = 0; m < 4; ++m) { const int r = row0 + ai * 128 + m * 16, b = r >> 13, s = r & (SEQ - 1);
                const f32x4 p0 = *(const f32x4*)(SS + (size_t)r * 8), p1 = *(const f32x4*)(SS + (size_t)r * 8 + 4);
                const float rstd = rsqrtf(((p0[0] + p0[1]) + (p0[2] + p0[3]) + (p1[0] + p1[1]) + (p1[2] + p1[3])) * (1.0f / 512.0f) + EPS);
                if (u.e == 0) { const size_t o = ((size_t)(b * MLA_H + u.pn) * SEQ + s) * 128 + wc * 32 + 8 * fq;
                    *(u32x4*)(KN + o) = pack8(acc[ai][0][m][0] * rstd, acc[ai][0][m][1] * rstd); *(u32x4*)(V + o) = pack8(acc[ai][1][m][0] * rstd, acc[ai][1][m][1] * rstd); }
                else if (u.pn < 8) {
#pragma unroll
                    for (int bj = 0; bj < 2; ++bj) { const size_t o = ((size_t)(b * MLA_H + 2 * u.pn + bj) * SEQ + s) * 128 + wc * 32 + 8 * fq;
                        *(u32x4*)(QN + o) = pack8(acc[ai][bj][m][0] * rstd, acc[ai][bj][m][1] * rstd); } }
                else { const int j = 16 * (wc & 1) + 4 * fq; const f32x4 c = *(const f32x4*)(COS + (size_t)r * 32 + j), sn = *(const f32x4*)(SIN + (size_t)r * 32 + j);
#pragma unroll
                    for (int bj = 0; bj < 2; ++bj) { const int head = 4 * (u.pn - 8) + 2 * bj + (wc >> 1); const size_t o = ((size_t)(b * MLA_H + head) * SEQ + s) * 64 + j;
                        const f32x4 x1 = acc[ai][bj][m][0] * rstd, x2 = acc[ai][bj][m][1] * rstd; const f32x4 o1 = x1 * c - x2 * sn, o2 = x2 * c + x1 * sn;
                        *(u32x2*)(QR + o) = (u32x2){cvt_pk_bf16(o1[0], o1[1]), cvt_pk_bf16(o1[2], o1[3])};
                        *(u32x2*)(QR + o + 32) = (u32x2){cvt_pk_bf16(o2[0], o2[1]), cvt_pk_bf16(o2[2], o2[3])}; } }
            }
    }
};

struct Args { const void* in[25]; float* out; unsigned char* ws; int ph_lo, ph_hi; };
enum { I_X = 0, I_C, I_POS, I_ADAW, I_ADAB, I_NORMG, I_HGWIN, I_HGLB, I_HGONG, I_HGWOUT, I_KVNG, I_KVADAW, I_KVADAB, I_WKVA, I_KVNORMG, I_WKVB, I_WQA, I_QNORMG, I_WQB, I_WO,
       I_FGU, I_FDN, I_ROUTER, I_MGU, I_MDN };
struct Frame { LAS unsigned char* lds; int tid, lane, wave, G, bid; const Args* a; unsigned char* ws; unsigned* ctl; bool probe_rep; };
#define INF(k) ((const float*)F.a->in[k])

__device__ __forceinline__ const float* modp(const Frame& F, int which, int part, int b) { return (const float*)(F.ws + WS_MOD) + (size_t)b * NMOD + (which < 4 ? which * 6144 : 24576) + part * 2048; }
__device__ __forceinline__ const float* normg(const Frame& F, int layer, int sub, int which) { return INF(I_NORMG) + ((layer * 2 + sub) * 2 + which) * 2048; }

__device__ __forceinline__ void p_mod(const Frame& F) {
    LAS float* scv = (LAS float*)F.lds;
    LAS float* red = (LAS float*)(F.lds + 16384);
    for (int it = F.bid; it < 224; it += F.G) {
        __syncthreads();
        for (int i = F.tid; i < 2 * D; i += 512) scv[i] = siluf_(INF(I_C)[i]);
        __syncthreads();
        const float* W; const float* bias; int N, col0, obase;
        if (it < 192) { const int mi = it / 48; W = INF(I_ADAW) + (size_t)mi * D * 6144; bias = INF(I_ADAB) + mi * 6144; N = 6144; col0 = (it % 48) * 128; obase = mi * 6144; }
        else { W = INF(I_KVADAW); bias = INF(I_KVADAB); N = 4096; col0 = (it - 192) * 128; obase = 24576; }
        const int half = F.lane >> 5, cq = F.lane & 31;
        const float* wp = W + (size_t)(256 * F.wave + half) * N + col0 + 4 * cq;
        f32x4 a0 = {0.f, 0.f, 0.f, 0.f}, a1 = a0;
#pragma unroll 16
        for (int i = 0; i < 128; ++i) { const f32x4 v = *(const f32x4*)(wp + (size_t)(2 * i) * N); const int k = 256 * F.wave + 2 * i + half; a0 += v * scv[k]; a1 += v * scv[D + k]; }
        const int slot = F.wave * 2 + half;
        *(LAS f32x4*)(red + (slot * 2 + 0) * 128 + 4 * cq) = a0; *(LAS f32x4*)(red + (slot * 2 + 1) * 128 + 4 * cq) = a1;
        __syncthreads();
        if (F.tid < 256) { const int b = F.tid >> 7, col = F.tid & 127; float s = bias[col0 + col];
#pragma unroll
            for (int p = 0; p < 16; ++p) s += red[(p * 2 + b) * 128 + col];
            ((float*)(F.ws + WS_MOD))[(size_t)b * NMOD + obase + col0 + col] = s; }
    }
    const int gtid = F.bid * 512 + F.tid, gn = F.G * 512;
    for (int i = gtid; i < D; i += gn) { const float l0 = INF(I_HGLB)[i], l1 = INF(I_HGLB)[D + i]; ((float*)(F.ws + WS_LB))[i] = 1.0f / (1.0f + expf(l1 - l0)); }
    for (int p = gtid; p < M * 32; p += gn) { const int m = p >> 5, j = p & 31; const float pos = (float)((const int*)F.a->in[I_POS])[m];
        const float inv = 1.0f / powf(10000.0f, (float)(2 * j) / 64.0f); const float ang = pos * inv; float s_, c_; sincosf(ang, &s_, &c_);
        ((float*)(F.ws + WS_COS))[p] = c_; ((float*)(F.ws + WS_SIN))[p] = s_; }
}

__device__ __forceinline__ int rope_dest(int p) { return 32 * ((p >> 4) & 1) + 8 * ((p >> 2) & 3) + 4 * (p >> 5) + (p & 3); }
__device__ __forceinline__ int dest_row(int kind, int c) {
    if (kind == 0) return c;
    if (kind == 1) { const int b = c >= DFF ? 1 : 0, j = c - b * DFF; return (j >> 7) * 256 + b * 128 + (j & 127); }
    if (kind == 2) return c < 512 ? c : 512 + rope_dest(c - 512);
    const int h = c / 192, j = c - h * 192; return j < 128 ? h * 128 + j : 2048 + h * 64 + rope_dest(j - 128);
}
__device__ __forceinline__ void conv_item(const float* W, int K, int N, bf16_t* WT, int kind, const float* gsc, LAS float* scr, int item, int lane) {
    const int nblk = N / 32, kb = item / nblk, nb = item % nblk, k0 = 64 * kb, n0 = 32 * nb;
#pragma unroll 8
    for (int i = 0; i < 32; ++i) { const int kk = 2 * i + (lane >> 5); float v = W[(size_t)(k0 + kk) * N + n0 + (lane & 31)]; if (gsc) v *= gsc[k0 + kk]; scr[kk * 33 + (lane & 31)] = v; }
    asm volatile("s_waitcnt lgkmcnt(0)" ::: "memory");
    const int c = lane & 7;
#pragma unroll
    for (int j = 0; j < 4; ++j) { const int n = (lane >> 3) + 8 * j; const LAS float* s = scr + (8 * c) * 33 + n;
        u32x4 o; o.x = cvt_pk_bf16(s[0 * 33], s[1 * 33]); o.y = cvt_pk_bf16(s[2 * 33], s[3 * 33]); o.z = cvt_pk_bf16(s[4 * 33], s[5 * 33]); o.w = cvt_pk_bf16(s[6 * 33], s[7 * 33]);
        *(u32x4*)(WT + (size_t)dest_row(kind, n0 + n) * K + k0 + 8 * c) = o; }
    asm volatile("s_waitcnt lgkmcnt(0)" ::: "memory");
}
__device__ __forceinline__ void conv_item8(const float* W, int K, int N, unsigned char* WT, int kind, LAS float* scr, int item, int lane) {
    const int nblk = N / 32, kb = item / nblk, nb = item % nblk, k0 = 64 * kb, n0 = 32 * nb;
#pragma unroll 8
    for (int i = 0; i < 32; ++i) { const int kk = 2 * i + (lane >> 5); scr[kk * 33 + (lane & 31)] = W[(size_t)(k0 + kk) * N + n0 + (lane & 31)] * pg8::W8_SCALE; }
    asm volatile("s_waitcnt lgkmcnt(0)" ::: "memory");
    const int c = lane & 7;
#pragma unroll
    for (int j = 0; j < 4; ++j) { const int n = (lane >> 3) + 8 * j; const LAS float* s = scr + (8 * c) * 33 + n;
        const f32x4 a = {s[0 * 33], s[1 * 33], s[2 * 33], s[3 * 33]}, b = {s[4 * 33], s[5 * 33], s[6 * 33], s[7 * 33]};
        *(u32x2*)(WT + (size_t)dest_row(kind, n0 + n) * K + k0 + 8 * c) = pack8_fp8(a, b); }
    asm volatile("s_waitcnt lgkmcnt(0)" ::: "memory");
}
constexpr int MOE_I_GU = (D / 64) * (2 * DFF / 128), MOE_I_DN = (DFF / 64) * (D / 128), MOE_I_E = MOE_I_GU + MOE_I_DN, MOE_ITEMS = NEXP * MOE_I_E;
__device__ __forceinline__ void conv_moe_item(const Frame& F, int g) {
    const int lane = F.lane, nq = lane & 31, half = lane >> 5; const int e = g / MOE_I_E; int r = g - e * MOE_I_E;
    const float* W; unsigned char* dst; int K, N, kind;
    if (r < MOE_I_GU) { W = INF(I_MGU) + (size_t)e * D * 2 * DFF; K = D; N = 2 * DFF; dst = F.ws + W_MGU + (size_t)e * 2 * DFF * D; kind = 1; }
    else { r -= MOE_I_GU; W = INF(I_MDN) + (size_t)e * DFF * D; K = DFF; N = D; dst = F.ws + W_MDN + (size_t)e * D * DFF; kind = 0; }
    const int nkb = K / 64, nb = r / nkb, kb = r - nb * nkb, k0 = 64 * kb, n0 = 128 * nb;
    const float* wp = W + (size_t)(k0 + 32 * half) * N + n0 + 4 * nq; f32x4 v[32];
#pragma unroll
    for (int i = 0; i < 32; ++i) v[i] = *(const f32x4*)(wp + (size_t)i * N);
    LAS unsigned char* t = F.lds + F.wave * 16384;
#pragma unroll
    for (int j = 0; j < 4; ++j)
#pragma unroll
        for (int c = 0; c < 4; ++c) { const f32x4 a = (f32x4){v[8 * c][j], v[8 * c + 1][j], v[8 * c + 2][j], v[8 * c + 3][j]} * pg8::W8_SCALE, b = (f32x4){v[8 * c + 4][j], v[8 * c + 5][j], v[8 * c + 6][j], v[8 * c + 7][j]} * pg8::W8_SCALE;
            *(LAS u32x2*)(t + (4 * nq + j) * 72 + 32 * half + 8 * c) = pack8_fp8(a, b); }
    asm volatile("s_waitcnt lgkmcnt(0)" ::: "memory");
    const int c8 = lane & 7;
#pragma unroll
    for (int jj = 0; jj < 16; ++jj) { const int n = (lane >> 3) + 8 * jj;
        *(u32x2*)(dst + (size_t)dest_row(kind, n0 + n) * K + k0 + 8 * c8) = *(const LAS u32x2*)(t + n * 72 + 8 * c8); }
    asm volatile("s_waitcnt lgkmcnt(0)" ::: "memory");
}
__device__ __forceinline__ void conv_moe_part(const Frame& F, int part, int nparts) {
    const int gw = F.bid * 8 + F.wave, NGW = F.G * 8, per = (MOE_ITEMS + NGW - 1) / NGW, chunk = (per + nparts - 1) / nparts;
    const int k0 = part * chunk, k1 = (k0 + chunk < per) ? k0 + chunk : per;
    for (int k = k0; k < k1; ++k) { const int g = gw + k * NGW; if (g < MOE_ITEMS) conv_moe_item(F, g); }
}
__device__ __forceinline__ void p_conv(const Frame& F) {
    LAS float* scr = (LAS float*)(F.lds + F.wave * 16384);
    const long gw = (long)F.bid * 8 + F.wave, NGW = (long)F.G * 8;
    struct Mt { const float* W; int K, N; size_t dst; int kind; const float* g; };
    auto run = [&](const float* W, int K, int N, size_t dst, int kind, const float* g) { const long n = (long)(K / 64) * (N / 32);
        for (long it = gw; it < n; it += NGW) conv_item(W, K, N, (bf16_t*)(F.ws + dst), kind, g, scr, (int)it, F.lane); };
    run(INF(I_HGWIN), D, 8192, W_IN, 0, nullptr);
    run(INF(I_HGWOUT), D, D, W_OUT, 0, nullptr);
    run(INF(I_FGU), D, 2 * DFF, W_GU, 1, nullptr);
    run(INF(I_FDN), DFF, D, W_DN, 0, nullptr);
    run(INF(I_WKVA), D, 576, W_LAT, 2, nullptr);
    run(INF(I_WQA), D, 512, W_LAT + (size_t)768 * D * 2, 0, nullptr);
    run(INF(I_WKVB), 512, 4096, W_KVQ, 0, INF(I_KVNORMG));
    run(INF(I_WQB), 512, 3072, W_KVQ + (size_t)4096 * 512 * 2, 3, INF(I_QNORMG));
    run(INF(I_WO), D, D, W_O, 0, nullptr);
}

struct Row { f32x4 v[8]; };
__device__ __forceinline__ void row_ld(Row& r, const float* p, int lane) {
#pragma unroll
    for (int j = 0; j < 8; ++j) r.v[j] = __builtin_nontemporal_load((const f32x4*)(p + 4 * lane + 256 * j));
}
__device__ __forceinline__ void row_ld_bf(Row& r, const bf16_t* p, int lane) {
#pragma unroll
    for (int j = 0; j < 8; ++j) { const u32x2 w = __builtin_nontemporal_load((const u32x2*)(p + 4 * lane + 256 * j)); r.v[j] = (f32x4){bflo(w[0]), bfhi(w[0]), bflo(w[1]), bfhi(w[1])}; }
}
__device__ __forceinline__ float row_ss(const Row& r) { float s = 0.f;
#pragma unroll
    for (int j = 0; j < 8; ++j) s += (r.v[j][0] * r.v[j][0] + r.v[j][1] * r.v[j][1]) + (r.v[j][2] * r.v[j][2] + r.v[j][3] * r.v[j][3]);
    return wave_sum(s); }
template <bool F8 = false>
__device__ __forceinline__ void row_mod_store(const Row& h, float rstd, const LAS float* gs, const LAS float* sh, bf16_t* o, int lane, Row* keep) {
#pragma unroll
    for (int j = 0; j < 8; ++j) { const int c = 4 * lane + 256 * j; const f32x4 gv = *(const LAS f32x4*)(gs + c), hv = *(const LAS f32x4*)(sh + c);
        const f32x4 u = h.v[j] * rstd * gv + hv; if (keep) keep->v[j] = u;
        if (F8) { int w = 0; w = __builtin_amdgcn_cvt_pk_fp8_f32(u[0], u[1], w, false); w = __builtin_amdgcn_cvt_pk_fp8_f32(u[2], u[3], w, true); *(int*)((unsigned char*)o + c) = w; }
        else *(u32x2*)(o + c) = (u32x2){cvt_pk_bf16(u[0], u[1]), cvt_pk_bf16(u[2], u[3])}; }
}
template <int MODE> __device__ __forceinline__ void p_thin(const Frame& F) {
    const int lane = F.lane; float* out = F.a->out;
    LAS float* T_GG = (LAS float*)F.lds; LAS float* T_GS = T_GG + 4096; LAS float* T_SH = T_GS + 4096; LAS float* T_KGS = T_SH + 4096; LAS float* T_KSH = T_KGS + 4096;
    LAS float* wr = T_SH + 4096;
    __syncthreads();
    for (int i = F.tid; i < 2 * D; i += 512) { const int b = i >> 11, c = i & (D - 1);
        if (MODE >= 1) { const int mw = MODE - 1; T_GG[i] = modp(F, mw, 2, b)[c] * normg(F, mw >> 1, mw & 1, 1)[c]; }
        if (MODE <= 3) { T_GS[i] = normg(F, MODE >> 1, MODE & 1, 0)[c] * (1.0f + modp(F, MODE, 1, b)[c]); T_SH[i] = modp(F, MODE, 0, b)[c]; }
        if (MODE == 2) { T_KGS[i] = INF(I_KVNG)[c] * (1.0f + modp(F, 4, 1, b)[c]); T_KSH[i] = modp(F, 4, 0, b)[c]; } }
    if (MODE == 3) { const float* w = INF(I_ROUTER); for (int i = F.tid; i < D * NEXP; i += 512) wr[i] = w[i]; }
    __syncthreads();
    int tst[NEXP];
    if (MODE == 4) { int t = 0;
#pragma unroll
        for (int e = 0; e < NEXP; ++e) { tst[e] = t * 256; t += ((int)F.ctl[CW_CNT + 64 * e] + 255) >> 8; } }
    for (int m = F.bid * 8 + F.wave; m < M; m += F.G * 8) {
        const int b = m >> 13, tb = b * D; Row h;
        if (MODE == 0) row_ld(h, INF(I_X) + (size_t)m * D, lane);
        else {
            Row y; float escale = EPS;
            if (MODE == 4) { const int4 tk = ((const int4*)(F.ws + WS_TOK))[m]; const float w0 = __int_as_float(tk.z), w1 = __int_as_float(tk.w);
                int o0 = 0, o1 = 0;
#pragma unroll
                for (int e = 0; e < NEXP; ++e) { o0 = ((tk.x & 15) == e) ? tst[e] : o0; o1 = ((tk.y & 15) == e) ? tst[e] : o1; }
                const bf16_t* y0 = (const bf16_t*)(F.ws + B_Y2) + (size_t)(o0 + (tk.x >> 4)) * D; const bf16_t* y1 = (const bf16_t*)(F.ws + B_Y2) + (size_t)(o1 + (tk.y >> 4)) * D;
                Row ya; row_ld_bf(ya, y0, lane); row_ld_bf(y, y1, lane);
#pragma unroll
                for (int j = 0; j < 8; ++j) y.v[j] = ya.v[j] * w0 + y.v[j] * w1;
            } else row_ld_bf(y, (const bf16_t*)(F.ws + WS_Y) + (size_t)m * D, lane);
            if (MODE == 1) { const float* ss = (const float*)(F.ws + WS_SSO) + (size_t)m * 128; const float so = wave_sum(ss[lane] + ss[64 + lane]) * (1.0f / D); escale = EPS * (so + EPS); }
            bf16_t* xr = (bf16_t*)(F.ws + WS_XR) + (size_t)m * D;
            if (MODE == 1) row_ld(h, INF(I_X) + (size_t)m * D, lane); else row_ld_bf(h, xr, lane);
            const float rstd = rsqrtf(row_ss(y) * (1.0f / D) + escale);
#pragma unroll
            for (int j = 0; j < 8; ++j) { const int c = 4 * lane + 256 * j; const f32x4 gg = *(const LAS f32x4*)(T_GG + tb + c);
                h.v[j] = h.v[j] + gg * (y.v[j] * rstd);
                if (MODE == 4) __builtin_nontemporal_store(h.v[j], (f32x4*)(out + (size_t)m * D + c));
                else *(u32x2*)(xr + c) = (u32x2){cvt_pk_bf16(h.v[j][0], h.v[j][1]), cvt_pk_bf16(h.v[j][2], h.v[j][3])}; }
        }
        if (MODE == 4) continue;
        const float rstd = rsqrtf(row_ss(h) * (1.0f / D) + EPS);
        if (MODE == 2) row_mod_store(h, rstd, T_KGS + tb, T_KSH + tb, (bf16_t*)(F.ws + WS_XS) + (size_t)m * D, lane, nullptr);
        Row u;
        if (MODE == 3) row_mod_store<true>(h, rstd, T_GS + tb, T_SH + tb, (bf16_t*)(F.ws + WS_U + (size_t)m * D), lane, &u);
        else row_mod_store(h, rstd, T_GS + tb, T_SH + tb, (bf16_t*)(F.ws + WS_U) + (size_t)m * D, lane, nullptr);
        if (MODE == 3) {
            float lg[NEXP];
#pragma unroll
            for (int e = 0; e < NEXP; ++e) lg[e] = 0.f;
#pragma unroll
            for (int j = 0; j < 8; ++j) { asm volatile("" ::: "memory");
#pragma unroll
                for (int c = 0; c < 4; ++c) { const int i = 4 * lane + 256 * j + c; const f32x4 w0 = *(const LAS f32x4*)(wr + i * 8), w1 = *(const LAS f32x4*)(wr + i * 8 + 4); const float x = u.v[j][c];
                    lg[0] += x * w0[0]; lg[1] += x * w0[1]; lg[2] += x * w0[2]; lg[3] += x * w0[3]; lg[4] += x * w1[0]; lg[5] += x * w1[1]; lg[6] += x * w1[2]; lg[7] += x * w1[3]; } }
#pragma unroll
            for (int e = 0; e < NEXP; ++e) lg[e] = wave_sum(lg[e]);
            int e0 = 0; float v0 = lg[0];
#pragma unroll
            for (int e = 1; e < NEXP; ++e) if (lg[e] > v0) { v0 = lg[e]; e0 = e; }
            int e1 = e0 == 0 ? 1 : 0; float v1 = lg[e1];
#pragma unroll
            for (int e = 0; e < NEXP; ++e) if (e != e0 && lg[e] > v1) { v1 = lg[e]; e1 = e; }
            if (lane == 0) { const float p1 = __expf(v1 - v0), w0 = 1.0f / (1.0f + p1), w1 = p1 * w0;
                const int s0 = (int)atomicAdd(F.ctl + CW_CNT + 64 * e0, 1u), s1 = (int)atomicAdd(F.ctl + CW_CNT + 64 * e1, 1u);
                int* list = (int*)(F.ws + WS_LIST); list[(size_t)e0 * M + s0] = m; list[(size_t)e1 * M + s1] = m;
                ((int4*)(F.ws + WS_TOK))[m] = make_int4(e0 | (s0 << 4), e1 | (s1 << 4), __float_as_int(w0), __float_as_int(w1)); }
        }
    }
}

#define MFMA16(X, Y, C) __builtin_amdgcn_mfma_f32_16x16x32_bf16((X), (Y), (C), 0, 0, 0)
__device__ __forceinline__ float expc(float x) { return __expf(fminf(x, 80.0f)); }
__device__ __forceinline__ int hg_tiled(int r, int seg) { return (((r >> 4) * 2 + (seg >> 1)) * 64 + (2 * (seg & 1)) * 16 + (r & 15)) * 8; }
__device__ __forceinline__ void p_hg_chunk(const Frame& F) {
    constexpr int RS = 272, TS = 144;
    LAS unsigned char* QA = F.lds; LAS unsigned char* QB = QA + 64 * RS; LAS unsigned char* KA = QB + 32 * RS; LAS unsigned char* KB = KA + 32 * RS;
    LAS unsigned char* VS = KB + 64 * RS; LAS unsigned char* VT = VS + 64 * RS; LAS unsigned char* PS = VT + 128 * TS; LAS float* TOT = (LAS float*)(PS + 64 * TS);
    const int tid = F.tid, lane = F.lane, w = F.wave, ch = tid & 127, seg = tid >> 7, fr = lane & 15, fq = lane >> 4;
    const _Float16* LFg = (const _Float16*)(F.ws + B_LF); const bf16_t* Qg = (const bf16_t*)(F.ws + B_Q); const bf16_t* VIg = (const bf16_t*)(F.ws + B_VI);
    for (int unit = F.bid; unit < 4096; unit += F.G) {
        const int bh = unit >> 7, c = unit & 127, b = bh >> 4, h = bh & 15, m0 = b * SEQ + 64 * c, k0 = 128 * h;
        float lf[16], qv[16];
#pragma unroll
        for (int i = 0; i < 16; ++i) { const size_t o = (size_t)(m0 + 16 * seg + i) * D + k0 + ch; lf[i] = (float)LFg[o]; qv[i] = bf2f(Qg[o]); }
#pragma unroll
        for (int p = 0; p < 2; ++p) { const int piece = tid + 512 * p, s = piece >> 4, v8 = (piece & 15) * 8; *(LAS u32x4*)(VS + s * RS + v8 * 2) = *(const u32x4*)(VIg + (size_t)(m0 + s) * D + k0 + v8); }
        float bcs[16]; float run = 0.f;
#pragma unroll
        for (int i = 0; i < 16; ++i) { run += lf[i]; bcs[i] = run; }
        TOT[seg * 128 + ch] = run;
        __syncthreads();
        const float t0 = TOT[ch], t1 = TOT[128 + ch], t2 = TOT[256 + ch], t3 = TOT[384 + ch];
        const float pre = seg == 0 ? 0.f : seg == 1 ? t0 : seg == 2 ? t0 + t1 : t0 + t1 + t2, r1 = t0 + t1, bl = r1 + t2 + t3;
        unsigned kh[8];
#pragma unroll
        for (int i = 0; i < 16; i += 2) { float kv[2];
#pragma unroll
            for (int z = 0; z < 2; ++z) { const int t = 16 * seg + i + z; const float bb = bcs[i + z] + pre, kk = 1.0f - __expf(lf[i + z]), q = qv[i + z];
                *(LAS bf16_t*)(QA + t * RS + ch * 2) = f2bf(q * expc(bb));
                if (seg >= 2) *(LAS bf16_t*)(QB + (t - 32) * RS + ch * 2) = f2bf(q * expc(bb - r1));
                if (seg < 2) *(LAS bf16_t*)(KA + t * RS + ch * 2) = f2bf(kk * expc(-bb));
                *(LAS bf16_t*)(KB + t * RS + ch * 2) = f2bf(kk * expc(r1 - bb));
                kv[z] = kk * expc(bl - bb); }
            kh[i >> 1] = cvt_pk_bf16(kv[0], kv[1]); }
        { bf16_t* kt = (bf16_t*)(F.ws + B_KT) + (size_t)unit * 8192 + hg_tiled(ch, seg); *(u32x4*)kt = (u32x4){kh[0], kh[1], kh[2], kh[3]}; *(u32x4*)(kt + 128) = (u32x4){kh[4], kh[5], kh[6], kh[7]}; }
        if (seg == 3) ((float*)(F.ws + B_DEC))[(size_t)unit * 128 + ch] = expc(bl);
        { unsigned vv[8];
#pragma unroll
            for (int i = 0; i < 16; i += 2) { const unsigned lo = *(const LAS bf16_t*)(VS + (16 * seg + i) * RS + ch * 2), hi = *(const LAS bf16_t*)(VS + (16 * seg + i + 1) * RS + ch * 2); vv[i >> 1] = lo | (hi << 16); }
            const u32x4 a = {vv[0], vv[1], vv[2], vv[3]}, bq = {vv[4], vv[5], vv[6], vv[7]};
            *(LAS u32x4*)(VT + ch * TS + 32 * seg) = a; *(LAS u32x4*)(VT + ch * TS + 32 * seg + 16) = bq;
            bf16_t* vt = (bf16_t*)(F.ws + B_VT) + (size_t)unit * 8192 + hg_tiled(ch, seg); *(u32x4*)vt = a; *(u32x4*)(vt + 128) = bq; }
        __syncthreads();
#pragma unroll
        for (int p = 0; p < 2; ++p) { const int piece = tid + 512 * p, ww = piece >> 7, pp = (piece >> 6) & 1, ln = piece & 63, r_ = ln & 15, q_ = ln >> 4;
            const u32x2 lo = *(const LAS u32x2*)(QA + (32 * pp + r_) * RS + (16 * ww + 4 * q_) * 2), hi = *(const LAS u32x2*)(QA + (32 * pp + 16 + r_) * RS + (16 * ww + 4 * q_) * 2);
            *(u32x4*)((bf16_t*)(F.ws + B_QH) + (size_t)unit * 8192 + piece * 8) = (u32x4){lo[0], lo[1], hi[0], hi[1]}; }
        { const int tt = w >> 2, st = w & 3; f32x4 acc = {0.f, 0.f, 0.f, 0.f};
#pragma unroll
            for (int kb = 0; kb < 4; ++kb) acc = MFMA16(*(const LAS bf16x8*)(KB + (16 * st + fr) * RS + (32 * kb + 8 * fq) * 2), *(const LAS bf16x8*)(QB + (16 * tt + fr) * RS + (32 * kb + 8 * fq) * 2), acc);
            const int ta = 32 + 16 * tt + fr, sa = 16 * st + 4 * fq;
#pragma unroll
            for (int j = 0; j < 4; ++j) if (sa + j > ta) acc[j] = 0.f;
            *(LAS u32x2*)(PS + ta * TS + sa * 2) = (u32x2){cvt_pk_bf16(acc[0], acc[1]), cvt_pk_bf16(acc[2], acc[3])}; }
        if (w < 4) { const int tt = w >> 1, st = w & 1; f32x4 acc = {0.f, 0.f, 0.f, 0.f};
#pragma unroll
            for (int kb = 0; kb < 4; ++kb) acc = MFMA16(*(const LAS bf16x8*)(KA + (16 * st + fr) * RS + (32 * kb + 8 * fq) * 2), *(const LAS bf16x8*)(QA + (16 * tt + fr) * RS + (32 * kb + 8 * fq) * 2), acc);
            const int ta = 16 * tt + fr, sa = 16 * st + 4 * fq;
#pragma unroll
            for (int j = 0; j < 4; ++j) if (sa + j > ta) acc[j] = 0.f;
            *(LAS u32x2*)(PS + ta * TS + sa * 2) = (u32x2){cvt_pk_bf16(acc[0], acc[1]), cvt_pk_bf16(acc[2], acc[3])}; }
        __syncthreads();
#pragma unroll
        for (int tt = 0; tt < 4; ++tt) { f32x4 acc = {0.f, 0.f, 0.f, 0.f};
#pragma unroll
            for (int sb = 0; sb < 2; ++sb) if (sb == 0 || tt >= 2) acc = MFMA16(*(const LAS bf16x8*)(VT + (16 * w + fr) * TS + (32 * sb + 8 * fq) * 2), *(const LAS bf16x8*)(PS + (16 * tt + fr) * TS + (32 * sb + 8 * fq) * 2), acc);
            *(u32x2*)((bf16_t*)(F.ws + B_OI) + tm_off(m0 + 16 * tt + fr, k0 + 16 * w + 4 * fq)) = (u32x2){cvt_pk_bf16(acc[0], acc[1]), cvt_pk_bf16(acc[2], acc[3])}; }
        __syncthreads();
    }
}
__device__ __forceinline__ void p_hg_scan(const Frame& F) {
    LAS f32x4* red = (LAS f32x4*)F.lds;
    const int tid = F.tid, lane = F.lane, w = F.wave, fr = lane & 15, fq = lane >> 4;
    const bf16_t* QH = (const bf16_t*)(F.ws + B_QH); const bf16_t* KT = (const bf16_t*)(F.ws + B_KT); const bf16_t* VT = (const bf16_t*)(F.ws + B_VT); const float* DEC = (const float*)(F.ws + B_DEC);
    const bf16_t* OI = (const bf16_t*)(F.ws + B_OI); const bf16_t* GS = (const bf16_t*)(F.ws + B_GS); bf16_t* OG = (bf16_t*)(F.ws + B_OG); float* SSO = (float*)(F.ws + WS_SSO);
    for (int ui = F.bid; ui < 256; ui += F.G) {
        const int unit = (F.G == 256) ? (((ui & 7) * 4 + (ui >> 6)) * 8 + ((ui >> 3) & 7)) : ui;
        const int bh = unit >> 3, vs = unit & 7, b = bh >> 4, h = bh & 15;
        const int tt2 = (tid >> 6) & 3;
        const size_t rowoff = tm_off(b * SEQ + 16 * tt2 + fr, 128 * h + 16 * vs + 4 * fq);
        f32x4 S = {0.f, 0.f, 0.f, 0.f};
        u32x4 qA[2], qB[2]; u32x2 gsA, gsB, oiA, oiB; bf16x8 ktA[2], ktB[2], vtA[2], vtB[2]; f32x4 dA, dB;
#define HG_LOAD(q_, kt_, vt_, d_, oi_, gs_, cc) do { const size_t cu = (size_t)(bh * 128 + (cc)); \
            _Pragma("unroll") for (int pp = 0; pp < 2; ++pp) q_[pp] = *(const u32x4*)(QH + cu * 8192 + ((w * 2 + pp) * 64 + lane) * 8); \
            _Pragma("unroll") for (int sb = 0; sb < 2; ++sb) { kt_[sb] = *(const bf16x8*)(KT + cu * 8192 + ((w * 2 + sb) * 64 + lane) * 8); vt_[sb] = *(const bf16x8*)(VT + cu * 8192 + ((vs * 2 + sb) * 64 + lane) * 8); } \
            d_ = *(const f32x4*)(DEC + cu * 128 + 16 * w + 4 * fq); \
            if (tid < 256) { oi_ = *(const u32x2*)(OI + rowoff + (size_t)(cc) * 131072); gs_ = *(const u32x2*)(GS + rowoff + (size_t)(cc) * 131072); } } while (0)
#define HG_STEP(q_, kt_, vt_, d_, oi_, gs_, cc) do { \
            LAS f32x4* rb = red + ((cc) & 1) * 2048; \
            { const u32x4 sw = {cvt_pk_bf16(S[0], S[1]), cvt_pk_bf16(S[2], S[3]), 0u, 0u}; const bf16x8 Sb = *(const bf16x8*)&sw; \
                _Pragma("unroll") for (int tt = 0; tt < 4; ++tt) { const u32x4 xw = {q_[tt >> 1][2 * (tt & 1)], q_[tt >> 1][2 * (tt & 1) + 1], 0u, 0u}; const f32x4 z = {0.f, 0.f, 0.f, 0.f}; \
                    rb[(w * 4 + tt) * 64 + lane] = MFMA16(Sb, *(const bf16x8*)&xw, z); } }            \
            S = S * d_; S = MFMA16(kt_[0], vt_[0], S); S = MFMA16(kt_[1], vt_[1], S); \
            const u32x2 oiw = oi_; const f32x4 oi = {bflo(oiw[0]), bfhi(oiw[0]), bflo(oiw[1]), bfhi(oiw[1])}; const u32x2 gs = gs_; \
            if ((cc) + 2 < NCH) HG_LOAD(q_, kt_, vt_, d_, oi_, gs_, (cc) + 2); \
            __syncthreads(); \
            if (tid < 256) { f32x4 o = rb[tt2 * 64 + lane]; \
                _Pragma("unroll") for (int ww = 1; ww < 8; ++ww) o += rb[(ww * 4 + tt2) * 64 + lane]; \
                o += oi; float s2 = (o[0] * o[0] + o[1] * o[1]) + (o[2] * o[2] + o[3] * o[3]); s2 += __shfl_xor(s2, 16); s2 += __shfl_xor(s2, 32); \
                *(u32x2*)(OG + rowoff + (size_t)(cc) * 131072) = (u32x2){cvt_pk_bf16(o[0] * bflo(gs[0]), o[1] * bfhi(gs[0])), cvt_pk_bf16(o[2] * bflo(gs[1]), o[3] * bfhi(gs[1]))}; \
                if (fq == 0) SSO[(size_t)(b * SEQ + 64 * (cc) + 16 * tt2 + fr) * 128 + h * 8 + vs] = s2; } } while (0)
        HG_LOAD(qA, ktA, vtA, dA, oiA, gsA, 0);
        HG_LOAD(qB, ktB, vtB, dB, oiB, gsB, 1);
        for (int c = 0; c < NCH; c += 2) { HG_STEP(qA, ktA, vtA, dA, oiA, gsA, c); HG_STEP(qB, ktB, vtB, dB, oiB, gsB, c + 1); }
        __syncthreads();
#undef HG_LOAD
#undef HG_STEP
    }
}

namespace att {
constexpr int KROW = 384, SHM_K = 64 * KROW, SHM_V = 16384, OFF_K = 2 * SHM_V, OFF_WS = OFF_K + 2 * SHM_K;
constexpr float THR = 8.f;
__device__ __forceinline__ int v_rd_base(int lane) { return ((lane & 3) << 3) | (((lane >> 2) & 3) << 6) | (((lane >> 4) & 1) << 5) | (((lane >> 5) & 1) << 8); }
__device__ __forceinline__ int crow(int r, int hi) { return (r & 3) + 8 * (r >> 2) + 4 * hi; }
#define SBAR() __builtin_amdgcn_sched_barrier(0)
__device__ __forceinline__ void mask_tile(f32x16& p0, f32x16& p1, int dq) {
    const float NEG = -__builtin_inff();
#pragma unroll
    for (int r = 0; r < 16; ++r) { const int c = (r & 3) + 8 * (r >> 2); if (dq - c < 0) p0[r] = NEG; if (dq - c - 32 < 0) p1[r] = NEG; }
}
__device__ __forceinline__ void partialSM(f32x16& p0, f32x16& p1, float& m_reg, float& mn, float& alpha) {
    float pmax = p0[0];
#pragma unroll
    for (int r = 1; r < 16; ++r) pmax = fmaxf(pmax, p0[r]);
#pragma unroll
    for (int r = 0; r < 16; ++r) pmax = fmaxf(pmax, p1[r]);
    { auto rr = __builtin_amdgcn_permlane32_swap(__float_as_uint(pmax), __float_as_uint(pmax), false, false); pmax = fmaxf(__uint_as_float(rr[0]), __uint_as_float(rr[1])); }
    constexpr float C2 = 1.4426950408889634f * MLA_SCALE;
    if (__builtin_expect(__all((pmax - m_reg) * MLA_SCALE <= THR), 1)) { mn = m_reg; alpha = 1.f; }
    else { mn = fmaxf(m_reg, pmax); alpha = __builtin_amdgcn_exp2f((m_reg - mn) * C2); m_reg = mn; }
    const float mnL = -mn * C2;
#pragma unroll
    for (int r = 0; r < 16; ++r) p0[r] = __builtin_amdgcn_exp2f(fmaf(p0[r], C2, mnL));
#pragma unroll
    for (int r = 0; r < 16; ++r) p1[r] = __builtin_amdgcn_exp2f(fmaf(p1[r], C2, mnL));
}
__device__ __forceinline__ void finishSM(f32x16& p0, f32x16& p1, float alpha, float& l_reg, bf16x8& pa0, bf16x8& pa1, bf16x8& pa2, bf16x8& pa3) {
    float ps = 0;
#pragma unroll
    for (int r = 0; r < 16; ++r) ps += p0[r];
#pragma unroll
    for (int r = 0; r < 16; ++r) ps += p1[r];
    { auto rr = __builtin_amdgcn_permlane32_swap(__float_as_uint(ps), __float_as_uint(ps), false, false); ps = __uint_as_float(rr[0]) + __uint_as_float(rr[1]); }
    l_reg = l_reg * alpha + ps;
#define PK4(P, B_, OUT) do { unsigned a0 = cvt_pk_bf16(P[B_+0], P[B_+1]), a1 = cvt_pk_bf16(P[B_+2], P[B_+3]); unsigned b0 = cvt_pk_bf16(P[B_+4], P[B_+5]), b1 = cvt_pk_bf16(P[B_+6], P[B_+7]); \
        auto r0 = __builtin_amdgcn_permlane32_swap(a0, b0, false, false); auto r1 = __builtin_amdgcn_permlane32_swap(a1, b1, false, false); \
        u32x4 w_ = {r0[0], r1[0], r0[1], r1[1]}; OUT = *reinterpret_cast<bf16x8*>(&w_); } while (0)
    PK4(p0, 0, pa0); PK4(p0, 8, pa1); PK4(p1, 0, pa2); PK4(p1, 8, pa3);
#undef PK4
}
#define KRD2(dst0, dst1, j, imm) do { asm volatile("ds_read_b128 %0, %1 offset:%2" : "=&v"(dst0) : "v"(kb[j]), "i"(imm) : "memory"); \
                                      asm volatile("ds_read_b128 %0, %1 offset:%2" : "=&v"(dst1) : "v"(kb[j]), "i"((imm) + 32 * KROW) : "memory"); } while (0)
#define LGK(n) asm volatile("s_waitcnt lgkmcnt(%0)" :: "i"(n) : "memory")
template <int KB> __device__ __forceinline__ void qkt(f32x16& p0, f32x16& p1, const int (&kb)[4], const bf16x8* qr) {
    p0 = f32x16{}; p1 = f32x16{};
    bf16x8 ka[4], kc[4];
#define KIMM(d0) (KB * SHM_K + ((d0) >> 2) * 128)
    KRD2(ka[0], kc[0], 0, KIMM(0)); KRD2(ka[1], kc[1], 1, KIMM(1)); KRD2(ka[2], kc[2], 2, KIMM(2));
#define QK_STEP(d0) do { if ((d0) + 3 < 12) KRD2(ka[((d0) + 3) & 3], kc[((d0) + 3) & 3], ((d0) + 3) & 3, KIMM((d0) + 3)); \
        LGK(((d0) + 3 < 12) ? 6 : 2 * (11 - (d0))); SBAR(); \
        p0 = __builtin_amdgcn_mfma_f32_32x32x16_bf16(ka[(d0) & 3], qr[d0], p0, 0, 0, 0); p1 = __builtin_amdgcn_mfma_f32_32x32x16_bf16(kc[(d0) & 3], qr[d0], p1, 0, 0, 0); } while (0)
    QK_STEP(0); QK_STEP(1); QK_STEP(2); QK_STEP(3); QK_STEP(4); QK_STEP(5); QK_STEP(6); QK_STEP(7); QK_STEP(8); QK_STEP(9); QK_STEP(10); QK_STEP(11);
#undef QK_STEP
#undef KIMM
}
#define TRRD(dst, off) asm volatile("ds_read_b64_tr_b16 %0, %1 offset:%2" : "=&v"(dst) : "v"(vb0), "i"(off) : "memory")
#define VRD8(L, H, d0, VB_) do { constexpr int b_ = (VB_) * SHM_V + (d0) * 512; TRRD(L[0], b_); TRRD(H[0], b_ + 2048); TRRD(L[1], b_ + 4096); TRRD(H[1], b_ + 6144); TRRD(L[2], b_ + 8192); TRRD(H[2], b_ + 10240); TRRD(L[3], b_ + 12288); TRRD(H[3], b_ + 14336); } while (0)
#define PVMM(L, H, d0) do { \
        o[d0] = __builtin_amdgcn_mfma_f32_32x32x16_bf16(pa0, (bf16x8){L[0][0], L[0][1], L[0][2], L[0][3], H[0][0], H[0][1], H[0][2], H[0][3]}, o[d0], 0, 0, 0); \
        o[d0] = __builtin_amdgcn_mfma_f32_32x32x16_bf16(pa1, (bf16x8){L[1][0], L[1][1], L[1][2], L[1][3], H[1][0], H[1][1], H[1][2], H[1][3]}, o[d0], 0, 0, 0); \
        o[d0] = __builtin_amdgcn_mfma_f32_32x32x16_bf16(pa2, (bf16x8){L[2][0], L[2][1], L[2][2], L[2][3], H[2][0], H[2][1], H[2][2], H[2][3]}, o[d0], 0, 0, 0); \
        o[d0] = __builtin_amdgcn_mfma_f32_32x32x16_bf16(pa3, (bf16x8){L[3][0], L[3][1], L[3][2], L[3][3], H[3][0], H[3][1], H[3][2], H[3][3]}, o[d0], 0, 0, 0); } while (0)
__device__ __forceinline__ void block(const Frame& F, int bh, int qb) {
    LAS unsigned char* lds = F.lds;
    int lane = F.lane; asm volatile("" : "+v"(lane));
    const int tid = F.tid, wid = F.wave, r32 = lane & 31, hi = lane >> 5, b = bh >> 4, h = bh & 15;
    const bf16_t* KN = (const bf16_t*)(F.ws + B_KN) + (size_t)bh * SEQ * 128; const bf16_t* VV = (const bf16_t*)(F.ws + B_V) + (size_t)bh * SEQ * 128;
    const bf16_t* KR = (const bf16_t*)(F.ws + B_KR) + (size_t)b * SEQ * 64;
    const bf16_t* QN = (const bf16_t*)(F.ws + B_QN) + (size_t)bh * SEQ * 128; const bf16_t* QR = (const bf16_t*)(F.ws + B_QR) + (size_t)bh * SEQ * 64;
    const int q0 = qb * 256, NT = (q0 + 256) / 64, qlo = q0 + wid * 32, qm = qlo + r32 - 4 * hi;
    bf16x8 qr[12];
    { const size_t row = (size_t)(qlo + r32);
#pragma unroll
      for (int d0 = 0; d0 < 8; ++d0) qr[d0] = *(const bf16x8*)(QN + row * 128 + d0 * 16 + hi * 8);
#pragma unroll
      for (int d0 = 0; d0 < 4; ++d0) qr[8 + d0] = *(const bf16x8*)(QR + row * 64 + d0 * 16 + hi * 8); }
    unsigned koff[3], kstr[3], voff[2];
    const unsigned oKN = (unsigned)(B_KN + (size_t)bh * SEQ * 128 * 2), oKR = (unsigned)(B_KR + (size_t)b * SEQ * 64 * 2), oV = (unsigned)(B_V + (size_t)bh * SEQ * 128 * 2);
#pragma unroll
    for (int i = 0; i < 3; ++i) { const int p = (wid * 3 + i) * 64 + lane, r = p / 24, cs = p - r * 24, c = cs ^ ((r >> 1) & 7);
        if (c < 16) { koff[i] = oKN + (unsigned)(r * 128 + 8 * c) * 2u; kstr[i] = 64 * 128 * 2; } else { koff[i] = oKR + (unsigned)(r * 64 + 8 * (c - 16)) * 2u; kstr[i] = 64 * 64 * 2; } }
#pragma unroll
    for (int i = 0; i < 2; ++i) { const int s_ = (wid * 2 + i) * 64 + lane, sub = s_ >> 5, w_ = s_ & 31, kk = (sub >> 2) * 8 + (w_ >> 2), c = (sub & 3) * 32 + (w_ & 3) * 8, k = (kk & ~0xC) | ((kk & 4) << 1) | ((kk & 8) >> 1);
        voff[i] = oV + (unsigned)(k * 128 + c) * 2u; }
    const char* wsb = (const char*)F.ws;
#define A_DMA(t, bf) do { \
        _Pragma("unroll") for (int i = 0; i < 3; ++i) __builtin_amdgcn_global_load_lds((const unsigned*)(wsb + (koff[i] + (unsigned)(t) * kstr[i])), (LAS unsigned*)(lds + OFF_K + (bf) * SHM_K + (wid * 3 + i) * 1024), 16, 0, 0); \
        _Pragma("unroll") for (int i = 0; i < 2; ++i) __builtin_amdgcn_global_load_lds((const unsigned*)(wsb + (voff[i] + (unsigned)(t) * (64u * 128u * 2u))), (LAS unsigned*)(lds + (bf) * SHM_V + (wid * 2 + i) * 1024), 16, 0, 0); } while (0)
    int kb[4];
#pragma unroll
    for (int j = 0; j < 4; ++j) kb[j] = (int)(uintptr_t)lds + OFF_K + r32 * KROW + (((2 * j + hi) ^ ((r32 >> 1) & 7)) << 4);
    const int vb0 = (int)(uintptr_t)lds + v_rd_base(lane);
    LAS float* wsl = (LAS float*)(lds + OFF_WS) + wid * 64; LAS float* li_l = wsl; LAS float* al_l = wsl + 32;
    float m_reg = -1e30f, l_reg = 0.f; f32x16 o[4] = {};
    A_DMA(0, 0);
#define A_STEP(t, VB) do { \
        asm volatile("s_waitcnt vmcnt(0)" ::: "memory"); __syncthreads(); \
        if ((t) + 1 < NT) A_DMA((t) + 1, (VB) ^ 1); \
        const int kb_ = (t) * 64; \
        if (kb_ <= qlo + 31) { f32x16 p0, p1; float mn, alpha; bf16x8 pa0, pa1, pa2, pa3; s16x4 la[4], ha[4], lb[4], hb[4]; \
            qkt<VB>(p0, p1, kb, qr); \
            VRD8(la, ha, 0, VB); SBAR(); \
            if (kb_ + 63 > qlo) { asm volatile("; diagonal tile" ::: "memory"); mask_tile(p0, p1, qm - kb_); } \
            partialSM(p0, p1, m_reg, mn, alpha); \
            if (__any(alpha < 1.f)) { if (hi == 0) al_l[r32] = alpha; asm volatile("s_waitcnt lgkmcnt(0)" ::: "memory"); \
                _Pragma("unroll") for (int d_ = 0; d_ < 4; ++d_) _Pragma("unroll") for (int r = 0; r < 16; ++r) o[d_][r] *= al_l[crow(r, hi)]; } \
            finishSM(p0, p1, alpha, l_reg, pa0, pa1, pa2, pa3); SBAR(); \
            VRD8(lb, hb, 1, VB); LGK(8); SBAR(); PVMM(la, ha, 0); SBAR(); \
            VRD8(la, ha, 2, VB); LGK(8); SBAR(); PVMM(lb, hb, 1); SBAR(); \
            VRD8(lb, hb, 3, VB); LGK(8); SBAR(); PVMM(la, ha, 2); SBAR(); \
            LGK(0); SBAR(); PVMM(lb, hb, 3); } } while (0)
    for (int t = 0; t < NT; t += 2) { A_STEP(t, 0); A_STEP(t + 1, 1); }
    if (hi == 0) li_l[r32] = l_reg; asm volatile("s_waitcnt lgkmcnt(0)" ::: "memory");
    bf16_t* Ow = (bf16_t*)(F.ws + B_O) + (size_t)(b * SEQ + qlo) * D + h * 128;
#pragma unroll
    for (int r = 0; r < 16; ++r) { const int orow = crow(r, hi); const float rl = __builtin_amdgcn_rcpf(li_l[orow]);
#pragma unroll
        for (int d0 = 0; d0 < 4; ++d0) { const float v = o[d0][r] * rl; const float vn = __shfl_xor(v, 1);
            if ((r32 & 1) == 0) *(unsigned*)(Ow + (size_t)orow * D + d0 * 32 + r32) = cvt_pk_bf16(v, vn); } }
    __syncthreads();
#undef A_DMA
#undef A_STEP
}
#undef SBAR
#undef KRD2
#undef LGK
#undef TRRD
#undef VRD8
#undef PVMM
}
__device__ __forceinline__ void p_attn(const Frame& F) {
    const int nIt = (F.G == 256) ? 4 : (1024 - F.bid + F.G - 1) / F.G;
    for (int n = 0; n < nIt; ++n) {
        int bh, qb;
        if (F.G == 256) { const int xcd = F.bid & 7, k = F.bid >> 3, x = k & 15; bh = xcd * 4 + (n >> 1) * 2 + (k >> 4); qb = (n & 1) ? 31 - x : x; }
        else { const int L = F.bid + n * F.G; bh = L >> 5; qb = L & 31; }
        att::block(F, bh, qb);
        if (((((F.bid >> 3) + n) & 3) == 0 || nIt != 4) && !F.probe_rep) conv_moe_part(F, nIt == 4 ? 0 : n, nIt == 4 ? 1 : nIt);
        __syncthreads();
    }
}

constexpr int N_PHASES = 18;
__global__ void __launch_bounds__(512, 2) fwd_kernel(Args args) {
    extern __shared__ __attribute__((aligned(16))) unsigned char lds_raw[];
    Frame F; F.lds = (LAS unsigned char*)lds_raw; F.tid = threadIdx.x; F.lane = F.tid & 63; F.wave = __builtin_amdgcn_readfirstlane(F.tid >> 6); F.G = gridDim.x; F.bid = blockIdx.x;
    F.a = &args; F.ws = args.ws; F.ctl = (unsigned*)(args.ws + WS_CTL);
    volatile LAS unsigned* MISC = (volatile LAS unsigned*)(F.lds + MISC_OFF);
    if (F.tid < 64) MISC[F.tid] = 0u;
    __syncthreads();
    XcdBarrier bar; bar.bar = F.ctl + CW_BAR; bar.x = 0; bar.st = MISC + 8;
    if (MK_N_LAUNCHES == 1) bar = xcd_barrier_post(F.ctl + CW_BAR, MISC + 8);
    const int lo = args.ph_lo, hi = args.ph_hi & 0xffff; F.probe_rep = (args.ph_hi >> 16) != 0;
#define IN(k) (lo <= (k) && (k) < hi)
#ifndef PROBE_REPEAT
#define PROBE_REPEAT (-1)
#endif
#define NREP(k) ((k) == PROBE_REPEAT ? 2 : 1)
#define SEAM(k) do { if (IN(k) && IN((k) + 1)) xcd_barrier(bar); } while (0)
    const char* ws = (const char*)F.ws;
    if (IN(0)) for (int rep_ = 0; rep_ < NREP(0); ++rep_) { if (rep_) xcd_barrier(bar); p_mod(F); } SEAM(0);
    if (IN(1)) for (int rep_ = 0; rep_ < NREP(1); ++rep_) { if (rep_) xcd_barrier(bar); p_conv(F); __syncthreads(); p_thin<0>(F); } SEAM(1);
    if (IN(2)) for (int rep_ = 0; rep_ < NREP(2); ++rep_) { if (rep_) xcd_barrier(bar); pg8::DualOrder S{ws + WS_U, ws + W_IN, ws + WS_U, ws + W_IN, 64, 32, 0, D, F.G, F.bid};
        EpiHgIn E{(bf16_t*)(F.ws + B_Q), (float*)(F.ws + B_LF), (bf16_t*)(F.ws + B_VI), (bf16_t*)(F.ws + B_GS), (const float*)(F.ws + WS_LB), INF(I_HGONG)};
        pg8::gemm_phase(F.lds, D, S, E); } SEAM(2);
    if (IN(3)) for (int rep_ = 0; rep_ < NREP(3); ++rep_) { if (rep_) xcd_barrier(bar); p_hg_chunk(F); } SEAM(3);
    if (IN(4)) for (int rep_ = 0; rep_ < NREP(4); ++rep_) { if (rep_) xcd_barrier(bar); p_hg_scan(F); } SEAM(4);
    if (IN(5)) for (int rep_ = 0; rep_ < NREP(5); ++rep_) { if (rep_) xcd_barrier(bar); pg8::DualOrder S{ws + B_OG, ws + W_OUT, ws + B_OG, ws + W_OUT, 64, 8, 0, D, F.G, F.bid, true}; EpiBf16 E{(bf16_t*)(F.ws + WS_Y), D}; pg8::gemm_phase(F.lds, D, S, E); } SEAM(5);
    if (IN(6)) for (int rep_ = 0; rep_ < NREP(6); ++rep_) { if (rep_) xcd_barrier(bar); p_thin<1>(F); } SEAM(6);
    if (IN(7)) for (int rep_ = 0; rep_ < NREP(7); ++rep_) { if (rep_) xcd_barrier(bar); pg8::DualOrder S{ws + WS_U, ws + W_GU, ws + WS_U, ws + W_GU, 64, 44, 0, D, F.G, F.bid}; EpiGU E{(bf16_t*)(F.ws + B_ACT)}; pg8::gemm_phase(F.lds, D, S, E); } SEAM(7);
    if (IN(8)) for (int rep_ = 0; rep_ < NREP(8); ++rep_) { if (rep_) xcd_barrier(bar); pg8::DualOrder S{ws + B_ACT, ws + W_DN, ws + B_ACT, ws + W_DN, 64, 8, 0, DFF, F.G, F.bid}; EpiBf16 E{(bf16_t*)(F.ws + WS_Y), D}; pg8::gemm_phase(F.lds, DFF, S, E); } SEAM(8);
    if (IN(9)) for (int rep_ = 0; rep_ < NREP(9); ++rep_) { if (rep_) xcd_barrier(bar); p_thin<2>(F); } SEAM(9);
    if (IN(10)) for (int rep_ = 0; rep_ < NREP(10); ++rep_) { if (rep_) xcd_barrier(bar); pg8::DualOrder S{ws + WS_XS, ws + W_LAT, ws + WS_U, ws + W_LAT + (size_t)768 * D * 2, 64, 3, 2, D, F.G, F.bid};
        EpiLat E{(bf16_t*)(F.ws + B_CKV), (bf16_t*)(F.ws + B_QLAT), (bf16_t*)(F.ws + B_KR), (float*)(F.ws + WS_SSC), (float*)(F.ws + WS_SSQ), (const float*)(F.ws + WS_COS), (const float*)(F.ws + WS_SIN)};
        pg8::gemm_phase(F.lds, D, S, E); } SEAM(10);
    if (IN(11)) for (int rep_ = 0; rep_ < NREP(11); ++rep_) { if (rep_) xcd_barrier(bar); pg8::DualOrder S{ws + B_CKV, ws + W_KVQ, ws + B_QLAT, ws + W_KVQ + (size_t)4096 * 512 * 2, 64, 16, 12, 512, F.G, F.bid};
        EpiKvQ E{(bf16_t*)(F.ws + B_KN), (bf16_t*)(F.ws + B_V), (bf16_t*)(F.ws + B_QN), (bf16_t*)(F.ws + B_QR), (const float*)(F.ws + WS_SSC), (const float*)(F.ws + WS_SSQ), (const float*)(F.ws + WS_COS), (const float*)(F.ws + WS_SIN)};
        pg8::gemm_phase(F.lds, 512, S, E); } SEAM(11);
    if (IN(12)) for (int rep_ = 0; rep_ < NREP(12); ++rep_) { if (rep_) xcd_barrier(bar); p_attn(F); } SEAM(12);
    if (IN(13)) for (int rep_ = 0; rep_ < NREP(13); ++rep_) { if (rep_) xcd_barrier(bar); pg8::DualOrder S{ws + B_O, ws + W_O, ws + B_O, ws + W_O, 64, 8, 0, D, F.G, F.bid}; EpiBf16 E{(bf16_t*)(F.ws + WS_Y), D}; pg8::gemm_phase(F.lds, D, S, E); } SEAM(13);
    if (IN(14)) for (int rep_ = 0; rep_ < NREP(14); ++rep_) { if (rep_) xcd_barrier(bar); p_thin<3>(F); } SEAM(14);
    if (IN(15)) for (int rep_ = 0; rep_ < NREP(15); ++rep_) { if (rep_) xcd_barrier(bar); pg8::MoeOrder<true> S; S.A = ws + WS_U; S.W = ws + W_MGU; S.wstride = (size_t)2 * DFF * D; S.list = (const int*)(ws + WS_LIST); S.nN = 44; S.rb = D; S.G = F.G; S.c = F.bid; S.init(F.ctl);
        EpiGU8 E{F.ws + B_ACT2}; pg8::gemm_phase<EpiGU8, pg8::MoeOrder<true>, true>(F.lds, D, S, E); } SEAM(15);
    if (IN(16)) for (int rep_ = 0; rep_ < NREP(16); ++rep_) { if (rep_) xcd_barrier(bar); pg8::MoeOrder<false> S; S.A = ws + B_ACT2; S.W = ws + W_MDN; S.wstride = (size_t)D * DFF; S.list = nullptr; S.nN = 8; S.rb = DFF; S.G = F.G; S.c = F.bid; S.init(F.ctl);
        EpiBf16 E{(bf16_t*)(F.ws + B_Y2), D}; pg8::gemm_phase<EpiBf16, pg8::MoeOrder<false>, true>(F.lds, DFF, S, E); } SEAM(16);
    if (IN(17)) for (int rep_ = 0; rep_ < NREP(17); ++rep_) { if (rep_) xcd_barrier(bar); p_thin<4>(F); }
#undef IN
#undef SEAM
}

extern "C" void kernel_launch(void* const* d_in, const int* in_sizes, int n_in, void* d_out, int out_size, void* d_ws, size_t ws_size, hipStream_t stream) {
    static int grid = 0;
    if (grid == 0) {
        if (n_in != 25 || out_size != M * D || ws_size < WS_NEED) { fprintf(stderr, "kernel_launch: expected 25 inputs, out %d, ws >= %zu; got n_in %d out %d ws %zu\n", M * D, (size_t)WS_NEED, n_in, out_size, ws_size); grid = -1; return; }
        int dev = 0, cus = 0;
        if (hipGetDevice(&dev) != hipSuccess || hipDeviceGetAttribute(&cus, hipDeviceAttributeMultiprocessorCount, dev) != hipSuccess) { grid = -1; return; }
        if (hipFuncSetAttribute((const void*)fwd_kernel, hipFuncAttributeMaxDynamicSharedMemorySize, LDS_BYTES) != hipSuccess) { fprintf(stderr, "kernel_launch: hipFuncSetAttribute failed\n"); grid = -1; return; }
        int per_cu = 0;
        if (hipOccupancyMaxActiveBlocksPerMultiprocessor(&per_cu, (const void*)fwd_kernel, 512, LDS_BYTES) != hipSuccess || per_cu < 1) { fprintf(stderr, "kernel_launch: occupancy query reports %d\n", per_cu); (void)hipGetLastError(); }
        grid = cus;
    }
    if (grid < 0) return;
    (void)hipMemsetAsync((char*)d_ws + WS_CTL, 0, CTL_BYTES, stream);
    Args a{};
    for (int i = 0; i < 25; ++i) a.in[i] = d_in[i];
    a.out = (float*)d_out; a.ws = (unsigned char*)d_ws;
    if (MK_N_LAUNCHES == 1) { a.ph_lo = 0; a.ph_hi = N_PHASES; hipLaunchKernelGGL(fwd_kernel, dim3(grid), dim3(512), LDS_BYTES, stream, a); }
    else for (int p = 0; p < N_PHASES; ++p) { a.ph_lo = p; a.ph_hi = p + 1; hipLaunchKernelGGL(fwd_kernel, dim3(grid), dim3(512), LDS_BYTES, stream, a);
#if defined(PROBE_HOST_REPEAT)
        if (p == PROBE_HOST_REPEAT) { a.ph_hi |= 1 << 16; hipLaunchKernelGGL(fwd_kernel, dim3(grid), dim3(512), LDS_BYTES, stream, a); }
#endif
    }
    const hipError_t le = hipPeekAtLastError();
    if (le != hipSuccess) fprintf(stderr, "kernel_launch: launch failed: %s\n", hipGetErrorName(le));
}
```

```cpp
#include <hip/hip_runtime.h>
#include <cstdio>
#include <cstdint>

#ifndef MK_N_LAUNCHES
#define MK_N_LAUNCHES 1
#endif

#define LAS __attribute__((address_space(3)))
#define GAS __attribute__((address_space(1)))
typedef unsigned short bf16_t;
typedef short bf16x8 __attribute__((ext_vector_type(8)));
typedef short s16x4 __attribute__((ext_vector_type(4)));
typedef float f32x4 __attribute__((ext_vector_type(4)));
typedef float f32x2 __attribute__((ext_vector_type(2)));
typedef float f32x16 __attribute__((ext_vector_type(16)));
typedef unsigned u32x4 __attribute__((ext_vector_type(4)));
typedef unsigned u32x2 __attribute__((ext_vector_type(2)));

constexpr int D = 2048, BATCH = 2, SEQ = 8192, M = BATCH * SEQ;
constexpr int HG_H = 16, HG_K = 128, HG_C = 64, NCH = SEQ / HG_C;
constexpr int MLA_H = 16, QLORA = 512, KVLORA = 512, NOPE = 128, ROPE = 64, VH = 128;
constexpr int DFF = 5632, NEXP = 8;
constexpr float EPS = 1e-6f;
constexpr float MLA_SCALE = 0.07216878364870322f;
constexpr int NMOD = 4 * 6144 + 4096;
constexpr int MOE_MAXT = 136;
constexpr int MOE_ROWS = MOE_MAXT * 256;

constexpr size_t MiB = 1ull << 20;
constexpr size_t WS_CTL = 0;
constexpr size_t CTL_BYTES = 1 * MiB;
constexpr size_t WS_MOD = 1 * MiB;
constexpr size_t WS_LB = WS_MOD + 256 * 1024;
constexpr size_t WS_COS = 2 * MiB;
constexpr size_t WS_SIN = 4 * MiB;
constexpr size_t WS_SSO = 6 * MiB;
constexpr size_t WS_SSC = 14 * MiB;
constexpr size_t WS_SSQ = 15 * MiB;
constexpr size_t WS_TOK = 16 * MiB;
constexpr size_t WS_LIST = 17 * MiB;
constexpr size_t WS_W = 18 * MiB;
constexpr size_t W_IN = WS_W;
constexpr size_t W_OUT = W_IN + (size_t)8192 * 2048 * 2;
constexpr size_t W_GU = W_OUT + (size_t)2048 * 2048 * 2;
constexpr size_t W_DN = W_GU + (size_t)11264 * 2048 * 2;
constexpr size_t W_LAT = W_DN + (size_t)2048 * 5632 * 2;
constexpr size_t W_KVQ = W_LAT + (size_t)1280 * 2048 * 2;
constexpr size_t W_O = W_KVQ + (size_t)7168 * 512 * 2;
constexpr size_t W_MGU = W_O + (size_t)2048 * 2048 * 2;
constexpr size_t W_MDN = W_MGU + (size_t)8 * 11264 * 2048 * 2;
constexpr size_t W_END = W_MDN + (size_t)8 * 2048 * 5632 * 2;
constexpr size_t WS_U = (W_END + MiB - 1) / MiB * MiB;
constexpr size_t WS_XS = WS_U + (size_t)M * D * 2;
constexpr size_t WS_Y = WS_XS + (size_t)M * D * 2;
constexpr size_t WS_XR = WS_Y + (size_t)M * D * 2;
constexpr size_t WS_BIG = WS_Y + (size_t)M * D * 4;
constexpr size_t B_Q = WS_BIG;
constexpr size_t B_LF = B_Q + (size_t)M * D * 2;
constexpr size_t B_VI = B_LF + (size_t)M * D * 4;
constexpr size_t B_GS = B_VI + (size_t)M * D * 2;
constexpr size_t B_QH = B_GS + (size_t)M * D * 2;
constexpr size_t B_KT = B_QH + (size_t)M * D * 2;
constexpr size_t B_VT = B_KT + (size_t)M * D * 2;
constexpr size_t B_DEC = B_VT + (size_t)M * D * 2;
constexpr size_t B_OI = B_DEC + (size_t)4096 * 128 * 4;
constexpr size_t B_OG = B_Q;
constexpr size_t B_HG_END = B_OI + (size_t)M * D * 4;
constexpr size_t B_ACT = WS_BIG;
constexpr size_t B_CKV = WS_BIG;
constexpr size_t B_QLAT = B_CKV + (size_t)M * 512 * 2;
constexpr size_t B_KR = B_QLAT + (size_t)M * 512 * 2;
constexpr size_t B_KN = B_KR + (size_t)M * 64 * 2;
constexpr size_t B_V = B_KN + (size_t)M * D * 2;
constexpr size_t B_QN = B_V + (size_t)M * D * 2;
constexpr size_t B_QR = B_QN + (size_t)M * D * 2;
constexpr size_t B_O = B_QR + (size_t)M * 1024 * 2;
constexpr size_t B_MLA_END = B_O + (size_t)M * D * 2;
constexpr size_t B_ACT2 = WS_BIG;
constexpr size_t B_Y2 = B_ACT2 + (size_t)MOE_ROWS * DFF * 2;
constexpr size_t B_MOE_END = B_Y2 + (size_t)MOE_ROWS * D * 4;
constexpr size_t WS_NEED = (B_HG_END > B_MOE_END ? (B_HG_END > B_MLA_END ? B_HG_END : B_MLA_END) : (B_MOE_END > B_MLA_END ? B_MOE_END : B_MLA_END));

constexpr int CW_BAR = 4096;
constexpr int CW_CNT = 16384;
constexpr int LDS_BYTES = 147456;
constexpr int MISC_OFF = 131072 + 8192;

typedef __bf16 bf16x2_t __attribute__((ext_vector_type(2)));
__device__ __forceinline__ unsigned cvt_pk_bf16(float lo, float hi) { const f32x2 v = {lo, hi}; return __builtin_bit_cast(unsigned, __builtin_convertvector(v, bf16x2_t)); }
__device__ __forceinline__ float bf2f(bf16_t v) { return __uint_as_float(((unsigned)v) << 16); }
__device__ __forceinline__ float bflo(unsigned w) { return __uint_as_float(w << 16); }
__device__ __forceinline__ float bfhi(unsigned w) { return __uint_as_float(w & 0xffff0000u); }
__device__ __forceinline__ bf16_t f2bf(float f) { return (bf16_t)(cvt_pk_bf16(f, 0.f) & 0xffffu); }
__device__ __forceinline__ float wave_sum(float v) {
    v += __builtin_bit_cast(float, __builtin_amdgcn_update_dpp(0, __builtin_bit_cast(int, v), 0xB1, 0xf, 0xf, false));
    v += __builtin_bit_cast(float, __builtin_amdgcn_update_dpp(0, __builtin_bit_cast(int, v), 0x4E, 0xf, 0xf, false));
    v += __builtin_bit_cast(float, __builtin_amdgcn_update_dpp(0, __builtin_bit_cast(int, v), 0x141, 0xf, 0xf, false));
    v += __builtin_bit_cast(float, __builtin_amdgcn_update_dpp(0, __builtin_bit_cast(int, v), 0x140, 0xf, 0xf, false));
    { auto r = __builtin_amdgcn_permlane16_swap(__float_as_uint(v), __float_as_uint(v), false, false); v = __uint_as_float(r[0]) + __uint_as_float(r[1]); }
    { auto r = __builtin_amdgcn_permlane32_swap(__float_as_uint(v), __float_as_uint(v), false, false); v = __uint_as_float(r[0]) + __uint_as_float(r[1]); }
    return v;
}
__device__ __forceinline__ float sigmoidf_(float x) { return __builtin_amdgcn_rcpf(1.0f + __builtin_amdgcn_exp2f(x * -1.4426950408889634f)); }
__device__ __forceinline__ float siluf_(float x) { return x * __builtin_amdgcn_rcpf(1.0f + __builtin_amdgcn_exp2f(x * -1.4426950408889634f)); }

#define XB_TMO      128
#define XB_XCNT(j)  (256  + 64 * (j))
#define XB_XSUB(j)  (1280 + 64 * (j))
#define XB_XGEN(j)  (2304 + 64 * (j))
#define XB_TOP      3328
#define XB_TOPGEN   3392
#define XCD_BAR_WORDS 3456
#define XB_SPIN_CAP (1u << 22)

__device__ __forceinline__ unsigned xb_ld(unsigned* p)              { return __hip_atomic_load(p, __ATOMIC_RELAXED, __HIP_MEMORY_SCOPE_AGENT); }
__device__ __forceinline__ unsigned xb_add(unsigned* p, unsigned v) { return __hip_atomic_fetch_add(p, v, __ATOMIC_RELAXED, __HIP_MEMORY_SCOPE_AGENT); }
__device__ __forceinline__ unsigned xb_xcc_id() { return (unsigned)__builtin_amdgcn_s_getreg((3 << 11) | 20) & 0xFu; }
#define XB_SPIN(cond, bar) do { unsigned _sp = 0; while (cond) { __builtin_amdgcn_s_sleep(1); \
    if ((++_sp & 255u) == 0u) { if (xb_ld(&(bar)[XB_TMO])) break; if (_sp > XB_SPIN_CAP) { atomicAdd(&(bar)[XB_TMO], 1u); break; } } } } while (0)

struct XcdBarrier { unsigned* bar; unsigned x; volatile LAS unsigned* st; };

__device__ __forceinline__ XcdBarrier xcd_barrier_post(unsigned* bar, volatile LAS unsigned* st) {
    XcdBarrier b; b.bar = bar; b.x = xb_xcc_id(); b.st = st;
    if (threadIdx.x == 0) (void)xb_add(&bar[XB_XCNT(b.x)], 1u);
    return b;
}
__device__ __forceinline__ void xcd_barrier_complete(unsigned* bar, unsigned x, unsigned& nloc, unsigned& nx) {
    const unsigned G = gridDim.x * gridDim.y * gridDim.z;
    unsigned sum, cnt, mine, sp = 0u;
    for (;;) {
        sum = 0u; cnt = 0u; mine = 0u;
#pragma unroll
        for (unsigned j = 0; j < 16; ++j) { const unsigned c = xb_ld(&bar[XB_XCNT(j)]); sum += c; cnt += (c > 0u) ? 1u : 0u; mine = (j == x) ? c : mine; }
        if (sum == G) break;
        __builtin_amdgcn_s_sleep(1);
        if ((++sp & 255u) == 0u) { if (xb_ld(&bar[XB_TMO])) break; if (sp > XB_SPIN_CAP) { atomicAdd(&bar[XB_TMO], 1u); break; } }
    }
    nloc = mine > 0u ? mine : 1u; nx = cnt > 0u ? cnt : 1u;
}
__device__ __forceinline__ void xcd_barrier(const XcdBarrier& b) {
    asm volatile("s_waitcnt vmcnt(0)" ::: "memory");
    __syncthreads();
    if (threadIdx.x == 0) {
        unsigned* bar = b.bar;
        __builtin_amdgcn_s_waitcnt(0);
        unsigned nloc = b.st[0], nx = b.st[1];
        if (nloc == 0u) { xcd_barrier_complete(bar, b.x, nloc, nx); b.st[0] = nloc; b.st[1] = nx; }
        const unsigned old = xb_add(&bar[XB_XSUB(b.x)], 1u);
        const unsigned gen = old / nloc;
        if (old + 1u == (gen + 1u) * nloc) {
            __builtin_amdgcn_fence(__ATOMIC_RELEASE, "agent");
            asm volatile("s_waitcnt vmcnt(0)" ::: "memory");
            const unsigned og = xb_add(&bar[XB_TOP], 1u);
            const unsigned tg = og / nx;
            if (og + 1u == (tg + 1u) * nx) xb_add(&bar[XB_TOPGEN], 1u);
            else XB_SPIN(xb_ld(&bar[XB_TOPGEN]) == tg, bar);
            __builtin_amdgcn_fence(__ATOMIC_ACQUIRE, "agent");
            xb_add(&bar[XB_XGEN(b.x)], 1u);
            asm volatile("s_waitcnt vmcnt(0)" ::: "memory");
        } else {
            XB_SPIN(xb_ld(&bar[XB_XGEN(b.x)]) == gen, bar);
            __builtin_amdgcn_fence(__ATOMIC_ACQUIRE, "agent");
            asm volatile("s_waitcnt vmcnt(0)" ::: "memory");
        }
    }
    __syncthreads();
}

namespace pg8 {
constexpr int BM = 256, BK = 64, HALF = 128, HTB = HALF * BK * 2, STAGE_BYTES = 8 * HTB, NXCD = 8, WGM = 8;
__device__ __forceinline__ int lds_byte(int r, int c) { const int st = (r >> 4) * 2 + (c >> 5), rr = r & 15, cc = c & 31, ob = rr * 64 + cc * 2; return st * 1024 + (ob ^ (((ob >> 9) & 1) << 5)); }
__device__ __forceinline__ void stage_rc(int b, int& R, int& C) { const int st = b / 1024, sb = b % 1024, swz = sb ^ (((sb >> 9) & 1) << 5); R = (st >> 1) * 16 + swz / 64; C = (st & 1) * 32 + (swz % 64) / 2; }
__device__ __forceinline__ int perm32(int rho) { const int n = rho >> 4, i = rho & 15; return 8 * (i >> 2) + 4 * n + (i & 3); }

struct Unit { const char* a; const char* b; int pm, pn, e, nv; };

__device__ __forceinline__ void tile_of(int L, int nM, int nN, int& pm, int& pn) {
    const int nwg = nM * nN; int wgid = L;
    { const int q = nwg / NXCD, r = nwg % NXCD, xcd = wgid % NXCD, off = wgid / NXCD; wgid = (xcd < r ? xcd * (q + 1) : r * (q + 1) + (xcd - r) * q) + off; }
    const int nig = WGM * nN, gid = wgid / nig, fm = gid * WGM, gsz = (nM - fm) < WGM ? (nM - fm) : WGM;
    pm = fm + ((wgid % nig) % gsz); pn = (wgid % nig) / gsz;
}
struct DualOrder {
    static constexpr bool GATHER = false;
    const char *A1, *B1, *A2, *B2; int nM, nN1, nN2, K, G, c; bool tmA = false;
    __device__ __forceinline__ bool next(int i, Unit& u) const {
        const int nN = nN1 + nN2; const long L = (long)i * G + c; if (L >= (long)nM * nN) return false;
        int pm, pn; tile_of((int)L, nM, nN, pm, pn);
        const size_t tstep = (size_t)BM * K * 2;
        if (pn < nN1) { u.e = 0; u.pn = pn; u.a = A1 + pm * tstep; u.b = B1 + pn * tstep; }
        else { u.e = 1; u.pn = pn - nN1; u.a = A2 + pm * tstep; u.b = B2 + (pn - nN1) * tstep; }
        u.pm = pm; u.nv = 256; return true;
    }
    __device__ __forceinline__ const int* rows(const Unit&) const { return nullptr; }
};
template <bool GATHER_> struct MoeOrder {
    static constexpr bool GATHER = GATHER_;
    static constexpr bool tmA = false;
    const char* A; const char* W; size_t wstride; const int* list; int nT, nN, rb  , G, c; int tstart[NEXP + 1]; int cnt[NEXP];
    __device__ __forceinline__ void init(const unsigned* ctl) {
        int t = 0;
#pragma unroll
        for (int e = 0; e < NEXP; ++e) { const int n = (int)ctl[CW_CNT + 64 * e]; cnt[e] = n; tstart[e] = t; t += (n + 255) >> 8; }
        tstart[NEXP] = t; nT = t;
    }
    __device__ __forceinline__ bool next(int i, Unit& u) const {
        const long L = (long)i * G + c; if (L >= (long)nT * nN) return false;
        int pm, pn; tile_of((int)L, nT, nN, pm, pn);
        int e = 0;
#pragma unroll
        for (int j = 1; j < NEXP; ++j) e += (pm >= tstart[j]) ? 1 : 0;
        int ce = 0, ts = 0;
#pragma unroll
        for (int j = 0; j < NEXP; ++j) { ce = (j == e) ? cnt[j] : ce; ts = (j == e) ? tstart[j] : ts; }
        u.e = e; u.pm = pm; u.pn = pn; const int left = ce - (pm - ts) * 256; u.nv = left < 256 ? left : 256;
        u.a = GATHER ? A : A + (size_t)pm * BM * rb; u.b = W + (size_t)e * wstride + (size_t)pn * BM * rb;
        return true;
    }
    __device__ __forceinline__ const int* rows(const Unit& u) const { int ts = 0;
#pragma unroll
        for (int j = 0; j < NEXP; ++j) ts = (j == u.e) ? tstart[j] : ts;
        return list + (size_t)u.e * M + (u.pm - ts) * 256; }
};

typedef int i32x4 __attribute__((ext_vector_type(4)));
typedef int i32x8 __attribute__((ext_vector_type(8)));
constexpr float W8_SCALE = 128.0f; constexpr int W8_EXP = 0x78787878, ONE_EXP = 0x7f7f7f7f;
template <class Epi, class Sched, bool FP8 = false>
__device__ __forceinline__ void gemm_phase(LAS unsigned char* lds, const int Kel, const Sched& S, const Epi& E) {
    const int K = FP8 ? Kel / 2 : Kel;
    const int tid = threadIdx.x, wid = __builtin_amdgcn_readfirstlane(tid >> 6), lane = tid & 63, wr = wid >> 2, wc = wid & 3, fr = lane & 15, fq = lane >> 4;
    const int nt = K / BK;
    unsigned vA[2][2], vB[2]; int Rr[2], Cc[2];
#pragma unroll
    for (int i = 0; i < 2; ++i) { int R, C; stage_rc(tid * 16 + i * 8192, R, C); Rr[i] = R; Cc[i] = C; const int Rb = Epi::PERM ? ((R & ~31) + perm32(R & 31)) : R;
        vB[i] = (unsigned)(Rb * K + C) * 2u; }
    const size_t kstep = (size_t)(BK * 2), kstepA = S.tmA ? (size_t)8192 : kstep;
    const size_t hstep = (size_t)HALF * K * 2;
    const unsigned ldsw = (unsigned)wid * 1024u;
    const int aoff = lds_byte(wr * 64 + fr, fq * 8), boff = lds_byte(wc * 32 + fr, fq * 8);
#define PG8_SA(b, h) (((b) * 2 + (h)) * HTB)
#define PG8_SB(b, h) ((4 + (b) * 2 + (h)) * HTB)
#define PG8_STAGE2(bufoff, gbase, v0, v1) do { \
        __builtin_amdgcn_global_load_lds((const unsigned*)((const char*)(gbase) + (v0)), (LAS unsigned*)(lds + (bufoff) + ldsw), 16, 0, 0); \
        __builtin_amdgcn_global_load_lds((const unsigned*)((const char*)(gbase) + (v1)), (LAS unsigned*)(lds + (bufoff) + ldsw + 8192), 16, 0, 0); } while (0)
#define PG8_STAGEB(bufoff, gbase) PG8_STAGE2(bufoff, gbase, vB[0], vB[1])
#define PG8_LD8(p) __builtin_shufflevector(*(const LAS i32x4*)(p), *(const LAS i32x4*)((p) + 1024), 0, 1, 2, 3, 4, 5, 6, 7)
#define PG8_LDA(dst, b, h) do { if constexpr (FP8) { _Pragma("unroll") for (int m = 0; m < 4; ++m) dst##8[m] = PG8_LD8(lds + PG8_SA(b, h) + aoff + m * 2048); } \
        else { _Pragma("unroll") for (int m = 0; m < 4; ++m) _Pragma("unroll") for (int k = 0; k < 2; ++k) dst[m][k] = *(const LAS bf16x8*)(lds + PG8_SA(b, h) + aoff + m * 2048 + k * 1024); } } while (0)
#define PG8_LDB(dst, b, h) do { if constexpr (FP8) { _Pragma("unroll") for (int n = 0; n < 2; ++n) dst##8[n] = PG8_LD8(lds + PG8_SB(b, h) + boff + n * 2048); } \
        else { _Pragma("unroll") for (int n = 0; n < 2; ++n) _Pragma("unroll") for (int k = 0; k < 2; ++k) dst[n][k] = *(const LAS bf16x8*)(lds + PG8_SB(b, h) + boff + n * 2048 + k * 1024); } } while (0)
#define PG8_MMA(ai, bj, At, Bt) do { __builtin_amdgcn_s_setprio(1); _Pragma("unroll") for (int m = 0; m < 4; ++m) _Pragma("unroll") for (int n = 0; n < 2; ++n) { \
        if constexpr (FP8) asm volatile("v_mfma_scale_f32_16x16x128_f8f6f4 %0, %1, %2, %0, %3, %4 op_sel_hi:[0,0,0]" : "+v"(acc[ai][bj][m][n]) : "v"(Bt##8[n]), "v"(At##8[m]), "v"(sc_w8), "v"(sc_one)); \
        else { _Pragma("unroll") for (int k = 0; k < 2; ++k) acc[ai][bj][m][n] = __builtin_amdgcn_mfma_f32_16x16x32_bf16(Bt[n][k], At[m][k], acc[ai][bj][m][n], 0, 0, 0); } } \
        __builtin_amdgcn_s_setprio(0); } while (0)
#define PG8_WAIT_V(n) asm volatile("s_waitcnt vmcnt(" #n ")" ::: "memory")
#define PG8_WAIT_L(n) asm volatile("s_waitcnt lgkmcnt(" #n ")" ::: "memory")
#define PG8_BAR __builtin_amdgcn_s_barrier()
#define PG8_SCHED __builtin_amdgcn_sched_barrier(0)
    Unit cur, nxt; int ui = 0;
    if (!S.next(0, cur)) return;
    if constexpr (Sched::GATHER) { const int* rl = S.rows(cur);
#pragma unroll
        for (int h = 0; h < 2; ++h)
#pragma unroll
            for (int i = 0; i < 2; ++i) { const int j = Rr[i] + 128 * h; const int tok = (j < cur.nv) ? rl[j] : 0; vA[h][i] = (unsigned)(tok * K + Cc[i]) * 2u; } }
    else {
#pragma unroll
        for (int h = 0; h < 2; ++h)
#pragma unroll
            for (int i = 0; i < 2; ++i) { const int row = Rr[i] + 128 * h; vA[h][i] = S.tmA ? (unsigned)((row >> 6) * 262144 + (Cc[i] >> 4) * 2048 + (row & 63) * 32 + (Cc[i] & 15) * 2) : (unsigned)(row * K + Cc[i]) * 2u; } }
    LAS unsigned char* idx_lds = lds + STAGE_BYTES + wid * 1024;
    f32x4 acc[2][2][4][2];
#pragma unroll
    for (int a = 0; a < 2; ++a)
#pragma unroll
        for (int b = 0; b < 2; ++b)
#pragma unroll
            for (int m = 0; m < 4; ++m)
#pragma unroll
                for (int n = 0; n < 2; ++n) acc[a][b][m][n] = (f32x4){0.f, 0.f, 0.f, 0.f};
    bf16x8 At[4][2], B0[2][2], B1[2][2]; i32x8 At8[4], B08[2], B18[2];
    int sc_w8 = W8_EXP, sc_one = ONE_EXP; asm volatile("" : "+v"(sc_w8), "+v"(sc_one));
    const char* cA = cur.a; const char* cB = cur.b;
    PG8_STAGEB(PG8_SB(0, 0), cB); PG8_STAGEB(PG8_SB(0, 1), cB + hstep); PG8_STAGE2(PG8_SA(0, 0), cA, vA[0][0], vA[0][1]); PG8_STAGE2(PG8_SA(0, 1), cA, vA[1][0], vA[1][1]);
    if (wr == 1) PG8_BAR;
    PG8_WAIT_V(2); PG8_BAR;
    PG8_STAGEB(PG8_SB(1, 0), cB + kstep); PG8_STAGE2(PG8_SA(1, 0), cA + kstepA, vA[0][0], vA[0][1]); PG8_STAGEB(PG8_SB(1, 1), cB + hstep + kstep);
    PG8_WAIT_V(6); PG8_BAR;
    for (;;) {
        const bool has_next = S.next(ui + 1, nxt);
        const char* nA = has_next ? nxt.a : cA; const char* nB = has_next ? nxt.b : cB;
        for (int t = 0; t < nt; t += 2) {
            const bool last = (t == nt - 2);
            if constexpr (Sched::GATHER) { if (t == nt - 6 && has_next) { const int* rl = S.rows(nxt);
#pragma unroll
                for (int h = 0; h < 2; ++h)
#pragma unroll
                    for (int i = 0; i < 2; ++i) __builtin_amdgcn_global_load_lds((const unsigned*)(rl + Rr[i] + 128 * h), (LAS unsigned*)(idx_lds + (h * 2 + i) * 256), 4, 0, 0); } }
            const char* a1 = cA + (size_t)(t + 1) * kstepA;
            const char* a2 = last ? nA : cA + (size_t)(t + 2) * kstepA; const char* b2 = last ? nB : cB + (size_t)(t + 2) * kstep;
            const char* a3 = a2 + kstepA; const char* b3 = b2 + kstep;
            PG8_LDB(B0, 0, 0); PG8_LDB(B1, 0, 1); PG8_SCHED; PG8_LDA(At, 0, 0); PG8_STAGE2(PG8_SA(1, 1), a1, vA[1][0], vA[1][1]);
            if constexpr (Sched::GATHER) { if (last && has_next) {
#pragma unroll
                for (int h = 0; h < 2; ++h)
#pragma unroll
                    for (int i = 0; i < 2; ++i) { const int j = Rr[i] + 128 * h; const int tok = *(const LAS int*)(idx_lds + (h * 2 + i) * 256 + lane * 4); vA[h][i] = (unsigned)(((j < nxt.nv) ? tok : 0) * K + Cc[i]) * 2u; } } }
            PG8_WAIT_V(8); PG8_WAIT_L(0); PG8_BAR; PG8_MMA(0, 0, At, B0); PG8_MMA(0, 1, At, B1); PG8_BAR; PG8_SCHED;
            PG8_LDA(At, 0, 1); PG8_STAGEB(PG8_SB(0, 0), b2); PG8_STAGEB(PG8_SB(0, 1), b2 + hstep); PG8_STAGE2(PG8_SA(0, 0), a2, vA[0][0], vA[0][1]);
            PG8_WAIT_V(8); PG8_WAIT_L(0); PG8_BAR; PG8_MMA(1, 0, At, B0); PG8_MMA(1, 1, At, B1); PG8_BAR; PG8_SCHED;
            PG8_LDB(B0, 1, 0); PG8_LDB(B1, 1, 1); PG8_SCHED; PG8_LDA(At, 1, 0); PG8_STAGE2(PG8_SA(0, 1), a2, vA[1][0], vA[1][1]);
            PG8_WAIT_V(8); PG8_WAIT_L(0); PG8_BAR; PG8_MMA(0, 0, At, B0); PG8_MMA(0, 1, At, B1); PG8_BAR; PG8_SCHED;
            PG8_LDA(At, 1, 1); PG8_STAGEB(PG8_SB(1, 0), b3); PG8_STAGEB(PG8_SB(1, 1), b3 + hstep); PG8_STAGE2(PG8_SA(1, 0), a3, vA[0][0], vA[0][1]);
            PG8_WAIT_V(8); PG8_WAIT_L(0); PG8_BAR; PG8_MMA(1, 0, At, B0); PG8_MMA(1, 1, At, B1); PG8_BAR; PG8_SCHED;
        }
        if (wr == 0) PG8_BAR;
        if constexpr (FP8) asm volatile("s_nop 15\n\ts_nop 15" ::: "memory");
        E(acc, cur, wr, wc, fr, fq);
        if (!has_next) break;
#pragma unroll
        for (int a = 0; a < 2; ++a)
#pragma unroll
            for (int b = 0; b < 2; ++b)
#pragma unroll
                for (int m = 0; m < 4; ++m)
#pragma unroll
                    for (int n = 0; n < 2; ++n) acc[a][b][m][n] = (f32x4){0.f, 0.f, 0.f, 0.f};
        cur = nxt; cA = nA; cB = nB; ++ui;
        if (wr == 1) PG8_BAR;
    }
    PG8_WAIT_V(0);
    PG8_BAR;
#undef PG8_SA
#undef PG8_SB
#undef PG8_STAGE2
#undef PG8_STAGEB
#undef PG8_LDA
#undef PG8_LD8
#undef PG8_LDB
#undef PG8_MMA
#undef PG8_WAIT_V
#undef PG8_WAIT_L
#undef PG8_BAR
#undef PG8_SCHED
}
}
using pg8::Unit;

__device__ __forceinline__ size_t tm_off(int m, int ch) { return ((((size_t)(m >> 6) * 128 + (ch >> 4)) * 64 + (m & 63)) * 16 + (ch & 15)); }
typedef f32x4 Acc[2][2][4][2];
__device__ __forceinline__ u32x4 pack8(f32x4 a, f32x4 b) { return (u32x4){cvt_pk_bf16(a[0], a[1]), cvt_pk_bf16(a[2], a[3]), cvt_pk_bf16(b[0], b[1]), cvt_pk_bf16(b[2], b[3])}; }

__device__ __forceinline__ u32x2 pack8_fp8(f32x4 a, f32x4 b) { int w0 = 0, w1 = 0;
    w0 = __builtin_amdgcn_cvt_pk_fp8_f32(a[0], a[1], w0, false); w0 = __builtin_amdgcn_cvt_pk_fp8_f32(a[2], a[3], w0, true);
    w1 = __builtin_amdgcn_cvt_pk_fp8_f32(b[0], b[1], w1, false); w1 = __builtin_amdgcn_cvt_pk_fp8_f32(b[2], b[3], w1, true); return (u32x2){(unsigned)w0, (unsigned)w1}; }
struct EpiHgIn {
    static constexpr bool PERM = true;
    bf16_t* Q; float* LF; bf16_t* VI; bf16_t* GS; const float* lb; const float* gn;
    __device__ __forceinline__ void operator()(const Acc& acc, const Unit& u, int wr, int wc, int fr, int fq) const {
        const int type = u.pn >> 3, row0 = u.pm * 256 + wr * 64 + fr, col0 = (u.pn & 7) * 256 + wc * 32 + 8 * fq;
        if (type == 0 || type == 2) { bf16_t* O = type == 0 ? Q : VI;
#pragma unroll
            for (int ai = 0; ai < 2; ++ai)
#pragma unroll
                for (int m = 0; m < 4; ++m) { bf16_t* rowp = O + (size_t)(row0 + ai * 128 + m * 16) * D + col0;
#pragma unroll
                    for (int bj = 0; bj < 2; ++bj) *(u32x4*)(rowp + bj * 128) = pack8(acc[ai][bj][m][0], acc[ai][bj][m][1]); }
        } else if (type == 1) {
#pragma unroll
            for (int bj = 0; bj < 2; ++bj) { const f32x4 l0 = *(const f32x4*)(lb + col0 + bj * 128), l1 = *(const f32x4*)(lb + col0 + bj * 128 + 4);
#pragma unroll
                for (int ai = 0; ai < 2; ++ai)
#pragma unroll
                    for (int m = 0; m < 4; ++m) { _Float16* rowp = (_Float16*)LF + (size_t)(row0 + ai * 128 + m * 16) * D + col0 + bj * 128; f32x4 o0, o1;
#pragma unroll
                        for (int j = 0; j < 4; ++j) { o0[j] = __builtin_amdgcn_logf(1.f - (1.f - l0[j]) * sigmoidf_(-acc[ai][bj][m][0][j])) * 0.6931471805599453f; o1[j] = __builtin_amdgcn_logf(1.f - (1.f - l1[j]) * sigmoidf_(-acc[ai][bj][m][1][j])) * 0.6931471805599453f; }
                        typedef _Float16 h8 __attribute__((ext_vector_type(8)));
                        *(h8*)rowp = (h8){(_Float16)o0[0], (_Float16)o0[1], (_Float16)o0[2], (_Float16)o0[3], (_Float16)o1[0], (_Float16)o1[1], (_Float16)o1[2], (_Float16)o1[3]}; } }
        } else {
#pragma unroll
            for (int bj = 0; bj < 2; ++bj) { const f32x4 g0 = *(const f32x4*)(gn + col0 + bj * 128), g1 = *(const f32x4*)(gn + col0 + bj * 128 + 4);
#pragma unroll
                for (int ai = 0; ai < 2; ++ai)
#pragma unroll
                    for (int m = 0; m < 4; ++m) { bf16_t* rowp = GS + tm_off(row0 + ai * 128 + m * 16, col0 + bj * 128); f32x4 o0, o1;
#pragma unroll
                        for (int j = 0; j < 4; ++j) { o0[j] = siluf_(acc[ai][bj][m][0][j]) * g0[j]; o1[j] = siluf_(acc[ai][bj][m][1][j]) * g1[j]; }
                        *(u32x4*)rowp = pack8(o0, o1); } }
        }
    }
};
struct EpiNull {
    static constexpr bool PERM = false;
    __device__ __forceinline__ void operator()(const Acc& acc, const Unit& u, int wr, int wc, int fr, int fq) const {
#pragma unroll
        for (int ai = 0; ai < 2; ++ai)
#pragma unroll
            for (int bj = 0; bj < 2; ++bj)
#pragma unroll
                for (int m = 0; m < 4; ++m)
#pragma unroll
                    for (int n = 0; n < 2; ++n) asm volatile("" :: "v"(acc[ai][bj][m][n]));
    }
};
struct EpiF32 {
    static constexpr bool PERM = false;
    float* C; int ldc;
    __device__ __forceinline__ void operator()(const Acc& acc, const Unit& u, int wr, int wc, int fr, int fq) const {
        const int row0 = u.pm * 256 + wr * 64 + fr, col0 = u.pn * 256 + wc * 32 + 4 * fq;
#pragma unroll
        for (int ai = 0; ai < 2; ++ai)
#pragma unroll
            for (int m = 0; m < 4; ++m) { float* rowp = C + (size_t)(row0 + ai * 128 + m * 16) * ldc + col0;
#pragma unroll
                for (int bj = 0; bj < 2; ++bj)
#pragma unroll
                    for (int n = 0; n < 2; ++n) *(f32x4*)(rowp + bj * 128 + n * 16) = acc[ai][bj][m][n]; }
    }
};
struct EpiBf16 {
    static constexpr bool PERM = true;
    bf16_t* C; int ldc;
    __device__ __forceinline__ void operator()(const Acc& acc, const Unit& u, int wr, int wc, int fr, int fq) const {
        const int row0 = u.pm * 256 + wr * 64 + fr, col0 = u.pn * 256 + wc * 32 + 8 * fq;
#pragma unroll
        for (int ai = 0; ai < 2; ++ai)
#pragma unroll
            for (int m = 0; m < 4; ++m) { bf16_t* rowp = C + (size_t)(row0 + ai * 128 + m * 16) * ldc + col0;
#pragma unroll
                for (int bj = 0; bj < 2; ++bj) *(u32x4*)(rowp + bj * 128) = pack8(acc[ai][bj][m][0], acc[ai][bj][m][1]); }
    }
};
struct EpiGU {
    static constexpr bool PERM = true;
    bf16_t* ACT;
    __device__ __forceinline__ void operator()(const Acc& acc, const Unit& u, int wr, int wc, int fr, int fq) const {
        const int row0 = u.pm * 256 + wr * 64 + fr, col0 = u.pn * 128 + wc * 32 + 8 * fq;
#pragma unroll
        for (int ai = 0; ai < 2; ++ai)
#pragma unroll
            for (int m = 0; m < 4; ++m) { f32x4 o0, o1;
#pragma unroll
                for (int j = 0; j < 4; ++j) { o0[j] = siluf_(acc[ai][0][m][0][j]) * acc[ai][1][m][0][j]; o1[j] = siluf_(acc[ai][0][m][1][j]) * acc[ai][1][m][1][j]; }
                *(u32x4*)(ACT + (size_t)(row0 + ai * 128 + m * 16) * DFF + col0) = pack8(o0, o1); }
    }
};
struct EpiGU8 {
    static constexpr bool PERM = true;
    unsigned char* ACT;
    __device__ __forceinline__ void operator()(const Acc& acc, const Unit& u, int wr, int wc, int fr, int fq) const {
        const int row0 = u.pm * 256 + wr * 64 + fr, col0 = u.pn * 128 + wc * 32 + 8 * fq;
#pragma unroll
        for (int ai = 0; ai < 2; ++ai)
#pragma unroll
            for (int m = 0; m < 4; ++m) { f32x4 o0, o1;
#pragma unroll
                for (int j = 0; j < 4; ++j) { o0[j] = __builtin_amdgcn_fmed3f(siluf_(acc[ai][0][m][0][j]) * acc[ai][1][m][0][j], -448.f, 448.f); o1[j] = __builtin_amdgcn_fmed3f(siluf_(acc[ai][0][m][1][j]) * acc[ai][1][m][1][j], -448.f, 448.f); }
                *(u32x2*)(ACT + (size_t)(row0 + ai * 128 + m * 16) * DFF + col0) = pack8_fp8(o0, o1); }
    }
};
struct EpiLat {
    static constexpr bool PERM = true;
    bf16_t* CKV; bf16_t* QLAT; bf16_t* KR; float* SSC; float* SSQ; const float* COS; const float* SIN;
    __device__ __forceinline__ void operator()(const Acc& acc, const Unit& u, int wr, int wc, int fr, int fq) const {
        const int row0 = u.pm * 256 + wr * 64 + fr;
        if (u.e == 0 && u.pn == 2) {
            if (wc < 2) { const int j = 16 * wc + 4 * fq;
#pragma unroll
                for (int ai = 0; ai < 2; ++ai)
#pragma unroll
                    for (int m = 0; m < 4; ++m) { const int r = row0 + ai * 128 + m * 16; const f32x4 c = *(const f32x4*)(COS + (size_t)r * 32 + j), s = *(const f32x4*)(SIN + (size_t)r * 32 + j);
                        const f32x4 x1 = acc[ai][0][m][0], x2 = acc[ai][0][m][1]; const f32x4 o1 = x1 * c - x2 * s, o2 = x2 * c + x1 * s;
                        *(u32x2*)(KR + (size_t)r * 64 + j) = (u32x2){cvt_pk_bf16(o1[0], o1[1]), cvt_pk_bf16(o1[2], o1[3])};
                        *(u32x2*)(KR + (size_t)r * 64 + 32 + j) = (u32x2){cvt_pk_bf16(o2[0], o2[1]), cvt_pk_bf16(o2[2], o2[3])}; } }
            return;
        }
        bf16_t* O = u.e == 0 ? CKV : QLAT; float* SS = u.e == 0 ? SSC : SSQ;
        const int col0 = u.pn * 256 + wc * 32 + 8 * fq;
#pragma unroll
        for (int ai = 0; ai < 2; ++ai)
#pragma unroll
            for (int m = 0; m < 4; ++m) { const int r = row0 + ai * 128 + m * 16; float s = 0.f;
#pragma unroll
                for (int bj = 0; bj < 2; ++bj) { const f32x4 a = acc[ai][bj][m][0], b = acc[ai][bj][m][1];
                    s += (a[0] * a[0] + a[1] * a[1]) + (a[2] * a[2] + a[3] * a[3]) + (b[0] * b[0] + b[1] * b[1]) + (b[2] * b[2] + b[3] * b[3]);
                    *(u32x4*)(O + (size_t)r * 512 + col0 + bj * 128) = pack8(a, b); }
                s += __shfl_xor(s, 16); s += __shfl_xor(s, 32);
                if (fq == 0) SS[(size_t)r * 8 + u.pn * 4 + wc] = s; }
    }
};
struct EpiKvQ {
    static constexpr bool PERM = true;
    bf16_t* KN; bf16_t* V; bf16_t* QN; bf16_t* QR; const float* SSC; const float* SSQ; const float* COS; const float* SIN;
    __device__ __forceinline__ void operator()(const Acc& acc, const Unit& u, int wr, int wc, int fr, int fq) const {
        const int row0 = u.pm * 256 + wr * 64 + fr; const float* SS = u.e == 0 ? SSC : SSQ;
#pragma unroll
        for (int ai = 0; ai < 2; ++ai)
#pragma unroll
            for (int m = 0; m < 4; ++m) { const int r = row0 + ai * 128 + m * 16, b = r >> 13, s = r & (SEQ - 1);
                const f32x4 p0 = *(const f32x4*)(SS + (size_t)r * 8), p1 = *(const f32x4*)(SS + (size_t)r * 8 + 4);
                const float rstd = rsqrtf(((p0[0] + p0[1]) + (p0[2] + p0[3]) + (p1[0] + p1[1]) + (p1[2] + p1[3])) * (1.0f / 512.0f) + EPS);
                if (u.e == 0) { const size_t o = ((size_t)(b * MLA_H + u.pn) * SEQ + s) * 128 + wc * 32 + 8 * fq;
                    *(u32x4*)(KN + o) = pack8(acc[ai][0][m][0] * rstd, acc[ai][0][m][1] * rstd); *(u32x4*)(V + o) = pack8(acc[ai][1][m][0] * rstd, acc[ai][1][m][1] * rstd); }
                else if (u.pn < 8) {
#pragma unroll
                    for (int bj = 0; bj < 2; ++bj) { const size_t o = ((size_t)(b * MLA_H + 2 * u.pn + bj) * SEQ + s) * 128 + wc * 32 + 8 * fq;
                        *(u32x4*)(QN + o) = pack8(acc[ai][bj][m][0] * rstd, acc[ai][bj][m][1] * rstd); } }
                else { const int j = 16 * (wc & 1) + 4 * fq; const f32x4 c = *(const f32x4*)(COS + (size_t)r * 32 + j), sn = *(const f32x4*)(SIN + (size_t)r * 32 + j);
#pragma unroll
                    for (int bj = 0; bj < 2; ++bj) { const int head = 4 * (u.pn - 8) + 2 * bj + (wc >> 1); const size_t o = ((size_t)(b * MLA_H + head) * SEQ + s) * 64 + j;
                        const f32x4 x1 = acc[ai][bj][m][0] * rstd, x2 = acc[ai][bj][m][1] * rstd; const f32x4 o1 = x1 * c - x2 * sn, o2 = x2 * c + x1 * sn;
                        *(u32x2*)(QR + o) = (u32x2){cvt_pk_bf16(o1[0], o1[1]), cvt_pk_bf16(o1[2], o1[3])};
                        *(u32x2*)(QR + o + 32) = (u32x2){cvt_pk_bf16(o2[0], o2[1]), cvt_pk_bf16(o2[2], o2[3])}; } }
            }
    }
};

struct Args { const void* in[25]; float* out; unsigned char* ws; int ph_lo, ph_hi; };
enum { I_X = 0, I_C, I_POS, I_ADAW, I_ADAB, I_NORMG, I_HGWIN, I_HGLB, I_HGONG, I_HGWOUT, I_KVNG, I_KVADAW, I_KVADAB, I_WKVA, I_KVNORMG, I_WKVB, I_WQA, I_QNORMG, I_WQB, I_WO,
       I_FGU, I_FDN, I_ROUTER, I_MGU, I_MDN };
struct Frame { LAS unsigned char* lds; int tid, lane, wave, G, bid; const Args* a; unsigned char* ws; unsigned* ctl; bool probe_rep; };
#define INF(k) ((const float*)F.a->in[k])

__device__ __forceinline__ const float* modp(const Frame& F, int which, int part, int b) { return (const float*)(F.ws + WS_MOD) + (size_t)b * NMOD + (which < 4 ? which * 6144 : 24576) + part * 2048; }
__device__ __forceinline__ const float* normg(const Frame& F, int layer, int sub, int which) { return INF(I_NORMG) + ((layer * 2 + sub) * 2 + which) * 2048; }

__device__ __forceinline__ void p_mod(const Frame& F) {
    LAS float* scv = (LAS float*)F.lds;
    LAS float* red = (LAS float*)(F.lds + 16384);
    for (int it = F.bid; it < 224; it += F.G) {
        __syncthreads();
        for (int i = F.tid; i < 2 * D; i += 512) scv[i] = siluf_(INF(I_C)[i]);
        __syncthreads();
        const float* W; const float* bias; int N, col0, obase;
        if (it < 192) { const int mi = it / 48; W = INF(I_ADAW) + (size_t)mi * D * 6144; bias = INF(I_ADAB) + mi * 6144; N = 6144; col0 = (it % 48) * 128; obase = mi * 6144; }
        else { W = INF(I_KVADAW); bias = INF(I_KVADAB); N = 4096; col0 = (it - 192) * 128; obase = 24576; }
        const int half = F.lane >> 5, cq = F.lane & 31;
        const float* wp = W + (size_t)(256 * F.wave + half) * N + col0 + 4 * cq;
        f32x4 a0 = {0.f, 0.f, 0.f, 0.f}, a1 = a0;
#pragma unroll 16
        for (int i = 0; i < 128; ++i) { const f32x4 v = *(const f32x4*)(wp + (size_t)(2 * i) * N); const int k = 256 * F.wave + 2 * i + half; a0 += v * scv[k]; a1 += v * scv[D + k]; }
        const int slot = F.wave * 2 + half;
        *(LAS f32x4*)(red + (slot * 2 + 0) * 128 + 4 * cq) = a0; *(LAS f32x4*)(red + (slot * 2 + 1) * 128 + 4 * cq) = a1;
        __syncthreads();
        if (F.tid < 256) { const int b = F.tid >> 7, col = F.tid & 127; float s = bias[col0 + col];
#pragma unroll
            for (int p = 0; p < 16; ++p) s += red[(p * 2 + b) * 128 + col];
            ((float*)(F.ws + WS_MOD))[(size_t)b * NMOD + obase + col0 + col] = s; }
    }
    const int gtid = F.bid * 512 + F.tid, gn = F.G * 512;
    for (int i = gtid; i < D; i += gn) { const float l0 = INF(I_HGLB)[i], l1 = INF(I_HGLB)[D + i]; ((float*)(F.ws + WS_LB))[i] = 1.0f / (1.0f + expf(l1 - l0)); }
    for (int p = gtid; p < M * 32; p += gn) { const int m = p >> 5, j = p & 31; const float pos = (float)((const int*)F.a->in[I_POS])[m];
        const float inv = 1.0f / powf(10000.0f, (float)(2 * j) / 64.0f); const float ang = pos * inv; float s_, c_; sincosf(ang, &s_, &c_);
        ((float*)(F.ws + WS_COS))[p] = c_; ((float*)(F.ws + WS_SIN))[p] = s_; }
}

__device__ __forceinline__ int rope_dest(int p) { return 32 * ((p >> 4) & 1) + 8 * ((p >> 2) & 3) + 4 * (p >> 5) + (p & 3); }
__device__ __forceinline__ int dest_row(int kind, int c) {
    if (kind == 0) return c;
    if (kind == 1) { const int b = c >= DFF ? 1 : 0, j = c - b * DFF; return (j >> 7) * 256 + b * 128 + (j & 127); }
    if (kind == 2) return c < 512 ? c : 512 + rope_dest(c - 512);
    const int h = c / 192, j = c - h * 192; return j < 128 ? h * 128 + j : 2048 + h * 64 + rope_dest(j - 128);
}
__device__ __forceinline__ void conv_item(const float* W, int K, int N, bf16_t* WT, int kind, const float* gsc, LAS float* scr, int item, int lane) {
    const int nblk = N / 32, kb = item / nblk, nb = item % nblk, k0 = 64 * kb, n0 = 32 * nb;
#pragma unroll 8
    for (int i = 0; i < 32; ++i) { const int kk = 2 * i + (lane >> 5); float v = W[(size_t)(k0 + kk) * N + n0 + (lane & 31)]; if (gsc) v *= gsc[k0 + kk]; scr[kk * 33 + (lane & 31)] = v; }
    asm volatile("s_waitcnt lgkmcnt(0)" ::: "memory");
    const int c = lane & 7;
#pragma unroll
    for (int j = 0; j < 4; ++j) { const int n = (lane >> 3) + 8 * j; const LAS float* s = scr + (8 * c) * 33 + n;
        u32x4 o; o.x = cvt_pk_bf16(s[0 * 33], s[1 * 33]); o.y = cvt_pk_bf16(s[2 * 33], s[3 * 33]); o.z = cvt_pk_bf16(s[4 * 33], s[5 * 33]); o.w = cvt_pk_bf16(s[6 * 33], s[7 * 33]);
        *(u32x4*)(WT + (size_t)dest_row(kind, n0 + n) * K + k0 + 8 * c) = o; }
    asm volatile("s_waitcnt lgkmcnt(0)" ::: "memory");
}
__device__ __forceinline__ void conv_item8(const float* W, int K, int N, unsigned char* WT, int kind, LAS float* scr, int item, int lane) {
    const int nblk = N / 32, kb = item / nblk, nb = item % nblk, k0 = 64 * kb, n0 = 32 * nb;
#pragma unroll 8
    for (int i = 0; i < 32; ++i) { const int kk = 2 * i + (lane >> 5); scr[kk * 33 + (lane & 31)] = W[(size_t)(k0 + kk) * N + n0 + (lane & 31)] * pg8::W8_SCALE; }
    asm volatile("s_waitcnt lgkmcnt(0)" ::: "memory");
    const int c = lane & 7;
#pragma unroll
    for (int j = 0; j < 4; ++j) { const int n = (lane >> 3) + 8 * j; const LAS float* s = scr + (8 * c) * 33 + n;
        const f32x4 a = {s[0 * 33], s[1 * 33], s[2 * 33], s[3 * 33]}, b = {s[4 * 33], s[5 * 33], s[6 * 33], s[7 * 33]};
        *(u32x2*)(WT + (size_t)dest_row(kind, n0 + n) * K + k0 + 8 * c) = pack8_fp8(a, b); }
    asm volatile("s_waitcnt lgkmcnt(0)" ::: "memory");
}
constexpr int MOE_I_GU = (D / 64) * (2 * DFF / 128), MOE_I_DN = (DFF / 64) * (D / 128), MOE_I_E = MOE_I_GU + MOE_I_DN, MOE_ITEMS = NEXP * MOE_I_E;
__device__ __forceinline__ void conv_moe_item(const Frame& F, int g) {
    const int lane = F.lane, nq = lane & 31, half = lane >> 5; const int e = g / MOE_I_E; int r = g - e * MOE_I_E;
    const float* W; unsigned char* dst; int K, N, kind;
    if (r < MOE_I_GU) { W = INF(I_MGU) + (size_t)e * D * 2 * DFF; K = D; N = 2 * DFF; dst = F.ws + W_MGU + (size_t)e * 2 * DFF * D; kind = 1; }
    else { r -= MOE_I_GU; W = INF(I_MDN) + (size_t)e * DFF * D; K = DFF; N = D; dst = F.ws + W_MDN + (size_t)e * D * DFF; kind = 0; }
    const int nkb = K / 64, nb = r / nkb, kb = r - nb * nkb, k0 = 64 * kb, n0 = 128 * nb;
    const float* wp = W + (size_t)(k0 + 32 * half) * N + n0 + 4 * nq; f32x4 v[32];
#pragma unroll
    for (int i = 0; i < 32; ++i) v[i] = *(const f32x4*)(wp + (size_t)i * N);
    LAS unsigned char* t = F.lds + F.wave * 16384;
#pragma unroll
    for (int j = 0; j < 4; ++j)
#pragma unroll
        for (int c = 0; c < 4; ++c) { const f32x4 a = (f32x4){v[8 * c][j], v[8 * c + 1][j], v[8 * c + 2][j], v[8 * c + 3][j]} * pg8::W8_SCALE, b = (f32x4){v[8 * c + 4][j], v[8 * c + 5][j], v[8 * c + 6][j], v[8 * c + 7][j]} * pg8::W8_SCALE;
            *(LAS u32x2*)(t + (4 * nq + j) * 72 + 32 * half + 8 * c) = pack8_fp8(a, b); }
    asm volatile("s_waitcnt lgkmcnt(0)" ::: "memory");
    const int c8 = lane & 7;
#pragma unroll
    for (int jj = 0; jj < 16; ++jj) { const int n = (lane >> 3) + 8 * jj;
        *(u32x2*)(dst + (size_t)dest_row(kind, n0 + n) * K + k0 + 8 * c8) = *(const LAS u32x2*)(t + n * 72 + 8 * c8); }
    asm volatile("s_waitcnt lgkmcnt(0)" ::: "memory");
}
__device__ __forceinline__ void conv_moe_part(const Frame& F, int part, int nparts) {
    const int gw = F.bid * 8 + F.wave, NGW = F.G * 8, per = (MOE_ITEMS + NGW - 1) / NGW, chunk = (per + nparts - 1) / nparts;
    const int k0 = part * chunk, k1 = (k0 + chunk < per) ? k0 + chunk : per;
    for (int k = k0; k < k1; ++k) { const int g = gw + k * NGW; if (g < MOE_ITEMS) conv_moe_item(F, g); }
}
__device__ __forceinline__ void p_conv(const Frame& F) {
    LAS float* scr = (LAS float*)(F.lds + F.wave * 16384);
    const long gw = (long)F.bid * 8 + F.wave, NGW = (long)F.G * 8;
    struct Mt { const float* W; int K, N; size_t dst; int kind; const float* g; };
    auto run = [&](const float* W, int K, int N, size_t dst, int kind, const float* g) { const long n = (long)(K / 64) * (N / 32);
        for (long it = gw; it < n; it += NGW) conv_item(W, K, N, (bf16_t*)(F.ws + dst), kind, g, scr, (int)it, F.lane); };
    run(INF(I_HGWIN), D, 8192, W_IN, 0, nullptr);
    run(INF(I_HGWOUT), D, D, W_OUT, 0, nullptr);
    run(INF(I_FGU), D, 2 * DFF, W_GU, 1, nullptr);
    run(INF(I_FDN), DFF, D, W_DN, 0, nullptr);
    run(INF(I_WKVA), D, 576, W_LAT, 2, nullptr);
    run(INF(I_WQA), D, 512, W_LAT + (size_t)768 * D * 2, 0, nullptr);
    run(INF(I_WKVB), 512, 4096, W_KVQ, 0, INF(I_KVNORMG));
    run(INF(I_WQB), 512, 3072, W_KVQ + (size_t)4096 * 512 * 2, 3, INF(I_QNORMG));
    run(INF(I_WO), D, D, W_O, 0, nullptr);
}

struct Row { f32x4 v[8]; };
__device__ __forceinline__ void row_ld(Row& r, const float* p, int lane) {
#pragma unroll
    for (int j = 0; j < 8; ++j) r.v[j] = *(const f32x4*)(p + 4 * lane + 256 * j);
}
__device__ __forceinline__ void row_ld_bf(Row& r, const bf16_t* p, int lane) {
#pragma unroll
    for (int j = 0; j < 8; ++j) { const u32x2 w = *(const u32x2*)(p + 4 * lane + 256 * j); r.v[j] = (f32x4){bflo(w[0]), bfhi(w[0]), bflo(w[1]), bfhi(w[1])}; }
}
__device__ __forceinline__ float row_ss(const Row& r) { float s = 0.f;
#pragma unroll
    for (int j = 0; j < 8; ++j) s += (r.v[j][0] * r.v[j][0] + r.v[j][1] * r.v[j][1]) + (r.v[j][2] * r.v[j][2] + r.v[j][3] * r.v[j][3]);
    return wave_sum(s); }
template <bool F8 = false>
__device__ __forceinline__ void row_mod_store(const Row& h, float rstd, const LAS float* gs, const LAS float* sh, bf16_t* o, int lane, Row* keep) {
#pragma unroll
    for (int j = 0; j < 8; ++j) { const int c = 4 * lane + 256 * j; const f32x4 gv = *(const LAS f32x4*)(gs + c), hv = *(const LAS f32x4*)(sh + c);
        const f32x4 u = h.v[j] * rstd * gv + hv; if (keep) keep->v[j] = u;
        if (F8) { int w = 0; w = __builtin_amdgcn_cvt_pk_fp8_f32(u[0], u[1], w, false); w = __builtin_amdgcn_cvt_pk_fp8_f32(u[2], u[3], w, true); *(int*)((unsigned char*)o + c) = w; }
        else *(u32x2*)(o + c) = (u32x2){cvt_pk_bf16(u[0], u[1]), cvt_pk_bf16(u[2], u[3])}; }
}
template <int MODE> __device__ __forceinline__ void p_thin(const Frame& F) {
    const int lane = F.lane; float* out = F.a->out;
    LAS float* T_GG = (LAS float*)F.lds; LAS float* T_GS = T_GG + 4096; LAS float* T_SH = T_GS + 4096; LAS float* T_KGS = T_SH + 4096; LAS float* T_KSH = T_KGS + 4096;
    LAS float* wr = T_SH + 4096;
    LAS int* sel = (LAS int*)(F.lds + 122880);
    __syncthreads();
    for (int i = F.tid; i < 2 * D; i += 512) { const int b = i >> 11, c = i & (D - 1);
        if (MODE >= 1) { const int mw = MODE - 1; T_GG[i] = modp(F, mw, 2, b)[c] * normg(F, mw >> 1, mw & 1, 1)[c]; }
        if (MODE <= 3) { T_GS[i] = normg(F, MODE >> 1, MODE & 1, 0)[c] * (1.0f + modp(F, MODE, 1, b)[c]); T_SH[i] = modp(F, MODE, 0, b)[c]; }
        if (MODE == 2) { T_KGS[i] = INF(I_KVNG)[c] * (1.0f + modp(F, 4, 1, b)[c]); T_KSH[i] = modp(F, 4, 0, b)[c]; } }
    if (MODE == 3) { const float* w = INF(I_ROUTER);
        for (int q = F.tid; q < D * 2; q += 512) { const int i = q >> 1, h = q & 1; ((LAS f32x4*)wr)[(((i >> 8) * 4 + (i & 3)) * 2 + h) * 64 + ((i & 255) >> 2)] = *(const f32x4*)(w + i * 8 + 4 * h); } }
    __syncthreads();
    int tst[NEXP];
    if (MODE == 4) { int t = 0;
#pragma unroll
        for (int e = 0; e < NEXP; ++e) { tst[e] = t * 256; t += ((int)F.ctl[CW_CNT + 64 * e] + 255) >> 8; } }
    for (int m = F.bid * 8 + F.wave; m < M; m += F.G * 8) {
        const int b = m >> 13, tb = b * D; Row h;
        if (MODE == 0) row_ld(h, INF(I_X) + (size_t)m * D, lane);
        else {
            Row y; float escale = EPS;
            if (MODE == 4) { const int4 tk = ((const int4*)(F.ws + WS_TOK))[m]; const float w0 = __int_as_float(tk.z), w1 = __int_as_float(tk.w);
                int o0 = 0, o1 = 0;
#pragma unroll
                for (int e = 0; e < NEXP; ++e) { o0 = ((tk.x & 15) == e) ? tst[e] : o0; o1 = ((tk.y & 15) == e) ? tst[e] : o1; }
                const bf16_t* y0 = (const bf16_t*)(F.ws + B_Y2) + (size_t)(o0 + (tk.x >> 4)) * D; const bf16_t* y1 = (const bf16_t*)(F.ws + B_Y2) + (size_t)(o1 + (tk.y >> 4)) * D;
                Row ya; row_ld_bf(ya, y0, lane); row_ld_bf(y, y1, lane);
#pragma unroll
                for (int j = 0; j < 8; ++j) y.v[j] = ya.v[j] * w0 + y.v[j] * w1;
            } else row_ld_bf(y, (const bf16_t*)(F.ws + WS_Y) + (size_t)m * D, lane);
            if (MODE == 1) { const float* ss = (const float*)(F.ws + WS_SSO) + (size_t)m * 128; const float so = wave_sum(ss[lane] + ss[64 + lane]) * (1.0f / D); escale = EPS * (so + EPS); }
            bf16_t* xr = (bf16_t*)(F.ws + WS_XR) + (size_t)m * D;
            if (MODE == 1) row_ld(h, INF(I_X) + (size_t)m * D, lane); else row_ld_bf(h, xr, lane);
            const float rstd = rsqrtf(row_ss(y) * (1.0f / D) + escale);
#pragma unroll
            for (int j = 0; j < 8; ++j) { const int c = 4 * lane + 256 * j; const f32x4 gg = *(const LAS f32x4*)(T_GG + tb + c);
                h.v[j] = h.v[j] + gg * (y.v[j] * rstd);
                if (MODE == 4) *(f32x4*)(out + (size_t)m * D + c) = h.v[j];
                else *(u32x2*)(xr + c) = (u32x2){cvt_pk_bf16(h.v[j][0], h.v[j][1]), cvt_pk_bf16(h.v[j][2], h.v[j][3])}; }
        }
        if (MODE == 4) continue;
        const float rstd = rsqrtf(row_ss(h) * (1.0f / D) + EPS);
        if (MODE == 2) row_mod_store(h, rstd, T_KGS + tb, T_KSH + tb, (bf16_t*)(F.ws + WS_XS) + (size_t)m * D, lane, nullptr);
        Row u;
        if (MODE == 3) row_mod_store<true>(h, rstd, T_GS + tb, T_SH + tb, (bf16_t*)(F.ws + WS_U + (size_t)m * D), lane, &u);
        else row_mod_store(h, rstd, T_GS + tb, T_SH + tb, (bf16_t*)(F.ws + WS_U) + (size_t)m * D, lane, nullptr);
        if (MODE == 3) {
            float lg[NEXP];
#pragma unroll
            for (int e = 0; e < NEXP; ++e) lg[e] = 0.f;
#pragma unroll
            for (int j = 0; j < 8; ++j) { asm volatile("" ::: "memory");
#pragma unroll
                for (int c = 0; c < 4; ++c) { const f32x4 w0 = ((const LAS f32x4*)wr)[((j * 4 + c) * 2 + 0) * 64 + lane], w1 = ((const LAS f32x4*)wr)[((j * 4 + c) * 2 + 1) * 64 + lane]; const float x = u.v[j][c];
                    lg[0] += x * w0[0]; lg[1] += x * w0[1]; lg[2] += x * w0[2]; lg[3] += x * w0[3]; lg[4] += x * w1[0]; lg[5] += x * w1[1]; lg[6] += x * w1[2]; lg[7] += x * w1[3]; } }
#pragma unroll
            for (int e = 0; e < NEXP; ++e) lg[e] = wave_sum(lg[e]);
            int e0 = 0; float v0 = lg[0];
#pragma unroll
            for (int e = 1; e < NEXP; ++e) if (lg[e] > v0) { v0 = lg[e]; e0 = e; }
            int e1 = e0 == 0 ? 1 : 0; float v1 = lg[e1];
#pragma unroll
            for (int e = 0; e < NEXP; ++e) if (e != e0 && lg[e] > v1) { v1 = lg[e]; e1 = e; }
            if (lane == 0) { const float p1 = __expf(v1 - v0), w0 = 1.0f / (1.0f + p1), w1 = p1 * w0;
                const int idx = ((m - F.bid * 8) / (F.G * 8)) * 8 + F.wave;
                sel[2 * idx] = e0; sel[2 * idx + 1] = e1;
                ((int2*)(F.ws + WS_TOK))[2 * (size_t)m + 1] = make_int2(__float_as_int(w0), __float_as_int(w1)); }
        }
    }
    if (MODE == 3) {
        __syncthreads();
        if (F.tid < NEXP) { const int e = F.tid, nIdx = ((M - F.bid * 8 + F.G * 8 - 1) / (F.G * 8)) * 8; int c = 0;
            for (int idx = 0; idx < nIdx; ++idx) { const int m = F.bid * 8 + (idx & 7) + (idx >> 3) * F.G * 8; if (m < M) c += (sel[2 * idx] == e ? 1 : 0) + (sel[2 * idx + 1] == e ? 1 : 0); }
            int r = c ? (int)atomicAdd(F.ctl + CW_CNT + 64 * e, (unsigned)c) : 0;
            int* list = (int*)(F.ws + WS_LIST) + (size_t)e * M; int* tok = (int*)(F.ws + WS_TOK);
            for (int idx = 0; idx < nIdx; ++idx) { const int m = F.bid * 8 + (idx & 7) + (idx >> 3) * F.G * 8; if (m >= M) continue;
                if (sel[2 * idx] == e) { list[r] = m; tok[4 * (size_t)m] = e | (r << 4); ++r; }
                if (sel[2 * idx + 1] == e) { list[r] = m; tok[4 * (size_t)m + 1] = e | (r << 4); ++r; } } }
    }
}

#define MFMA16(X, Y, C) __builtin_amdgcn_mfma_f32_16x16x32_bf16((X), (Y), (C), 0, 0, 0)
__device__ __forceinline__ float expc(float x) { return __expf(fminf(x, 80.0f)); }
__device__ __forceinline__ int hg_tiled(int r, int seg) { return (((r >> 4) * 2 + (seg >> 1)) * 64 + (2 * (seg & 1)) * 16 + (r & 15)) * 8; }
__device__ __forceinline__ void p_hg_chunk(const Frame& F) {
    constexpr int RS = 272, TS = 144;
    LAS unsigned char* QA = F.lds; LAS unsigned char* QB = QA + 64 * RS; LAS unsigned char* KA = QB + 32 * RS; LAS unsigned char* KB = KA + 32 * RS;
    LAS unsigned char* VS = KB + 64 * RS; LAS unsigned char* VT = VS + 64 * RS; LAS unsigned char* PS = VT + 128 * TS; LAS float* TOT = (LAS float*)(PS + 64 * TS);
    const int tid = F.tid, lane = F.lane, w = F.wave, ch = tid & 127, seg = tid >> 7, fr = lane & 15, fq = lane >> 4;
    const _Float16* LFg = (const _Float16*)(F.ws + B_LF); const bf16_t* Qg = (const bf16_t*)(F.ws + B_Q); const bf16_t* VIg = (const bf16_t*)(F.ws + B_VI);
    for (int unit = F.bid; unit < 4096; unit += F.G) {
        const int bh = unit >> 7, c = unit & 127, b = bh >> 4, h = bh & 15, m0 = b * SEQ + 64 * c, k0 = 128 * h;
        float lf[16], qv[16];
#pragma unroll
        for (int i = 0; i < 16; ++i) { const size_t o = (size_t)(m0 + 16 * seg + i) * D + k0 + ch; lf[i] = (float)LFg[o]; qv[i] = bf2f(Qg[o]); }
#pragma unroll
        for (int p = 0; p < 2; ++p) { const int piece = tid + 512 * p, s = piece >> 4, v8 = (piece & 15) * 8; *(LAS u32x4*)(VS + s * RS + v8 * 2) = *(const u32x4*)(VIg + (size_t)(m0 + s) * D + k0 + v8); }
        float bcs[16]; float run = 0.f;
#pragma unroll
        for (int i = 0; i < 16; ++i) { run += lf[i]; bcs[i] = run; }
        TOT[seg * 128 + ch] = run;
        __syncthreads();
        const float t0 = TOT[ch], t1 = TOT[128 + ch], t2 = TOT[256 + ch], t3 = TOT[384 + ch];
        const float pre = seg == 0 ? 0.f : seg == 1 ? t0 : seg == 2 ? t0 + t1 : t0 + t1 + t2, r1 = t0 + t1, bl = r1 + t2 + t3;
        unsigned kh[8];
#pragma unroll
        for (int i = 0; i < 16; i += 2) { float kv[2];
#pragma unroll
            for (int z = 0; z < 2; ++z) { const int t = 16 * seg + i + z; const float bb = bcs[i + z] + pre, kk = 1.0f - __expf(lf[i + z]), q = qv[i + z];
                *(LAS bf16_t*)(QA + t * RS + ch * 2) = f2bf(q * expc(bb));
                if (seg >= 2) *(LAS bf16_t*)(QB + (t - 32) * RS + ch * 2) = f2bf(q * expc(bb - r1));
                if (seg < 2) *(LAS bf16_t*)(KA + t * RS + ch * 2) = f2bf(kk * expc(-bb));
                *(LAS bf16_t*)(KB + t * RS + ch * 2) = f2bf(kk * expc(r1 - bb));
                kv[z] = kk * expc(bl - bb); }
            kh[i >> 1] = cvt_pk_bf16(kv[0], kv[1]); }
        { bf16_t* kt = (bf16_t*)(F.ws + B_KT) + (size_t)unit * 8192 + hg_tiled(ch, seg); *(u32x4*)kt = (u32x4){kh[0], kh[1], kh[2], kh[3]}; *(u32x4*)(kt + 128) = (u32x4){kh[4], kh[5], kh[6], kh[7]}; }
        if (seg == 3) ((float*)(F.ws + B_DEC))[(size_t)unit * 128 + ch] = expc(bl);
        { unsigned vv[8];
#pragma unroll
            for (int i = 0; i < 16; i += 2) { const unsigned lo = *(const LAS bf16_t*)(VS + (16 * seg + i) * RS + ch * 2), hi = *(const LAS bf16_t*)(VS + (16 * seg + i + 1) * RS + ch * 2); vv[i >> 1] = lo | (hi << 16); }
            const u32x4 a = {vv[0], vv[1], vv[2], vv[3]}, bq = {vv[4], vv[5], vv[6], vv[7]};
            *(LAS u32x4*)(VT + ch * TS + 32 * seg) = a; *(LAS u32x4*)(VT + ch * TS + 32 * seg + 16) = bq;
            bf16_t* vt = (bf16_t*)(F.ws + B_VT) + (size_t)unit * 8192 + hg_tiled(ch, seg); *(u32x4*)vt = a; *(u32x4*)(vt + 128) = bq; }
        __syncthreads();
#pragma unroll
        for (int p = 0; p < 2; ++p) { const int piece = tid + 512 * p, ww = piece >> 7, pp = (piece >> 6) & 1, ln = piece & 63, r_ = ln & 15, q_ = ln >> 4;
            const u32x2 lo = *(const LAS u32x2*)(QA + (32 * pp + r_) * RS + (16 * ww + 4 * q_) * 2), hi = *(const LAS u32x2*)(QA + (32 * pp + 16 + r_) * RS + (16 * ww + 4 * q_) * 2);
            *(u32x4*)((bf16_t*)(F.ws + B_QH) + (size_t)unit * 8192 + piece * 8) = (u32x4){lo[0], lo[1], hi[0], hi[1]}; }
        { const int tt = w >> 2, st = w & 3; f32x4 acc = {0.f, 0.f, 0.f, 0.f};
#pragma unroll
            for (int kb = 0; kb < 4; ++kb) acc = MFMA16(*(const LAS bf16x8*)(KB + (16 * st + fr) * RS + (32 * kb + 8 * fq) * 2), *(const LAS bf16x8*)(QB + (16 * tt + fr) * RS + (32 * kb + 8 * fq) * 2), acc);
            const int ta = 32 + 16 * tt + fr, sa = 16 * st + 4 * fq;
#pragma unroll
            for (int j = 0; j < 4; ++j) if (sa + j > ta) acc[j] = 0.f;
            *(LAS u32x2*)(PS + ta * TS + sa * 2) = (u32x2){cvt_pk_bf16(acc[0], acc[1]), cvt_pk_bf16(acc[2], acc[3])}; }
        if (w < 4) { const int tt = w >> 1, st = w & 1; f32x4 acc = {0.f, 0.f, 0.f, 0.f};
#pragma unroll
            for (int kb = 0; kb < 4; ++kb) acc = MFMA16(*(const LAS bf16x8*)(KA + (16 * st + fr) * RS + (32 * kb + 8 * fq) * 2), *(const LAS bf16x8*)(QA + (16 * tt + fr) * RS + (32 * kb + 8 * fq) * 2), acc);
            const int ta = 16 * tt + fr, sa = 16 * st + 4 * fq;
#pragma unroll
            for (int j = 0; j < 4; ++j) if (sa + j > ta) acc[j] = 0.f;
            *(LAS u32x2*)(PS + ta * TS + sa * 2) = (u32x2){cvt_pk_bf16(acc[0], acc[1]), cvt_pk_bf16(acc[2], acc[3])}; }
        __syncthreads();
#pragma unroll
        for (int tt = 0; tt < 4; ++tt) { f32x4 acc = {0.f, 0.f, 0.f, 0.f};
#pragma unroll
            for (int sb = 0; sb < 2; ++sb) if (sb == 0 || tt >= 2) acc = MFMA16(*(const LAS bf16x8*)(VT + (16 * w + fr) * TS + (32 * sb + 8 * fq) * 2), *(const LAS bf16x8*)(PS + (16 * tt + fr) * TS + (32 * sb + 8 * fq) * 2), acc);
            *(u32x2*)((bf16_t*)(F.ws + B_OI) + tm_off(m0 + 16 * tt + fr, k0 + 16 * w + 4 * fq)) = (u32x2){cvt_pk_bf16(acc[0], acc[1]), cvt_pk_bf16(acc[2], acc[3])}; }
        __syncthreads();
    }
}
__device__ __forceinline__ void p_hg_scan(const Frame& F) {
    LAS f32x4* red = (LAS f32x4*)F.lds;
    const int tid = F.tid, lane = F.lane, w = F.wave, fr = lane & 15, fq = lane >> 4;
    const bf16_t* QH = (const bf16_t*)(F.ws + B_QH); const bf16_t* KT = (const bf16_t*)(F.ws + B_KT); const bf16_t* VT = (const bf16_t*)(F.ws + B_VT); const float* DEC = (const float*)(F.ws + B_DEC);
    const bf16_t* OI = (const bf16_t*)(F.ws + B_OI); const bf16_t* GS = (const bf16_t*)(F.ws + B_GS); bf16_t* OG = (bf16_t*)(F.ws + B_OG); float* SSO = (float*)(F.ws + WS_SSO);
    for (int ui = F.bid; ui < 256; ui += F.G) {
        const int unit = (F.G == 256) ? (((ui & 7) * 4 + (ui >> 6)) * 8 + ((ui >> 3) & 7)) : ui;
        const int bh = unit >> 3, vs = unit & 7, b = bh >> 4, h = bh & 15;
        const int tt2 = (tid >> 6) & 3;
        const size_t rowoff = tm_off(b * SEQ + 16 * tt2 + fr, 128 * h + 16 * vs + 4 * fq);
        f32x4 S = {0.f, 0.f, 0.f, 0.f};
        u32x4 qA[2], qB[2]; u32x2 gsA, gsB, oiA, oiB; bf16x8 ktA[2], ktB[2], vtA[2], vtB[2]; f32x4 dA, dB;
#define HG_LOAD(q_, kt_, vt_, d_, oi_, gs_, cc) do { const size_t cu = (size_t)(bh * 128 + (cc)); \
            _Pragma("unroll") for (int pp = 0; pp < 2; ++pp) q_[pp] = *(const u32x4*)(QH + cu * 8192 + ((w * 2 + pp) * 64 + lane) * 8); \
            _Pragma("unroll") for (int sb = 0; sb < 2; ++sb) { kt_[sb] = *(const bf16x8*)(KT + cu * 8192 + ((w * 2 + sb) * 64 + lane) * 8); vt_[sb] = *(const bf16x8*)(VT + cu * 8192 + ((vs * 2 + sb) * 64 + lane) * 8); } \
            d_ = *(const f32x4*)(DEC + cu * 128 + 16 * w + 4 * fq); \
            if (tid < 256) { oi_ = *(const u32x2*)(OI + rowoff + (size_t)(cc) * 131072); gs_ = *(const u32x2*)(GS + rowoff + (size_t)(cc) * 131072); } } while (0)
#define HG_STEP(q_, kt_, vt_, d_, oi_, gs_, cc) do { \
            LAS f32x4* rb = red + ((cc) & 1) * 2048; \
            { const u32x4 sw = {cvt_pk_bf16(S[0], S[1]), cvt_pk_bf16(S[2], S[3]), 0u, 0u}; const bf16x8 Sb = *(const bf16x8*)&sw; \
                _Pragma("unroll") for (int tt = 0; tt < 4; ++tt) { const u32x4 xw = {q_[tt >> 1][2 * (tt & 1)], q_[tt >> 1][2 * (tt & 1) + 1], 0u, 0u}; const f32x4 z = {0.f, 0.f, 0.f, 0.f}; \
                    rb[(w * 4 + tt) * 64 + lane] = MFMA16(Sb, *(const bf16x8*)&xw, z); } }            \
            S = S * d_; S = MFMA16(kt_[0], vt_[0], S); S = MFMA16(kt_[1], vt_[1], S); \
            const u32x2 oiw = oi_; const f32x4 oi = {bflo(oiw[0]), bfhi(oiw[0]), bflo(oiw[1]), bfhi(oiw[1])}; const u32x2 gs = gs_; \
            if ((cc) + 2 < NCH) HG_LOAD(q_, kt_, vt_, d_, oi_, gs_, (cc) + 2); \
            __syncthreads(); \
            if (tid < 256) { f32x4 o = rb[tt2 * 64 + lane]; \
                _Pragma("unroll") for (int ww = 1; ww < 8; ++ww) o += rb[(ww * 4 + tt2) * 64 + lane]; \
                o += oi; float s2 = (o[0] * o[0] + o[1] * o[1]) + (o[2] * o[2] + o[3] * o[3]); s2 += __shfl_xor(s2, 16); s2 += __shfl_xor(s2, 32); \
                *(u32x2*)(OG + rowoff + (size_t)(cc) * 131072) = (u32x2){cvt_pk_bf16(o[0] * bflo(gs[0]), o[1] * bfhi(gs[0])), cvt_pk_bf16(o[2] * bflo(gs[1]), o[3] * bfhi(gs[1]))}; \
                if (fq == 0) SSO[(size_t)(b * SEQ + 64 * (cc) + 16 * tt2 + fr) * 128 + h * 8 + vs] = s2; } } while (0)
        HG_LOAD(qA, ktA, vtA, dA, oiA, gsA, 0);
        HG_LOAD(qB, ktB, vtB, dB, oiB, gsB, 1);
        for (int c = 0; c < NCH; c += 2) { HG_STEP(qA, ktA, vtA, dA, oiA, gsA, c); HG_STEP(qB, ktB, vtB, dB, oiB, gsB, c + 1); }
        __syncthreads();
#undef HG_LOAD
#undef HG_STEP
    }
}

namespace att {
constexpr int KROW = 384, SHM_K = 64 * KROW, SHM_V = 16384, OFF_K = 2 * SHM_V, OFF_WS = OFF_K + 2 * SHM_K;
constexpr float THR = 8.f;
__device__ __forceinline__ int v_rd_base(int lane) { return ((lane & 3) << 3) | (((lane >> 2) & 3) << 6) | (((lane >> 4) & 1) << 5) | (((lane >> 5) & 1) << 8); }
__device__ __forceinline__ int crow(int r, int hi) { return (r & 3) + 8 * (r >> 2) + 4 * hi; }
#define SBAR() __builtin_amdgcn_sched_barrier(0)
__device__ __forceinline__ void mask_tile(f32x16& p0, f32x16& p1, int dq) {
    const float NEG = -__builtin_inff();
#pragma unroll
    for (int r = 0; r < 16; ++r) { const int c = (r & 3) + 8 * (r >> 2); if (dq - c < 0) p0[r] = NEG; if (dq - c - 32 < 0) p1[r] = NEG; }
}
__device__ __forceinline__ void partialSM(f32x16& p0, f32x16& p1, float& m_reg, float& mn, float& alpha) {
    float pmax = p0[0];
#pragma unroll
    for (int r = 1; r < 16; ++r) pmax = fmaxf(pmax, p0[r]);
#pragma unroll
    for (int r = 0; r < 16; ++r) pmax = fmaxf(pmax, p1[r]);
    { auto rr = __builtin_amdgcn_permlane32_swap(__float_as_uint(pmax), __float_as_uint(pmax), false, false); pmax = fmaxf(__uint_as_float(rr[0]), __uint_as_float(rr[1])); }
    constexpr float C2 = 1.4426950408889634f * MLA_SCALE;
    if (__builtin_expect(__all((pmax - m_reg) * MLA_SCALE <= THR), 1)) { mn = m_reg; alpha = 1.f; }
    else { mn = fmaxf(m_reg, pmax); alpha = __builtin_amdgcn_exp2f((m_reg - mn) * C2); m_reg = mn; }
    const float mnL = -mn * C2;
#pragma unroll
    for (int r = 0; r < 16; ++r) p0[r] = __builtin_amdgcn_exp2f(fmaf(p0[r], C2, mnL));
#pragma unroll
    for (int r = 0; r < 16; ++r) p1[r] = __builtin_amdgcn_exp2f(fmaf(p1[r], C2, mnL));
}
__device__ __forceinline__ void finishSM(f32x16& p0, f32x16& p1, float alpha, float& l_reg, bf16x8& pa0, bf16x8& pa1, bf16x8& pa2, bf16x8& pa3) {
    float ps = 0;
#pragma unroll
    for (int r = 0; r < 16; ++r) ps += p0[r];
#pragma unroll
    for (int r = 0; r < 16; ++r) ps += p1[r];
    { auto rr = __builtin_amdgcn_permlane32_swap(__float_as_uint(ps), __float_as_uint(ps), false, false); ps = __uint_as_float(rr[0]) + __uint_as_float(rr[1]); }
    l_reg = l_reg * alpha + ps;
#define PK4(P, B_, OUT) do { unsigned a0 = cvt_pk_bf16(P[B_+0], P[B_+1]), a1 = cvt_pk_bf16(P[B_+2], P[B_+3]); unsigned b0 = cvt_pk_bf16(P[B_+4], P[B_+5]), b1 = cvt_pk_bf16(P[B_+6], P[B_+7]); \
        auto r0 = __builtin_amdgcn_permlane32_swap(a0, b0, false, false); auto r1 = __builtin_amdgcn_permlane32_swap(a1, b1, false, false); \
        u32x4 w_ = {r0[0], r1[0], r0[1], r1[1]}; OUT = *reinterpret_cast<bf16x8*>(&w_); } while (0)
    PK4(p0, 0, pa0); PK4(p0, 8, pa1); PK4(p1, 0, pa2); PK4(p1, 8, pa3);
#undef PK4
}
#define KRD2(dst0, dst1, j, imm) do { asm volatile("ds_read_b128 %0, %1 offset:%2" : "=&v"(dst0) : "v"(kb[j]), "i"(imm) : "memory"); \
                                      asm volatile("ds_read_b128 %0, %1 offset:%2" : "=&v"(dst1) : "v"(kb[j]), "i"((imm) + 32 * KROW) : "memory"); } while (0)
#define LGK(n) asm volatile("s_waitcnt lgkmcnt(%0)" :: "i"(n) : "memory")
template <int KB> __device__ __forceinline__ void qkt(f32x16& p0, f32x16& p1, const int (&kb)[4], const bf16x8* qr) {
    p0 = f32x16{}; p1 = f32x16{};
    bf16x8 ka[4], kc[4];
#define KIMM(d0) (KB * SHM_K + ((d0) >> 2) * 128)
    KRD2(ka[0], kc[0], 0, KIMM(0)); KRD2(ka[1], kc[1], 1, KIMM(1)); KRD2(ka[2], kc[2], 2, KIMM(2));
#define QK_STEP(d0) do { if ((d0) + 3 < 12) KRD2(ka[((d0) + 3) & 3], kc[((d0) + 3) & 3], ((d0) + 3) & 3, KIMM((d0) + 3)); \
        LGK(((d0) + 3 < 12) ? 6 : 2 * (11 - (d0))); SBAR(); \
        p0 = __builtin_amdgcn_mfma_f32_32x32x16_bf16(ka[(d0) & 3], qr[d0], p0, 0, 0, 0); p1 = __builtin_amdgcn_mfma_f32_32x32x16_bf16(kc[(d0) & 3], qr[d0], p1, 0, 0, 0); } while (0)
    QK_STEP(0); QK_STEP(1); QK_STEP(2); QK_STEP(3); QK_STEP(4); QK_STEP(5); QK_STEP(6); QK_STEP(7); QK_STEP(8); QK_STEP(9); QK_STEP(10); QK_STEP(11);
#undef QK_STEP
#undef KIMM
}
#define TRRD(dst, off) asm volatile("ds_read_b64_tr_b16 %0, %1 offset:%2" : "=&v"(dst) : "v"(vb0), "i"(off) : "memory")
#define VRD8(L, H, d0, VB_) do { constexpr int b_ = (VB_) * SHM_V + (d0) * 512; TRRD(L[0], b_); TRRD(H[0], b_ + 2048); TRRD(L[1], b_ + 4096); TRRD(H[1], b_ + 6144); TRRD(L[2], b_ + 8192); TRRD(H[2], b_ + 10240); TRRD(L[3], b_ + 12288); TRRD(H[3], b_ + 14336); } while (0)
#define PVMM(L, H, d0) do { \
        o[d0] = __builtin_amdgcn_mfma_f32_32x32x16_bf16(pa0, (bf16x8){L[0][0], L[0][1], L[0][2], L[0][3], H[0][0], H[0][1], H[0][2], H[0][3]}, o[d0], 0, 0, 0); \
        o[d0] = __builtin_amdgcn_mfma_f32_32x32x16_bf16(pa1, (bf16x8){L[1][0], L[1][1], L[1][2], L[1][3], H[1][0], H[1][1], H[1][2], H[1][3]}, o[d0], 0, 0, 0); \
        o[d0] = __builtin_amdgcn_mfma_f32_32x32x16_bf16(pa2, (bf16x8){L[2][0], L[2][1], L[2][2], L[2][3], H[2][0], H[2][1], H[2][2], H[2][3]}, o[d0], 0, 0, 0); \
        o[d0] = __builtin_amdgcn_mfma_f32_32x32x16_bf16(pa3, (bf16x8){L[3][0], L[3][1], L[3][2], L[3][3], H[3][0], H[3][1], H[3][2], H[3][3]}, o[d0], 0, 0, 0); } while (0)
__device__ __forceinline__ void block(const Frame& F, int bh, int qb) {
    LAS unsigned char* lds = F.lds;
    int lane = F.lane; asm volatile("" : "+v"(lane));
    const int tid = F.tid, wid = F.wave, r32 = lane & 31, hi = lane >> 5, b = bh >> 4, h = bh & 15;
    const bf16_t* KN = (const bf16_t*)(F.ws + B_KN) + (size_t)bh * SEQ * 128; const bf16_t* VV = (const bf16_t*)(F.ws + B_V) + (size_t)bh * SEQ * 128;
    const bf16_t* KR = (const bf16_t*)(F.ws + B_KR) + (size_t)b * SEQ * 64;
    const bf16_t* QN = (const bf16_t*)(F.ws + B_QN) + (size_t)bh * SEQ * 128; const bf16_t* QR = (const bf16_t*)(F.ws + B_QR) + (size_t)bh * SEQ * 64;
    const int q0 = qb * 256, NT = (q0 + 256) / 64, qlo = q0 + wid * 32, qm = qlo + r32 - 4 * hi;
    bf16x8 qr[12];
    { const size_t row = (size_t)(qlo + r32);
#pragma unroll
      for (int d0 = 0; d0 < 8; ++d0) qr[d0] = *(const bf16x8*)(QN + row * 128 + d0 * 16 + hi * 8);
#pragma unroll
      for (int d0 = 0; d0 < 4; ++d0) qr[8 + d0] = *(const bf16x8*)(QR + row * 64 + d0 * 16 + hi * 8); }
    unsigned koff[3], kstr[3], voff[2];
    const unsigned oKN = (unsigned)(B_KN + (size_t)bh * SEQ * 128 * 2), oKR = (unsigned)(B_KR + (size_t)b * SEQ * 64 * 2), oV = (unsigned)(B_V + (size_t)bh * SEQ * 128 * 2);
#pragma unroll
    for (int i = 0; i < 3; ++i) { const int p = (wid * 3 + i) * 64 + lane, r = p / 24, cs = p - r * 24, c = cs ^ ((r >> 1) & 7);
        if (c < 16) { koff[i] = oKN + (unsigned)(r * 128 + 8 * c) * 2u; kstr[i] = 64 * 128 * 2; } else { koff[i] = oKR + (unsigned)(r * 64 + 8 * (c - 16)) * 2u; kstr[i] = 64 * 64 * 2; } }
#pragma unroll
    for (int i = 0; i < 2; ++i) { const int s_ = (wid * 2 + i) * 64 + lane, sub = s_ >> 5, w_ = s_ & 31, kk = (sub >> 2) * 8 + (w_ >> 2), c = (sub & 3) * 32 + (w_ & 3) * 8, k = (kk & ~0xC) | ((kk & 4) << 1) | ((kk & 8) >> 1);
        voff[i] = oV + (unsigned)(k * 128 + c) * 2u; }
    const char* wsb = (const char*)F.ws;
#define A_DMA(t, bf) do { \
        _Pragma("unroll") for (int i = 0; i < 3; ++i) __builtin_amdgcn_global_load_lds((const unsigned*)(wsb + (koff[i] + (unsigned)(t) * kstr[i])), (LAS unsigned*)(lds + OFF_K + (bf) * SHM_K + (wid * 3 + i) * 1024), 16, 0, 0); \
        _Pragma("unroll") for (int i = 0; i < 2; ++i) __builtin_amdgcn_global_load_lds((const unsigned*)(wsb + (voff[i] + (unsigned)(t) * (64u * 128u * 2u))), (LAS unsigned*)(lds + (bf) * SHM_V + (wid * 2 + i) * 1024), 16, 0, 0); } while (0)
    int kb[4];
#pragma unroll
    for (int j = 0; j < 4; ++j) kb[j] = (int)(uintptr_t)lds + OFF_K + r32 * KROW + (((2 * j + hi) ^ ((r32 >> 1) & 7)) << 4);
    const int vb0 = (int)(uintptr_t)lds + v_rd_base(lane);
    LAS float* wsl = (LAS float*)(lds + OFF_WS) + wid * 64; LAS float* li_l = wsl; LAS float* al_l = wsl + 32;
    float m_reg = -1e30f, l_reg = 0.f; f32x16 o[4] = {};
    A_DMA(0, 0);
#define A_STEP(t, VB) do { \
        asm volatile("s_waitcnt vmcnt(0)" ::: "memory"); __syncthreads(); \
        if ((t) + 1 < NT) A_DMA((t) + 1, (VB) ^ 1); \
        const int kb_ = (t) * 64; \
        if (kb_ <= qlo + 31) { f32x16 p0, p1; float mn, alpha; bf16x8 pa0, pa1, pa2, pa3; s16x4 la[4], ha[4], lb[4], hb[4]; \
            qkt<VB>(p0, p1, kb, qr); \
            VRD8(la, ha, 0, VB); SBAR(); \
            if (kb_ + 63 > qlo) { asm volatile("; diagonal tile" ::: "memory"); mask_tile(p0, p1, qm - kb_); } \
            partialSM(p0, p1, m_reg, mn, alpha); \
            if (__any(alpha < 1.f)) { if (hi == 0) al_l[r32] = alpha; asm volatile("s_waitcnt lgkmcnt(0)" ::: "memory"); \
                _Pragma("unroll") for (int d_ = 0; d_ < 4; ++d_) _Pragma("unroll") for (int r = 0; r < 16; ++r) o[d_][r] *= al_l[crow(r, hi)]; } \
            finishSM(p0, p1, alpha, l_reg, pa0, pa1, pa2, pa3); SBAR(); \
            VRD8(lb, hb, 1, VB); LGK(8); SBAR(); PVMM(la, ha, 0); SBAR(); \
            VRD8(la, ha, 2, VB); LGK(8); SBAR(); PVMM(lb, hb, 1); SBAR(); \
            VRD8(lb, hb, 3, VB); LGK(8); SBAR(); PVMM(la, ha, 2); SBAR(); \
            LGK(0); SBAR(); PVMM(lb, hb, 3); } } while (0)
    for (int t = 0; t < NT; t += 2) { A_STEP(t, 0); A_STEP(t + 1, 1); }
    if (hi == 0) li_l[r32] = l_reg; asm volatile("s_waitcnt lgkmcnt(0)" ::: "memory");
    bf16_t* Ow = (bf16_t*)(F.ws + B_O) + (size_t)(b * SEQ + qlo) * D + h * 128;
#pragma unroll
    for (int r = 0; r < 16; ++r) { const int orow = crow(r, hi); const float rl = __builtin_amdgcn_rcpf(li_l[orow]);
#pragma unroll
        for (int d0 = 0; d0 < 4; ++d0) { const float v = o[d0][r] * rl; const float vn = __shfl_xor(v, 1);
            if ((r32 & 1) == 0) *(unsigned*)(Ow + (size_t)orow * D + d0 * 32 + r32) = cvt_pk_bf16(v, vn); } }
    __syncthreads();
#undef A_DMA
#undef A_STEP
}
#undef SBAR
#undef KRD2
#undef LGK
#undef TRRD
#undef VRD8
#undef PVMM
}
__device__ __forceinline__ void p_attn(const Frame& F) {
    const int nIt = (F.G == 256) ? 4 : (1024 - F.bid + F.G - 1) / F.G;
    for (int n = 0; n < nIt; ++n) {
        int bh, qb;
        if (F.G == 256) { const int xcd = F.bid & 7, k = F.bid >> 3, x = k & 15; bh = xcd * 4 + (n >> 1) * 2 + (k >> 4); qb = (n & 1) ? 31 - x : x; }
        else { const int L = F.bid + n * F.G; bh = L >> 5; qb = L & 31; }
        att::block(F, bh, qb);
        if (((((F.bid >> 3) + n) & 3) == 0 || nIt != 4) && !F.probe_rep) conv_moe_part(F, nIt == 4 ? 0 : n, nIt == 4 ? 1 : nIt);
        __syncthreads();
    }
}

constexpr int N_PHASES = 18;
__global__ void __launch_bounds__(512, 2) fwd_kernel(Args args) {
    extern __shared__ __attribute__((aligned(16))) unsigned char lds_raw[];
    Frame F; F.lds = (LAS unsigned char*)lds_raw; F.tid = threadIdx.x; F.lane = F.tid & 63; F.wave = __builtin_amdgcn_readfirstlane(F.tid >> 6); F.G = gridDim.x; F.bid = blockIdx.x;
    F.a = &args; F.ws = args.ws; F.ctl = (unsigned*)(args.ws + WS_CTL);
    volatile LAS unsigned* MISC = (volatile LAS unsigned*)(F.lds + MISC_OFF);
    if (F.tid < 64) MISC[F.tid] = 0u;
    __syncthreads();
    XcdBarrier bar; bar.bar = F.ctl + CW_BAR; bar.x = 0; bar.st = MISC + 8;
    if (MK_N_LAUNCHES == 1) bar = xcd_barrier_post(F.ctl + CW_BAR, MISC + 8);
    const int lo = args.ph_lo, hi = args.ph_hi & 0xffff; F.probe_rep = (args.ph_hi >> 16) != 0;
#define IN(k) (lo <= (k) && (k) < hi)
#ifndef PROBE_REPEAT
#define PROBE_REPEAT (-1)
#endif
#define NREP(k) ((k) == PROBE_REPEAT ? 2 : 1)
#define SEAM(k) do { if (IN(k) && IN((k) + 1)) xcd_barrier(bar); } while (0)
    const char* ws = (const char*)F.ws;
    if (IN(0)) for (int rep_ = 0; rep_ < NREP(0); ++rep_) { if (rep_) xcd_barrier(bar); p_mod(F); } SEAM(0);
    if (IN(1)) for (int rep_ = 0; rep_ < NREP(1); ++rep_) { if (rep_) xcd_barrier(bar); p_conv(F); __syncthreads(); p_thin<0>(F); } SEAM(1);
    if (IN(2)) for (int rep_ = 0; rep_ < NREP(2); ++rep_) { if (rep_) xcd_barrier(bar); pg8::DualOrder S{ws + WS_U, ws + W_IN, ws + WS_U, ws + W_IN, 64, 32, 0, D, F.G, F.bid};
        EpiHgIn E{(bf16_t*)(F.ws + B_Q), (float*)(F.ws + B_LF), (bf16_t*)(F.ws + B_VI), (bf16_t*)(F.ws + B_GS), (const float*)(F.ws + WS_LB), INF(I_HGONG)};
        pg8::gemm_phase(F.lds, D, S, E); } SEAM(2);
    if (IN(3)) for (int rep_ = 0; rep_ < NREP(3); ++rep_) { if (rep_) xcd_barrier(bar); p_hg_chunk(F); } SEAM(3);
    if (IN(4)) for (int rep_ = 0; rep_ < NREP(4); ++rep_) { if (rep_) xcd_barrier(bar); p_hg_scan(F); } SEAM(4);
    if (IN(5)) for (int rep_ = 0; rep_ < NREP(5); ++rep_) { if (rep_) xcd_barrier(bar); pg8::DualOrder S{ws + B_OG, ws + W_OUT, ws + B_OG, ws + W_OUT, 64, 8, 0, D, F.G, F.bid, true}; EpiBf16 E{(bf16_t*)(F.ws + WS_Y), D}; pg8::gemm_phase(F.lds, D, S, E); } SEAM(5);
    if (IN(6)) for (int rep_ = 0; rep_ < NREP(6); ++rep_) { if (rep_) xcd_barrier(bar); p_thin<1>(F); } SEAM(6);
    if (IN(7)) for (int rep_ = 0; rep_ < NREP(7); ++rep_) { if (rep_) xcd_barrier(bar); pg8::DualOrder S{ws + WS_U, ws + W_GU, ws + WS_U, ws + W_GU, 64, 44, 0, D, F.G, F.bid}; EpiGU E{(bf16_t*)(F.ws + B_ACT)}; pg8::gemm_phase(F.lds, D, S, E); } SEAM(7);
    if (IN(8)) for (int rep_ = 0; rep_ < NREP(8); ++rep_) { if (rep_) xcd_barrier(bar); pg8::DualOrder S{ws + B_ACT, ws + W_DN, ws + B_ACT, ws + W_DN, 64, 8, 0, DFF, F.G, F.bid}; EpiBf16 E{(bf16_t*)(F.ws + WS_Y), D}; pg8::gemm_phase(F.lds, DFF, S, E); } SEAM(8);
    if (IN(9)) for (int rep_ = 0; rep_ < NREP(9); ++rep_) { if (rep_) xcd_barrier(bar); p_thin<2>(F); } SEAM(9);
    if (IN(10)) for (int rep_ = 0; rep_ < NREP(10); ++rep_) { if (rep_) xcd_barrier(bar); pg8::DualOrder S{ws + WS_XS, ws + W_LAT, ws + WS_U, ws + W_LAT + (size_t)768 * D * 2, 64, 3, 2, D, F.G, F.bid};
        EpiLat E{(bf16_t*)(F.ws + B_CKV), (bf16_t*)(F.ws + B_QLAT), (bf16_t*)(F.ws + B_KR), (float*)(F.ws + WS_SSC), (float*)(F.ws + WS_SSQ), (const float*)(F.ws + WS_COS), (const float*)(F.ws + WS_SIN)};
        pg8::gemm_phase(F.lds, D, S, E); } SEAM(10);
    if (IN(11)) for (int rep_ = 0; rep_ < NREP(11); ++rep_) { if (rep_) xcd_barrier(bar); pg8::DualOrder S{ws + B_CKV, ws + W_KVQ, ws + B_QLAT, ws + W_KVQ + (size_t)4096 * 512 * 2, 64, 16, 12, 512, F.G, F.bid};
        EpiKvQ E{(bf16_t*)(F.ws + B_KN), (bf16_t*)(F.ws + B_V), (bf16_t*)(F.ws + B_QN), (bf16_t*)(F.ws + B_QR), (const float*)(F.ws + WS_SSC), (const float*)(F.ws + WS_SSQ), (const float*)(F.ws + WS_COS), (const float*)(F.ws + WS_SIN)};
        pg8::gemm_phase(F.lds, 512, S, E); } SEAM(11);
    if (IN(12)) for (int rep_ = 0; rep_ < NREP(12); ++rep_) { if (rep_) xcd_barrier(bar); p_attn(F); } SEAM(12);
    if (IN(13)) for (int rep_ = 0; rep_ < NREP(13); ++rep_) { if (rep_) xcd_barrier(bar); pg8::DualOrder S{ws + B_O, ws + W_O, ws + B_O, ws + W_O, 64, 8, 0, D, F.G, F.bid}; EpiBf16 E{(bf16_t*)(F.ws + WS_Y), D}; pg8::gemm_phase(F.lds, D, S, E); } SEAM(13);
    if (IN(14)) for (int rep_ = 0; rep_ < NREP(14); ++rep_) { if (rep_) xcd_barrier(bar); p_thin<3>(F); } SEAM(14);
    if (IN(15)) for (int rep_ = 0; rep_ < NREP(15); ++rep_) { if (rep_) xcd_barrier(bar); pg8::MoeOrder<true> S; S.A = ws + WS_U; S.W = ws + W_MGU; S.wstride = (size_t)2 * DFF * D; S.list = (const int*)(ws + WS_LIST); S.nN = 44; S.rb = D; S.G = F.G; S.c = F.bid; S.init(F.ctl);
        EpiGU8 E{F.ws + B_ACT2}; pg8::gemm_phase<EpiGU8, pg8::MoeOrder<true>, true>(F.lds, D, S, E); } SEAM(15);
    if (IN(16)) for (int rep_ = 0; rep_ < NREP(16); ++rep_) { if (rep_) xcd_barrier(bar); pg8::MoeOrder<false> S; S.A = ws + B_ACT2; S.W = ws + W_MDN; S.wstride = (size_t)D * DFF; S.list = nullptr; S.nN = 8; S.rb = DFF; S.G = F.G; S.c = F.bid; S.init(F.ctl);
        EpiBf16 E{(bf16_t*)(F.ws + B_Y2), D}; pg8::gemm_phase<EpiBf16, pg8::MoeOrder<false>, true>(F.lds, DFF, S, E); } SEAM(16);
    if (IN(17)) for (int rep_ = 0; rep_ < NREP(17); ++rep_) { if (rep_) xcd_barrier(bar); p_thin<4>(F); }
#undef IN
#undef SEAM
}

extern "C" void kernel_launch(void* const* d_in, const int* in_sizes, int n_in, void* d_out, int out_size, void* d_ws, size_t ws_size, hipStream_t stream) {
    static int grid = 0;
    if (grid == 0) {
        if (n_in != 25 || out_size != M * D || ws_size < WS_NEED) { fprintf(stderr, "kernel_launch: expected 25 inputs, out %d, ws >= %zu; got n_in %d out %d ws %zu\n", M * D, (size_t)WS_NEED, n_in, out_size, ws_size); grid = -1; return; }
        int dev = 0, cus = 0;
        if (hipGetDevice(&dev) != hipSuccess || hipDeviceGetAttribute(&cus, hipDeviceAttributeMultiprocessorCount, dev) != hipSuccess) { grid = -1; return; }
        if (hipFuncSetAttribute((const void*)fwd_kernel, hipFuncAttributeMaxDynamicSharedMemorySize, LDS_BYTES) != hipSuccess) { fprintf(stderr, "kernel_launch: hipFuncSetAttribute failed\n"); grid = -1; return; }
        int per_cu = 0;
        if (hipOccupancyMaxActiveBlocksPerMultiprocessor(&per_cu, (const void*)fwd_kernel, 512, LDS_BYTES) != hipSuccess || per_cu < 1) { fprintf(stderr, "kernel_launch: occupancy query reports %d\n", per_cu); (void)hipGetLastError(); }
        grid = cus;
    }
    if (grid < 0) return;
    (void)hipMemsetAsync((char*)d_ws + WS_CTL, 0, CTL_BYTES, stream);
    Args a{};
    for (int i = 0; i < 25; ++i) a.in[i] = d_in[i];
    a.out = (float*)d_out; a.ws = (unsigned char*)d_ws;
    if (MK_N_LAUNCHES == 1) { a.ph_lo = 0; a.ph_hi = N_PHASES; hipLaunchKernelGGL(fwd_kernel, dim3(grid), dim3(512), LDS_BYTES, stream, a); }
    else for (int p = 0; p < N_PHASES; ++p) { a.ph_lo = p; a.ph_hi = p + 1; hipLaunchKernelGGL(fwd_kernel, dim3(grid), dim3(512), LDS_BYTES, stream, a);
#if defined(PROBE_HOST_REPEAT)
        if (p == PROBE_HOST_REPEAT) { a.ph_hi |= 1 << 16; hipLaunchKernelGGL(fwd_kernel, dim3(grid), dim3(512), LDS_BYTES, stream, a); }
#endif
    }
    const hipError_t le = hipPeekAtLastError();
    if (le != hipSuccess) fprintf(stderr, "kernel_launch: launch failed: %s\n", hipGetErrorName(le));
}
```

```cpp
#include <hip/hip_runtime.h>
#include <cstdio>
#include <cstdint>

#ifndef MK_N_LAUNCHES
#define MK_N_LAUNCHES 1
#endif

#define LAS __attribute__((address_space(3)))
#define GAS __attribute__((address_space(1)))
typedef unsigned short bf16_t;
typedef short bf16x8 __attribute__((ext_vector_type(8)));
typedef short s16x4 __attribute__((ext_vector_type(4)));
typedef float f32x4 __attribute__((ext_vector_type(4)));
typedef float f32x2 __attribute__((ext_vector_type(2)));
typedef float f32x16 __attribute__((ext_vector_type(16)));
typedef unsigned u32x4 __attribute__((ext_vector_type(4)));
typedef unsigned u32x2 __attribute__((ext_vector_type(2)));

constexpr int D = 2048, BATCH = 2, SEQ = 8192, M = BATCH * SEQ;
constexpr int HG_H = 16, HG_K = 128, HG_C = 64, NCH = SEQ / HG_C;
constexpr int MLA_H = 16, QLORA = 512, KVLORA = 512, NOPE = 128, ROPE = 64, VH = 128;
constexpr int DFF = 5632, NEXP = 8;
constexpr float EPS = 1e-6f;
constexpr float MLA_SCALE = 0.07216878364870322f;
constexpr int NMOD = 4 * 6144 + 4096;
constexpr int MOE_MAXT = 136;
constexpr int MOE_ROWS = MOE_MAXT * 256;

constexpr size_t MiB = 1ull << 20;
constexpr size_t WS_CTL = 0;
constexpr size_t CTL_BYTES = 1 * MiB;
constexpr size_t WS_MOD = 1 * MiB;
constexpr size_t WS_LB = WS_MOD + 256 * 1024;
constexpr size_t WS_COS = 2 * MiB;
constexpr size_t WS_SIN = 4 * MiB;
constexpr size_t WS_SSO = 6 * MiB;
constexpr size_t WS_SSC = 14 * MiB;
constexpr size_t WS_SSQ = 15 * MiB;
constexpr size_t WS_TOK = 16 * MiB;
constexpr size_t WS_LIST = 17 * MiB;
constexpr size_t WS_W = 18 * MiB;
constexpr size_t W_IN = WS_W;
constexpr size_t W_OUT = W_IN + (size_t)8192 * 2048 * 2;
constexpr size_t W_GU = W_OUT + (size_t)2048 * 2048 * 2;
constexpr size_t W_DN = W_GU + (size_t)11264 * 2048 * 2;
constexpr size_t W_LAT = W_DN + (size_t)2048 * 5632 * 2;
constexpr size_t W_KVQ = W_LAT + (size_t)1280 * 2048 * 2;
constexpr size_t W_O = W_KVQ + (size_t)7168 * 512 * 2;
constexpr size_t W_MGU = W_O + (size_t)2048 * 2048 * 2;
constexpr size_t W_MDN = W_MGU + (size_t)8 * 11264 * 2048 * 2;
constexpr size_t W_END = W_MDN + (size_t)8 * 2048 * 5632 * 2;
constexpr size_t WS_U = (W_END + MiB - 1) / MiB * MiB;
constexpr size_t WS_XS = WS_U + (size_t)M * D * 2;
constexpr size_t WS_Y = WS_XS + (size_t)M * D * 2;
constexpr size_t WS_XR = WS_Y + (size_t)M * D * 2;
constexpr size_t WS_BIG = WS_Y + (size_t)M * D * 4;
constexpr size_t B_Q = WS_BIG;
constexpr size_t B_LF = B_Q + (size_t)M * D * 2;
constexpr size_t B_VI = B_LF + (size_t)M * D * 4;
constexpr size_t B_GS = B_VI + (size_t)M * D * 2;
constexpr size_t B_QH = B_GS + (size_t)M * D * 2;
constexpr size_t B_KT = B_QH + (size_t)M * D * 2;
constexpr size_t B_VT = B_KT + (size_t)M * D * 2;
constexpr size_t B_DEC = B_VT + (size_t)M * D * 2;
constexpr size_t B_OI = B_DEC + (size_t)4096 * 128 * 4;
constexpr size_t B_OG = B_Q;
constexpr size_t B_HG_END = B_OI + (size_t)M * D * 4;
constexpr size_t B_ACT = WS_BIG;
constexpr size_t B_CKV = WS_BIG;
constexpr size_t B_QLAT = B_CKV + (size_t)M * 512 * 2;
constexpr size_t B_KR = B_QLAT + (size_t)M * 512 * 2;
constexpr size_t B_KN = B_KR + (size_t)M * 64 * 2;
constexpr size_t B_V = B_KN + (size_t)M * D * 2;
constexpr size_t B_QN = B_V + (size_t)M * D * 2;
constexpr size_t B_QR = B_QN + (size_t)M * D * 2;
constexpr size_t B_O = B_QR + (size_t)M * 1024 * 2;
constexpr size_t B_MLA_END = B_O + (size_t)M * D * 2;
constexpr size_t B_ACT2 = WS_BIG;
constexpr size_t B_Y2 = B_ACT2 + (size_t)MOE_ROWS * DFF * 2;
constexpr size_t B_MOE_END = B_Y2 + (size_t)MOE_ROWS * D * 4;
constexpr size_t WS_NEED = (B_HG_END > B_MOE_END ? (B_HG_END > B_MLA_END ? B_HG_END : B_MLA_END) : (B_MOE_END > B_MLA_END ? B_MOE_END : B_MLA_END));

constexpr int CW_BAR = 4096;
constexpr int CW_CNT = 16384;
constexpr int LDS_BYTES = 147456;
constexpr int MISC_OFF = 131072 + 8192;

typedef __bf16 bf16x2_t __attribute__((ext_vector_type(2)));
__device__ __forceinline__ unsigned cvt_pk_bf16(float lo, float hi) { const f32x2 v = {lo, hi}; return __builtin_bit_cast(unsigned, __builtin_convertvector(v, bf16x2_t)); }
__device__ __forceinline__ float bf2f(bf16_t v) { return __uint_as_float(((unsigned)v) << 16); }
__device__ __forceinline__ float bflo(unsigned w) { return __uint_as_float(w << 16); }
__device__ __forceinline__ float bfhi(unsigned w) { return __uint_as_float(w & 0xffff0000u); }
__device__ __forceinline__ bf16_t f2bf(float f) { return (bf16_t)(cvt_pk_bf16(f, 0.f) & 0xffffu); }
__device__ __forceinline__ float wave_sum(float v) {
    v += __builtin_bit_cast(float, __builtin_amdgcn_update_dpp(0, __builtin_bit_cast(int, v), 0xB1, 0xf, 0xf, false));
    v += __builtin_bit_cast(float, __builtin_amdgcn_update_dpp(0, __builtin_bit_cast(int, v), 0x4E, 0xf, 0xf, false));
    v += __builtin_bit_cast(float, __builtin_amdgcn_update_dpp(0, __builtin_bit_cast(int, v), 0x141, 0xf, 0xf, false));
    v += __builtin_bit_cast(float, __builtin_amdgcn_update_dpp(0, __builtin_bit_cast(int, v), 0x140, 0xf, 0xf, false));
    { auto r = __builtin_amdgcn_permlane16_swap(__float_as_uint(v), __float_as_uint(v), false, false); v = __uint_as_float(r[0]) + __uint_as_float(r[1]); }
    { auto r = __builtin_amdgcn_permlane32_swap(__float_as_uint(v), __float_as_uint(v), false, false); v = __uint_as_float(r[0]) + __uint_as_float(r[1]); }
    return v;
}
__device__ __forceinline__ float sigmoidf_(float x) { return __builtin_amdgcn_rcpf(1.0f + __builtin_amdgcn_exp2f(x * -1.4426950408889634f)); }
__device__ __forceinline__ float siluf_(float x) { return x * __builtin_amdgcn_rcpf(1.0f + __builtin_amdgcn_exp2f(x * -1.4426950408889634f)); }

#define XB_TMO      128
#define XB_XCNT(j)  (256  + 64 * (j))
#define XB_XSUB(j)  (1280 + 64 * (j))
#define XB_XGEN(j)  (2304 + 64 * (j))
#define XB_TOP      3328
#define XB_TOPGEN   3392
#define XCD_BAR_WORDS 3456
#define XB_SPIN_CAP (1u << 22)

__device__ __forceinline__ unsigned xb_ld(unsigned* p)              { return __hip_atomic_load(p, __ATOMIC_RELAXED, __HIP_MEMORY_SCOPE_AGENT); }
__device__ __forceinline__ unsigned xb_add(unsigned* p, unsigned v) { return __hip_atomic_fetch_add(p, v, __ATOMIC_RELAXED, __HIP_MEMORY_SCOPE_AGENT); }
__device__ __forceinline__ unsigned xb_xcc_id() { return (unsigned)__builtin_amdgcn_s_getreg((3 << 11) | 20) & 0xFu; }
#define XB_SPIN(cond, bar) do { unsigned _sp = 0; while (cond) { __builtin_amdgcn_s_sleep(1); \
    if ((++_sp & 255u) == 0u) { if (xb_ld(&(bar)[XB_TMO])) break; if (_sp > XB_SPIN_CAP) { atomicAdd(&(bar)[XB_TMO], 1u); break; } } } } while (0)

struct XcdBarrier { unsigned* bar; unsigned x; volatile LAS unsigned* st; };

__device__ __forceinline__ XcdBarrier xcd_barrier_post(unsigned* bar, volatile LAS unsigned* st) {
    XcdBarrier b; b.bar = bar; b.x = xb_xcc_id(); b.st = st;
    if (threadIdx.x == 0) (void)xb_add(&bar[XB_XCNT(b.x)], 1u);
    return b;
}
__device__ __forceinline__ void xcd_barrier_complete(unsigned* bar, unsigned x, unsigned& nloc, unsigned& nx) {
    const unsigned G = gridDim.x * gridDim.y * gridDim.z;
    unsigned sum, cnt, mine, sp = 0u;
    for (;;) {
        sum = 0u; cnt = 0u; mine = 0u;
#pragma unroll
        for (unsigned j = 0; j < 16; ++j) { const unsigned c = xb_ld(&bar[XB_XCNT(j)]); sum += c; cnt += (c > 0u) ? 1u : 0u; mine = (j == x) ? c : mine; }
        if (sum == G) break;
        __builtin_amdgcn_s_sleep(1);
        if ((++sp & 255u) == 0u) { if (xb_ld(&bar[XB_TMO])) break; if (sp > XB_SPIN_CAP) { atomicAdd(&bar[XB_TMO], 1u); break; } }
    }
    nloc = mine > 0u ? mine : 1u; nx = cnt > 0u ? cnt : 1u;
}
__device__ __forceinline__ void xcd_barrier(const XcdBarrier& b) {
    asm volatile("s_waitcnt vmcnt(0)" ::: "memory");
    __syncthreads();
    if (threadIdx.x == 0) {
        unsigned* bar = b.bar;
        __builtin_amdgcn_s_waitcnt(0);
        unsigned nloc = b.st[0], nx = b.st[1];
        if (nloc == 0u) { xcd_barrier_complete(bar, b.x, nloc, nx); b.st[0] = nloc; b.st[1] = nx; }
        const unsigned old = xb_add(&bar[XB_XSUB(b.x)], 1u);
        const unsigned gen = old / nloc;
        if (old + 1u == (gen + 1u) * nloc) {
            __builtin_amdgcn_fence(__ATOMIC_RELEASE, "agent");
            asm volatile("s_waitcnt vmcnt(0)" ::: "memory");
            const unsigned og = xb_add(&bar[XB_TOP], 1u);
            const unsigned tg = og / nx;
            if (og + 1u == (tg + 1u) * nx) xb_add(&bar[XB_TOPGEN], 1u);
            else XB_SPIN(xb_ld(&bar[XB_TOPGEN]) == tg, bar);
            __builtin_amdgcn_fence(__ATOMIC_ACQUIRE, "agent");
            xb_add(&bar[XB_XGEN(b.x)], 1u);
            asm volatile("s_waitcnt vmcnt(0)" ::: "memory");
        } else {
            XB_SPIN(xb_ld(&bar[XB_XGEN(b.x)]) == gen, bar);
            __builtin_amdgcn_fence(__ATOMIC_ACQUIRE, "agent");
            asm volatile("s_waitcnt vmcnt(0)" ::: "memory");
        }
    }
    __syncthreads();
}

namespace pg8 {
constexpr int BM = 256, BK = 64, HALF = 128, HTB = HALF * BK * 2, STAGE_BYTES = 8 * HTB, NXCD = 8, WGM = 8;
__device__ __forceinline__ int lds_byte(int r, int c) { const int st = (r >> 4) * 2 + (c >> 5), rr = r & 15, cc = c & 31, ob = rr * 64 + cc * 2; return st * 1024 + (ob ^ (((ob >> 9) & 1) << 5)); }
__device__ __forceinline__ void stage_rc(int b, int& R, int& C) { const int st = b / 1024, sb = b % 1024, swz = sb ^ (((sb >> 9) & 1) << 5); R = (st >> 1) * 16 + swz / 64; C = (st & 1) * 32 + (swz % 64) / 2; }
__device__ __forceinline__ int perm32(int rho) { const int n = rho >> 4, i = rho & 15; return 8 * (i >> 2) + 4 * n + (i & 3); }

struct Unit { const char* a; const char* b; int pm, pn, e, nv; };

__device__ __forceinline__ void tile_of(int L, int nM, int nN, int& pm, int& pn) {
    const int nwg = nM * nN; int wgid = L;
    { const int q = nwg / NXCD, r = nwg % NXCD, xcd = wgid % NXCD, off = wgid / NXCD; wgid = (xcd < r ? xcd * (q + 1) : r * (q + 1) + (xcd - r) * q) + off; }
    const int nig = WGM * nN, gid = wgid / nig, fm = gid * WGM, gsz = (nM - fm) < WGM ? (nM - fm) : WGM;
    pm = fm + ((wgid % nig) % gsz); pn = (wgid % nig) / gsz;
}
struct DualOrder {
    static constexpr bool GATHER = false;
    const char *A1, *B1, *A2, *B2; int nM, nN1, nN2, K, G, c; bool tmA = false;
    __device__ __forceinline__ bool next(int i, Unit& u) const {
        const int nN = nN1 + nN2; const long L = (long)i * G + c; if (L >= (long)nM * nN) return false;
        int pm, pn; tile_of((int)L, nM, nN, pm, pn);
        const size_t tstep = (size_t)BM * K * 2;
        if (pn < nN1) { u.e = 0; u.pn = pn; u.a = A1 + pm * tstep; u.b = B1 + pn * tstep; }
        else { u.e = 1; u.pn = pn - nN1; u.a = A2 + pm * tstep; u.b = B2 + (pn - nN1) * tstep; }
        u.pm = pm; u.nv = 256; return true;
    }
    __device__ __forceinline__ const int* rows(const Unit&) const { return nullptr; }
};
template <bool GATHER_> struct MoeOrder {
    static constexpr bool GATHER = GATHER_;
    static constexpr bool tmA = false;
    const char* A; const char* W; size_t wstride; const int* list; int nT, nN, rb  , G, c; int tstart[NEXP + 1]; int cnt[NEXP];
    __device__ __forceinline__ void init(const unsigned* ctl) {
        int t = 0;
#pragma unroll
        for (int e = 0; e < NEXP; ++e) { const int n = (int)ctl[CW_CNT + 64 * e]; cnt[e] = n; tstart[e] = t; t += (n + 255) >> 8; }
        tstart[NEXP] = t; nT = t;
    }
    __device__ __forceinline__ bool next(int i, Unit& u) const {
        const long L = (long)i * G + c; if (L >= (long)nT * nN) return false;
        int pm, pn; tile_of((int)L, nT, nN, pm, pn);
        int e = 0;
#pragma unroll
        for (int j = 1; j < NEXP; ++j) e += (pm >= tstart[j]) ? 1 : 0;
        int ce = 0, ts = 0;
#pragma unroll
        for (int j = 0; j < NEXP; ++j) { ce = (j == e) ? cnt[j] : ce; ts = (j == e) ? tstart[j] : ts; }
        u.e = e; u.pm = pm; u.pn = pn; const int left = ce - (pm - ts) * 256; u.nv = left < 256 ? left : 256;
        u.a = GATHER ? A : A + (size_t)pm * BM * rb; u.b = W + (size_t)e * wstride + (size_t)pn * BM * rb;
        return true;
    }
    __device__ __forceinline__ const int* rows(const Unit& u) const { int ts = 0;
#pragma unroll
        for (int j = 0; j < NEXP; ++j) ts = (j == u.e) ? tstart[j] : ts;
        return list + (size_t)u.e * M + (u.pm - ts) * 256; }
};

typedef int i32x4 __attribute__((ext_vector_type(4)));
typedef int i32x8 __attribute__((ext_vector_type(8)));
constexpr float W8_SCALE = 128.0f; constexpr int W8_EXP = 0x78787878, ONE_EXP = 0x7f7f7f7f;
template <class Epi, class Sched, bool FP8 = false>
__device__ __forceinline__ void gemm_phase(LAS unsigned char* lds, const int Kel, const Sched& S, const Epi& E) {
    const int K = FP8 ? Kel / 2 : Kel;
    const int tid = threadIdx.x, wid = __builtin_amdgcn_readfirstlane(tid >> 6), lane = tid & 63, wr = wid >> 2, wc = wid & 3, fr = lane & 15, fq = lane >> 4;
    const int nt = K / BK;
    unsigned vA[2][2], vB[2]; int Rr[2], Cc[2];
#pragma unroll
    for (int i = 0; i < 2; ++i) { int R, C; stage_rc(tid * 16 + i * 8192, R, C); Rr[i] = R; Cc[i] = C; const int Rb = Epi::PERM ? ((R & ~31) + perm32(R & 31)) : R;
        vB[i] = (unsigned)(Rb * K + C) * 2u; }
    const size_t kstep = (size_t)(BK * 2), kstepA = S.tmA ? (size_t)8192 : kstep;
    const size_t hstep = (size_t)HALF * K * 2;
    const unsigned ldsw = (unsigned)wid * 1024u;
    const int aoff = lds_byte(wr * 64 + fr, fq * 8), boff = lds_byte(wc * 32 + fr, fq * 8);
#define PG8_SA(b, h) (((b) * 2 + (h)) * HTB)
#define PG8_SB(b, h) ((4 + (b) * 2 + (h)) * HTB)
#define PG8_STAGE2(bufoff, gbase, v0, v1) do { \
        __builtin_amdgcn_global_load_lds((const unsigned*)((const char*)(gbase) + (v0)), (LAS unsigned*)(lds + (bufoff) + ldsw), 16, 0, 0); \
        __builtin_amdgcn_global_load_lds((const unsigned*)((const char*)(gbase) + (v1)), (LAS unsigned*)(lds + (bufoff) + ldsw + 8192), 16, 0, 0); } while (0)
#define PG8_STAGEB(bufoff, gbase) PG8_STAGE2(bufoff, gbase, vB[0], vB[1])
#define PG8_LD8(p) __builtin_shufflevector(*(const LAS i32x4*)(p), *(const LAS i32x4*)((p) + 1024), 0, 1, 2, 3, 4, 5, 6, 7)
#define PG8_LDA(dst, b, h) do { if constexpr (FP8) { _Pragma("unroll") for (int m = 0; m < 4; ++m) dst##8[m] = PG8_LD8(lds + PG8_SA(b, h) + aoff + m * 2048); } \
        else { _Pragma("unroll") for (int m = 0; m < 4; ++m) _Pragma("unroll") for (int k = 0; k < 2; ++k) dst[m][k] = *(const LAS bf16x8*)(lds + PG8_SA(b, h) + aoff + m * 2048 + k * 1024); } } while (0)
#define PG8_LDB(dst, b, h) do { if constexpr (FP8) { _Pragma("unroll") for (int n = 0; n < 2; ++n) dst##8[n] = PG8_LD8(lds + PG8_SB(b, h) + boff + n * 2048); } \
        else { _Pragma("unroll") for (int n = 0; n < 2; ++n) _Pragma("unroll") for (int k = 0; k < 2; ++k) dst[n][k] = *(const LAS bf16x8*)(lds + PG8_SB(b, h) + boff + n * 2048 + k * 1024); } } while (0)
#define PG8_MMA(ai, bj, At, Bt) do { __builtin_amdgcn_s_setprio(1); _Pragma("unroll") for (int m = 0; m < 4; ++m) _Pragma("unroll") for (int n = 0; n < 2; ++n) { \
        if constexpr (FP8) asm volatile("v_mfma_scale_f32_16x16x128_f8f6f4 %0, %1, %2, %0, %3, %4 op_sel_hi:[0,0,0]" : "+v"(acc[ai][bj][m][n]) : "v"(Bt##8[n]), "v"(At##8[m]), "v"(sc_w8), "v"(sc_one)); \
        else { _Pragma("unroll") for (int k = 0; k < 2; ++k) acc[ai][bj][m][n] = __builtin_amdgcn_mfma_f32_16x16x32_bf16(Bt[n][k], At[m][k], acc[ai][bj][m][n], 0, 0, 0); } } \
        __builtin_amdgcn_s_setprio(0); } while (0)
#define PG8_WAIT_V(n) asm volatile("s_waitcnt vmcnt(" #n ")" ::: "memory")
#define PG8_WAIT_L(n) asm volatile("s_waitcnt lgkmcnt(" #n ")" ::: "memory")
#define PG8_BAR __builtin_amdgcn_s_barrier()
#define PG8_SCHED __builtin_amdgcn_sched_barrier(0)
    Unit cur, nxt; int ui = 0;
    if (!S.next(0, cur)) return;
    if constexpr (Sched::GATHER) { const int* rl = S.rows(cur);
#pragma unroll
        for (int h = 0; h < 2; ++h)
#pragma unroll
            for (int i = 0; i < 2; ++i) { const int j = Rr[i] + 128 * h; const int tok = (j < cur.nv) ? rl[j] : 0; vA[h][i] = (unsigned)(tok * K + Cc[i]) * 2u; } }
    else {
#pragma unroll
        for (int h = 0; h < 2; ++h)
#pragma unroll
            for (int i = 0; i < 2; ++i) { const int row = Rr[i] + 128 * h; vA[h][i] = S.tmA ? (unsigned)((row >> 6) * 262144 + (Cc[i] >> 4) * 2048 + (row & 63) * 32 + (Cc[i] & 15) * 2) : (unsigned)(row * K + Cc[i]) * 2u; } }
    LAS unsigned char* idx_lds = lds + STAGE_BYTES + wid * 1024;
    f32x4 acc[2][2][4][2];
#pragma unroll
    for (int a = 0; a < 2; ++a)
#pragma unroll
        for (int b = 0; b < 2; ++b)
#pragma unroll
            for (int m = 0; m < 4; ++m)
#pragma unroll
                for (int n = 0; n < 2; ++n) acc[a][b][m][n] = (f32x4){0.f, 0.f, 0.f, 0.f};
    bf16x8 At[4][2], B0[2][2], B1[2][2]; i32x8 At8[4], B08[2], B18[2];
    int sc_w8 = W8_EXP, sc_one = ONE_EXP; asm volatile("" : "+v"(sc_w8), "+v"(sc_one));
    const char* cA = cur.a; const char* cB = cur.b;
    PG8_STAGEB(PG8_SB(0, 0), cB); PG8_STAGEB(PG8_SB(0, 1), cB + hstep); PG8_STAGE2(PG8_SA(0, 0), cA, vA[0][0], vA[0][1]); PG8_STAGE2(PG8_SA(0, 1), cA, vA[1][0], vA[1][1]);
    if (wr == 1) PG8_BAR;
    PG8_WAIT_V(2); PG8_BAR;
    PG8_STAGEB(PG8_SB(1, 0), cB + kstep); PG8_STAGE2(PG8_SA(1, 0), cA + kstepA, vA[0][0], vA[0][1]); PG8_STAGEB(PG8_SB(1, 1), cB + hstep + kstep);
    PG8_WAIT_V(6); PG8_BAR;
    for (;;) {
        const bool has_next = S.next(ui + 1, nxt);
        const char* nA = has_next ? nxt.a : cA; const char* nB = has_next ? nxt.b : cB;
        for (int t = 0; t < nt; t += 2) {
            const bool last = (t == nt - 2);
            if constexpr (Sched::GATHER) { if (t == nt - 6 && has_next) { const int* rl = S.rows(nxt);
#pragma unroll
                for (int h = 0; h < 2; ++h)
#pragma unroll
                    for (int i = 0; i < 2; ++i) __builtin_amdgcn_global_load_lds((const unsigned*)(rl + Rr[i] + 128 * h), (LAS unsigned*)(idx_lds + (h * 2 + i) * 256), 4, 0, 0); } }
            const char* a1 = cA + (size_t)(t + 1) * kstepA;
            const char* a2 = last ? nA : cA + (size_t)(t + 2) * kstepA; const char* b2 = last ? nB : cB + (size_t)(t + 2) * kstep;
            const char* a3 = a2 + kstepA; const char* b3 = b2 + kstep;
            PG8_LDB(B0, 0, 0); PG8_LDB(B1, 0, 1); PG8_SCHED; PG8_LDA(At, 0, 0); PG8_STAGE2(PG8_SA(1, 1), a1, vA[1][0], vA[1][1]);
            if constexpr (Sched::GATHER) { if (last && has_next) {
#pragma unroll
                for (int h = 0; h < 2; ++h)
#pragma unroll
                    for (int i = 0; i < 2; ++i) { const int j = Rr[i] + 128 * h; const int tok = *(const LAS int*)(idx_lds + (h * 2 + i) * 256 + lane * 4); vA[h][i] = (unsigned)(((j < nxt.nv) ? tok : 0) * K + Cc[i]) * 2u; } } }
            PG8_WAIT_V(8); PG8_WAIT_L(0); PG8_BAR; PG8_MMA(0, 0, At, B0); PG8_MMA(0, 1, At, B1); PG8_BAR; PG8_SCHED;
            PG8_LDA(At, 0, 1); PG8_STAGEB(PG8_SB(0, 0), b2); PG8_STAGEB(PG8_SB(0, 1), b2 + hstep); PG8_STAGE2(PG8_SA(0, 0), a2, vA[0][0], vA[0][1]);
            PG8_WAIT_V(8); PG8_WAIT_L(0); PG8_BAR; PG8_MMA(1, 0, At, B0); PG8_MMA(1, 1, At, B1); PG8_BAR; PG8_SCHED;
            PG8_LDB(B0, 1, 0); PG8_LDB(B1, 1, 1); PG8_SCHED; PG8_LDA(At, 1, 0); PG8_STAGE2(PG8_SA(0, 1), a2, vA[1][0], vA[1][1]);
            PG8_WAIT_V(8); PG8_WAIT_L(0); PG8_BAR; PG8_MMA(0, 0, At, B0); PG8_MMA(0, 1, At, B1); PG8_BAR; PG8_SCHED;
            PG8_LDA(At, 1, 1); PG8_STAGEB(PG8_SB(1, 0), b3); PG8_STAGEB(PG8_SB(1, 1), b3 + hstep); PG8_STAGE2(PG8_SA(1, 0), a3, vA[0][0], vA[0][1]);
            PG8_WAIT_V(8); PG8_WAIT_L(0); PG8_BAR; PG8_MMA(1, 0, At, B0); PG8_MMA(1, 1, At, B1); PG8_BAR; PG8_SCHED;
        }
        if (wr == 0) PG8_BAR;
        if constexpr (FP8) asm volatile("s_nop 15\n\ts_nop 15" ::: "memory");
        E(acc, cur, wr, wc, fr, fq);
        if (!has_next) break;
#pragma unroll
        for (int a = 0; a < 2; ++a)
#pragma unroll
            for (int b = 0; b < 2; ++b)
#pragma unroll
                for (int m = 0; m < 4; ++m)
#pragma unroll
                    for (int n = 0; n < 2; ++n) acc[a][b][m][n] = (f32x4){0.f, 0.f, 0.f, 0.f};
        cur = nxt; cA = nA; cB = nB; ++ui;
        if (wr == 1) PG8_BAR;
    }
    PG8_WAIT_V(0);
    PG8_BAR;
#undef PG8_SA
#undef PG8_SB
#undef PG8_STAGE2
#undef PG8_STAGEB
#undef PG8_LDA
#undef PG8_LD8
#undef PG8_LDB
#undef PG8_MMA
#undef PG8_WAIT_V
#undef PG8_WAIT_L
#undef PG8_BAR
#undef PG8_SCHED
}
}
using pg8::Unit;

__device__ __forceinline__ size_t tm_off(int m, int ch) { return ((((size_t)(m >> 6) * 128 + (ch >> 4)) * 64 + (m & 63)) * 16 + (ch & 15)); }
typedef f32x4 Acc[2][2][4][2];
__device__ __forceinline__ u32x4 pack8(f32x4 a, f32x4 b) { return (u32x4){cvt_pk_bf16(a[0], a[1]), cvt_pk_bf16(a[2], a[3]), cvt_pk_bf16(b[0], b[1]), cvt_pk_bf16(b[2], b[3])}; }

__device__ __forceinline__ u32x2 pack8_fp8(f32x4 a, f32x4 b) { int w0 = 0, w1 = 0;
    w0 = __builtin_amdgcn_cvt_pk_fp8_f32(a[0], a[1], w0, false); w0 = __builtin_amdgcn_cvt_pk_fp8_f32(a[2], a[3], w0, true);
    w1 = __builtin_amdgcn_cvt_pk_fp8_f32(b[0], b[1], w1, false); w1 = __builtin_amdgcn_cvt_pk_fp8_f32(b[2], b[3], w1, true); return (u32x2){(unsigned)w0, (unsigned)w1}; }
struct EpiHgIn {
    static constexpr bool PERM = true;
    bf16_t* Q; float* LF; bf16_t* VI; bf16_t* GS; const float* lb; const float* gn;
    __device__ __forceinline__ void operator()(const Acc& acc, const Unit& u, int wr, int wc, int fr, int fq) const {
        const int type = u.pn >> 3, row0 = u.pm * 256 + wr * 64 + fr, col0 = (u.pn & 7) * 256 + wc * 32 + 8 * fq;
        if (type == 0 || type == 2) { bf16_t* O = type == 0 ? Q : VI;
#pragma unroll
            for (int ai = 0; ai < 2; ++ai)
#pragma unroll
                for (int m = 0; m < 4; ++m) { bf16_t* rowp = O + (size_t)(row0 + ai * 128 + m * 16) * D + col0;
#pragma unroll
                    for (int bj = 0; bj < 2; ++bj) *(u32x4*)(rowp + bj * 128) = pack8(acc[ai][bj][m][0], acc[ai][bj][m][1]); }
        } else if (type == 1) {
#pragma unroll
            for (int bj = 0; bj < 2; ++bj) { const f32x4 l0 = *(const f32x4*)(lb + col0 + bj * 128), l1 = *(const f32x4*)(lb + col0 + bj * 128 + 4);
#pragma unroll
                for (int ai = 0; ai < 2; ++ai)
#pragma unroll
                    for (int m = 0; m < 4; ++m) { _Float16* rowp = (_Float16*)LF + (size_t)(row0 + ai * 128 + m * 16) * D + col0 + bj * 128; f32x4 o0, o1;
#pragma unroll
                        for (int j = 0; j < 4; ++j) { o0[j] = __builtin_amdgcn_logf(1.f - (1.f - l0[j]) * sigmoidf_(-acc[ai][bj][m][0][j])) * 0.6931471805599453f; o1[j] = __builtin_amdgcn_logf(1.f - (1.f - l1[j]) * sigmoidf_(-acc[ai][bj][m][1][j])) * 0.6931471805599453f; }
                        typedef _Float16 h8 __attribute__((ext_vector_type(8)));
                        *(h8*)rowp = (h8){(_Float16)o0[0], (_Float16)o0[1], (_Float16)o0[2], (_Float16)o0[3], (_Float16)o1[0], (_Float16)o1[1], (_Float16)o1[2], (_Float16)o1[3]}; } }
        } else {
#pragma unroll
            for (int bj = 0; bj < 2; ++bj) { const f32x4 g0 = *(const f32x4*)(gn + col0 + bj * 128), g1 = *(const f32x4*)(gn + col0 + bj * 128 + 4);
#pragma unroll
                for (int ai = 0; ai < 2; ++ai)
#pragma unroll
                    for (int m = 0; m < 4; ++m) { bf16_t* rowp = GS + tm_off(row0 + ai * 128 + m * 16, col0 + bj * 128); f32x4 o0, o1;
#pragma unroll
                        for (int j = 0; j < 4; ++j) { o0[j] = siluf_(acc[ai][bj][m][0][j]) * g0[j]; o1[j] = siluf_(acc[ai][bj][m][1][j]) * g1[j]; }
                        *(u32x4*)rowp = pack8(o0, o1); } }
        }
    }
};
struct EpiNull {
    static constexpr bool PERM = false;
    __device__ __forceinline__ void operator()(const Acc& acc, const Unit& u, int wr, int wc, int fr, int fq) const {
#pragma unroll
        for (int ai = 0; ai < 2; ++ai)
#pragma unroll
            for (int bj = 0; bj < 2; ++bj)
#pragma unroll
                for (int m = 0; m < 4; ++m)
#pragma unroll
                    for (int n = 0; n < 2; ++n) asm volatile("" :: "v"(acc[ai][bj][m][n]));
    }
};
struct EpiF32 {
    static constexpr bool PERM = false;
    float* C; int ldc;
    __device__ __forceinline__ void operator()(const Acc& acc, const Unit& u, int wr, int wc, int fr, int fq) const {
        const int row0 = u.pm * 256 + wr * 64 + fr, col0 = u.pn * 256 + wc * 32 + 4 * fq;
#pragma unroll
        for (int ai = 0; ai < 2; ++ai)
#pragma unroll
            for (int m = 0; m < 4; ++m) { float* rowp = C + (size_t)(row0 + ai * 128 + m * 16) * ldc + col0;
#pragma unroll
                for (int bj = 0; bj < 2; ++bj)
#pragma unroll
                    for (int n = 0; n < 2; ++n) *(f32x4*)(rowp + bj * 128 + n * 16) = acc[ai][bj][m][n]; }
    }
};
struct EpiBf16 {
    static constexpr bool PERM = true;
    bf16_t* C; int ldc;
    __device__ __forceinline__ void operator()(const Acc& acc, const Unit& u, int wr, int wc, int fr, int fq) const {
        const int row0 = u.pm * 256 + wr * 64 + fr, col0 = u.pn * 256 + wc * 32 + 8 * fq;
#pragma unroll
        for (int ai = 0; ai < 2; ++ai)
#pragma unroll
            for (int m = 0; m < 4; ++m) { bf16_t* rowp = C + (size_t)(row0 + ai * 128 + m * 16) * ldc + col0;
#pragma unroll
                for (int bj = 0; bj < 2; ++bj) *(u32x4*)(rowp + bj * 128) = pack8(acc[ai][bj][m][0], acc[ai][bj][m][1]); }
    }
};
struct EpiGU {
    static constexpr bool PERM = true;
    bf16_t* ACT;
    __device__ __forceinline__ void operator()(const Acc& acc, const Unit& u, int wr, int wc, int fr, int fq) const {
        const int row0 = u.pm * 256 + wr * 64 + fr, col0 = u.pn * 128 + wc * 32 + 8 * fq;
#pragma unroll
        for (int ai = 0; ai < 2; ++ai)
#pragma unroll
            for (int m = 0; m < 4; ++m) { f32x4 o0, o1;
#pragma unroll
                for (int j = 0; j < 4; ++j) { o0[j] = siluf_(acc[ai][0][m][0][j]) * acc[ai][1][m][0][j]; o1[j] = siluf_(acc[ai][0][m][1][j]) * acc[ai][1][m][1][j]; }
                *(u32x4*)(ACT + (size_t)(row0 + ai * 128 + m * 16) * DFF + col0) = pack8(o0, o1); }
    }
};
struct EpiGU8 {
    static constexpr bool PERM = true;
    unsigned char* ACT;
    __device__ __forceinline__ void operator()(const Acc& acc, const Unit& u, int wr, int wc, int fr, int fq) const {
        const int row0 = u.pm * 256 + wr * 64 + fr, col0 = u.pn * 128 + wc * 32 + 8 * fq;
#pragma unroll
        for (int ai = 0; ai < 2; ++ai)
#pragma unroll
            for (int m = 0; m < 4; ++m) { f32x4 o0, o1;
#pragma unroll
                for (int j = 0; j < 4; ++j) { o0[j] = __builtin_amdgcn_fmed3f(siluf_(acc[ai][0][m][0][j]) * acc[ai][1][m][0][j], -448.f, 448.f); o1[j] = __builtin_amdgcn_fmed3f(siluf_(acc[ai][0][m][1][j]) * acc[ai][1][m][1][j], -448.f, 448.f); }
                *(u32x2*)(ACT + (size_t)(row0 + ai * 128 + m * 16) * DFF + col0) = pack8_fp8(o0, o1); }
    }
};
struct EpiLat {
    static constexpr bool PERM = true;
    bf16_t* CKV; bf16_t* QLAT; bf16_t* KR; float* SSC; float* SSQ; const float* COS; const float* SIN;
    __device__ __forceinline__ void operator()(const Acc& acc, const Unit& u, int wr, int wc, int fr, int fq) const {
        const int row0 = u.pm * 256 + wr * 64 + fr;
        if (u.e == 0 && u.pn == 2) {
            if (wc < 2) { const int j = 16 * wc + 4 * fq;
#pragma unroll
                for (int ai = 0; ai < 2; ++ai)
#pragma unroll
                    for (int m = 0; m < 4; ++m) { const int r = row0 + ai * 128 + m * 16; const f32x4 c = *(const f32x4*)(COS + (size_t)r * 32 + j), s = *(const f32x4*)(SIN + (size_t)r * 32 + j);
                        const f32x4 x1 = acc[ai][0][m][0], x2 = acc[ai][0][m][1]; const f32x4 o1 = x1 * c - x2 * s, o2 = x2 * c + x1 * s;
                        *(u32x2*)(KR + (size_t)r * 64 + j) = (u32x2){cvt_pk_bf16(o1[0], o1[1]), cvt_pk_bf16(o1[2], o1[3])};
                        *(u32x2*)(KR + (size_t)r * 64 + 32 + j) = (u32x2){cvt_pk_bf16(o2[0], o2[1]), cvt_pk_bf16(o2[2], o2[3])}; } }
            return;
        }
        bf16_t* O = u.e == 0 ? CKV : QLAT; float* SS = u.e == 0 ? SSC : SSQ;
        const int col0 = u.pn * 256 + wc * 32 + 8 * fq;
#pragma unroll
        for (int ai = 0; ai < 2; ++ai)
#pragma unroll
            for (int m = 0; m < 4; ++m) { const int r = row0 + ai * 128 + m * 16; float s = 0.f;
#pragma unroll
                for (int bj = 0; bj < 2; ++bj) { const f32x4 a = acc[ai][bj][m][0], b = acc[ai][bj][m][1];
                    s += (a[0] * a[0] + a[1] * a[1]) + (a[2] * a[2] + a[3] * a[3]) + (b[0] * b[0] + b[1] * b[1]) + (b[2] * b[2] + b[3] * b[3]);
                    *(u32x4*)(O + (size_t)r * 512 + col0 + bj * 128) = pack8(a, b); }
                s += __shfl_xor(s, 16); s += __shfl_xor(s, 32);
                if (fq == 0) SS[(size_t)r * 8 + u.pn * 4 + wc] = s; }
    }
};
struct EpiKvQ {
    static constexpr bool PERM = true;
    bf16_t* KN; bf16_t* V; bf16_t* QN; bf16_t* QR; const float* SSC; const float* SSQ; const float* COS; const float* SIN;
    __device__ __forceinline__ void operator()(const Acc& acc, const Unit& u, int wr, int wc, int fr, int fq) const {
        const int row0 = u.pm * 256 + wr * 64 + fr; const float* SS = u.e == 0 ? SSC : SSQ;
#pragma unroll
        for (int ai = 0; ai < 2; ++ai)
#pragma unroll
            for (int m = 0; m < 4; ++m) { const int r = row0 + ai * 128 + m * 16, b = r >> 13, s = r & (SEQ - 1);
                const f32x4 p0 = *(const f32x4*)(SS + (size_t)r * 8), p1 = *(const f32x4*)(SS + (size_t)r * 8 + 4);
                const float rstd = rsqrtf(((p0[0] + p0[1]) + (p0[2] + p0[3]) + (p1[0] + p1[1]) + (p1[2] + p1[3])) * (1.0f / 512.0f) + EPS);
                if (u.e == 0) { const size_t o = ((size_t)(b * MLA_H + u.pn) * SEQ + s) * 128 + wc * 32 + 8 * fq;
                    *(u32x4*)(KN + o) = pack8(acc[ai][0][m][0] * rstd, acc[ai][0][m][1] * rstd); *(u32x4*)(V + o) = pack8(acc[ai][1][m][0] * rstd, acc[ai][1][m][1] * rstd); }
                else if (u.pn < 8) {
#pragma unroll
                    for (int bj = 0; bj < 2; ++bj) { const size_t o = ((size_t)(b * MLA_H + 2 * u.pn + bj) * SEQ + s) * 128 + wc * 32 + 8 * fq;
                        *(u32x4*)(QN + o) = pack8(acc[ai][bj][m][0] * rstd, acc[ai][bj][m][1] * rstd); } }
                else { const int j = 16 * (wc & 1) + 4 * fq; const f32x4 c = *(const f32x4*)(COS + (size_t)r * 32 + j), sn = *(const f32x4*)(SIN + (size_t)r * 32 + j);
#pragma unroll
                    for (int bj = 0; bj < 2; ++bj) { const int head = 4 * (u.pn - 8) + 2 * bj + (wc >> 1); const size_t o = ((size_t)(b * MLA_H + head) * SEQ + s) * 64 + j;
                        const f32x4 x1 = acc[ai][bj][m][0] * rstd, x2 = acc[ai][bj][m][1] * rstd; const f32x4 o1 = x1 * c - x2 * sn, o2 = x2 * c + x1 * sn;
                        *(u32x2*)(QR + o) = (u32x2){cvt_pk_bf16(o1[0], o1[1]), cvt_pk_bf16(o1[2], o1[3])};
                        *(u32x2*)(QR + o + 32) = (u32x2){cvt_pk_bf16(o2[0], o2[1]), cvt_pk_bf16(o2[2], o2[3])}; } }
            }
    }
};

struct Args { const void* in[25]; float* out; unsigned char* ws; int ph_lo, ph_hi; };
enum { I_X = 0, I_C, I_POS, I_ADAW, I_ADAB, I_NORMG, I_HGWIN, I_HGLB, I_HGONG, I_HGWOUT, I_KVNG, I_KVADAW, I_KVADAB, I_WKVA, I_KVNORMG, I_WKVB, I_WQA, I_QNORMG, I_WQB, I_WO,
       I_FGU, I_FDN, I_ROUTER, I_MGU, I_MDN };
struct Frame { LAS unsigned char* lds; int tid, lane, wave, G, bid; const Args* a; unsigned char* ws; unsigned* ctl; bool probe_rep; };
#define INF(k) ((const float*)F.a->in[k])

__device__ __forceinline__ const float* modp(const Frame& F, int which, int part, int b) { return (const float*)(F.ws + WS_MOD) + (size_t)b * NMOD + (which < 4 ? which * 6144 : 24576) + part * 2048; }
__device__ __forceinline__ const float* normg(const Frame& F, int layer, int sub, int which) { return INF(I_NORMG) + ((layer * 2 + sub) * 2 + which) * 2048; }

__device__ __forceinline__ void p_mod(const Frame& F) {
    LAS float* scv = (LAS float*)F.lds;
    LAS float* red = (LAS float*)(F.lds + 16384);
    for (int it = F.bid; it < 224; it += F.G) {
        __syncthreads();
        for (int i = F.tid; i < 2 * D; i += 512) scv[i] = siluf_(INF(I_C)[i]);
        __syncthreads();
        const float* W; const float* bias; int N, col0, obase;
        if (it < 192) { const int mi = it / 48; W = INF(I_ADAW) + (size_t)mi * D * 6144; bias = INF(I_ADAB) + mi * 6144; N = 6144; col0 = (it % 48) * 128; obase = mi * 6144; }
        else { W = INF(I_KVADAW); bias = INF(I_KVADAB); N = 4096; col0 = (it - 192) * 128; obase = 24576; }
        const int half = F.lane >> 5, cq = F.lane & 31;
        const float* wp = W + (size_t)(256 * F.wave + half) * N + col0 + 4 * cq;
        f32x4 a0 = {0.f, 0.f, 0.f, 0.f}, a1 = a0;
#pragma unroll 16
        for (int i = 0; i < 128; ++i) { const f32x4 v = *(const f32x4*)(wp + (size_t)(2 * i) * N); const int k = 256 * F.wave + 2 * i + half; a0 += v * scv[k]; a1 += v * scv[D + k]; }
        const int slot = F.wave * 2 + half;
        *(LAS f32x4*)(red + (slot * 2 + 0) * 128 + 4 * cq) = a0; *(LAS f32x4*)(red + (slot * 2 + 1) * 128 + 4 * cq) = a1;
        __syncthreads();
        if (F.tid < 256) { const int b = F.tid >> 7, col = F.tid & 127; float s = bias[col0 + col];
#pragma unroll
            for (int p = 0; p < 16; ++p) s += red[(p * 2 + b) * 128 + col];
            ((float*)(F.ws + WS_MOD))[(size_t)b * NMOD + obase + col0 + col] = s; }
    }
    const int gtid = F.bid * 512 + F.tid, gn = F.G * 512;
    for (int i = gtid; i < D; i += gn) { const float l0 = INF(I_HGLB)[i], l1 = INF(I_HGLB)[D + i]; ((float*)(F.ws + WS_LB))[i] = 1.0f / (1.0f + expf(l1 - l0)); }
    for (int p = gtid; p < M * 32; p += gn) { const int m = p >> 5, j = p & 31; const float pos = (float)((const int*)F.a->in[I_POS])[m];
        const float inv = 1.0f / powf(10000.0f, (float)(2 * j) / 64.0f); const float ang = pos * inv; float s_, c_; sincosf(ang, &s_, &c_);
        ((float*)(F.ws + WS_COS))[p] = c_; ((float*)(F.ws + WS_SIN))[p] = s_; }
}

__device__ __forceinline__ int rope_dest(int p) { return 32 * ((p >> 4) & 1) + 8 * ((p >> 2) & 3) + 4 * (p >> 5) + (p & 3); }
__device__ __forceinline__ int dest_row(int kind, int c) {
    if (kind == 0) return c;
    if (kind == 1) { const int b = c >= DFF ? 1 : 0, j = c - b * DFF; return (j >> 7) * 256 + b * 128 + (j & 127); }
    if (kind == 2) return c < 512 ? c : 512 + rope_dest(c - 512);
    const int h = c / 192, j = c - h * 192; return j < 128 ? h * 128 + j : 2048 + h * 64 + rope_dest(j - 128);
}
__device__ __forceinline__ void conv_item(const float* W, int K, int N, bf16_t* WT, int kind, const float* gsc, LAS float* scr, int item, int lane) {
    const int nblk = N / 32, kb = item / nblk, nb = item % nblk, k0 = 64 * kb, n0 = 32 * nb;
#pragma unroll 8
    for (int i = 0; i < 32; ++i) { const int kk = 2 * i + (lane >> 5); float v = W[(size_t)(k0 + kk) * N + n0 + (lane & 31)]; if (gsc) v *= gsc[k0 + kk]; scr[kk * 33 + (lane & 31)] = v; }
    asm volatile("s_waitcnt lgkmcnt(0)" ::: "memory");
    const int c = lane & 7;
#pragma unroll
    for (int j = 0; j < 4; ++j) { const int n = (lane >> 3) + 8 * j; const LAS float* s = scr + (8 * c) * 33 + n;
        u32x4 o; o.x = cvt_pk_bf16(s[0 * 33], s[1 * 33]); o.y = cvt_pk_bf16(s[2 * 33], s[3 * 33]); o.z = cvt_pk_bf16(s[4 * 33], s[5 * 33]); o.w = cvt_pk_bf16(s[6 * 33], s[7 * 33]);
        *(u32x4*)(WT + (size_t)dest_row(kind, n0 + n) * K + k0 + 8 * c) = o; }
    asm volatile("s_waitcnt lgkmcnt(0)" ::: "memory");
}
__device__ __forceinline__ void conv_item8(const float* W, int K, int N, unsigned char* WT, int kind, LAS float* scr, int item, int lane) {
    const int nblk = N / 32, kb = item / nblk, nb = item % nblk, k0 = 64 * kb, n0 = 32 * nb;
#pragma unroll 8
    for (int i = 0; i < 32; ++i) { const int kk = 2 * i + (lane >> 5); scr[kk * 33 + (lane & 31)] = W[(size_t)(k0 + kk) * N + n0 + (lane & 31)] * pg8::W8_SCALE; }
    asm volatile("s_waitcnt lgkmcnt(0)" ::: "memory");
    const int c = lane & 7;
#pragma unroll
    for (int j = 0; j < 4; ++j) { const int n = (lane >> 3) + 8 * j; const LAS float* s = scr + (8 * c) * 33 + n;
        const f32x4 a = {s[0 * 33], s[1 * 33], s[2 * 33], s[3 * 33]}, b = {s[4 * 33], s[5 * 33], s[6 * 33], s[7 * 33]};
        *(u32x2*)(WT + (size_t)dest_row(kind, n0 + n) * K + k0 + 8 * c) = pack8_fp8(a, b); }
    asm volatile("s_waitcnt lgkmcnt(0)" ::: "memory");
}
constexpr int MOE_I_GU = (D / 64) * (2 * DFF / 128), MOE_I_DN = (DFF / 64) * (D / 128), MOE_I_E = MOE_I_GU + MOE_I_DN, MOE_ITEMS = NEXP * MOE_I_E;
__device__ __forceinline__ void conv_moe_item(const Frame& F, int g) {
    const int lane = F.lane, nq = lane & 31, half = lane >> 5; const int e = g / MOE_I_E; int r = g - e * MOE_I_E;
    const float* W; unsigned char* dst; int K, N, kind;
    if (r < MOE_I_GU) { W = INF(I_MGU) + (size_t)e * D * 2 * DFF; K = D; N = 2 * DFF; dst = F.ws + W_MGU + (size_t)e * 2 * DFF * D; kind = 1; }
    else { r -= MOE_I_GU; W = INF(I_MDN) + (size_t)e * DFF * D; K = DFF; N = D; dst = F.ws + W_MDN + (size_t)e * D * DFF; kind = 0; }
    const int nkb = K / 64, nb = r / nkb, kb = r - nb * nkb, k0 = 64 * kb, n0 = 128 * nb;
    const float* wp = W + (size_t)(k0 + 32 * half) * N + n0 + 4 * nq; f32x4 v[32];
#pragma unroll
    for (int i = 0; i < 32; ++i) v[i] = *(const f32x4*)(wp + (size_t)i * N);
    LAS unsigned char* t = F.lds + F.wave * 16384;
#pragma unroll
    for (int j = 0; j < 4; ++j)
#pragma unroll
        for (int c = 0; c < 4; ++c) { const f32x4 a = (f32x4){v[8 * c][j], v[8 * c + 1][j], v[8 * c + 2][j], v[8 * c + 3][j]} * pg8::W8_SCALE, b = (f32x4){v[8 * c + 4][j], v[8 * c + 5][j], v[8 * c + 6][j], v[8 * c + 7][j]} * pg8::W8_SCALE;
            *(LAS u32x2*)(t + (4 * nq + j) * 72 + 32 * half + 8 * c) = pack8_fp8(a, b); }
    asm volatile("s_waitcnt lgkmcnt(0)" ::: "memory");
    const int c8 = lane & 7;
#pragma unroll
    for (int jj = 0; jj < 16; ++jj) { const int n = (lane >> 3) + 8 * jj;
        *(u32x2*)(dst + (size_t)dest_row(kind, n0 + n) * K + k0 + 8 * c8) = *(const LAS u32x2*)(t + n * 72 + 8 * c8); }
    asm volatile("s_waitcnt lgkmcnt(0)" ::: "memory");
}
__device__ __forceinline__ void conv_moe_part(const Frame& F, int part, int nparts) {
    const int gw = F.bid * 8 + F.wave, NGW = F.G * 8, per = (MOE_ITEMS + NGW - 1) / NGW, chunk = (per + nparts - 1) / nparts;
    const int k0 = part * chunk, k1 = (k0 + chunk < per) ? k0 + chunk : per;
    for (int k = k0; k < k1; ++k) { const int g = gw + k * NGW; if (g < MOE_ITEMS) conv_moe_item(F, g); }
}
__device__ __forceinline__ void p_conv(const Frame& F) {
    LAS float* scr = (LAS float*)(F.lds + F.wave * 16384);
    const long gw = (long)F.bid * 8 + F.wave, NGW = (long)F.G * 8;
    struct Mt { const float* W; int K, N; size_t dst; int kind; const float* g; };
    auto run = [&](const float* W, int K, int N, size_t dst, int kind, const float* g) { const long n = (long)(K / 64) * (N / 32);
        for (long it = gw; it < n; it += NGW) conv_item(W, K, N, (bf16_t*)(F.ws + dst), kind, g, scr, (int)it, F.lane); };
    run(INF(I_HGWIN), D, 8192, W_IN, 0, nullptr);
    run(INF(I_HGWOUT), D, D, W_OUT, 0, nullptr);
    run(INF(I_FGU), D, 2 * DFF, W_GU, 1, nullptr);
    run(INF(I_FDN), DFF, D, W_DN, 0, nullptr);
    run(INF(I_WKVA), D, 576, W_LAT, 2, nullptr);
    run(INF(I_WQA), D, 512, W_LAT + (size_t)768 * D * 2, 0, nullptr);
    run(INF(I_WKVB), 512, 4096, W_KVQ, 0, INF(I_KVNORMG));
    run(INF(I_WQB), 512, 3072, W_KVQ + (size_t)4096 * 512 * 2, 3, INF(I_QNORMG));
    run(INF(I_WO), D, D, W_O, 0, nullptr);
}

struct Row { f32x4 v[8]; };
struct RowIn { u32x2 y[8], ya[8], xb[8]; f32x4 xf[8]; float s0, s1; int4 tk; };
__device__ __forceinline__ void row_ld(Row& r, const float* p, int lane) {
#pragma unroll
    for (int j = 0; j < 8; ++j) r.v[j] = *(const f32x4*)(p + 4 * lane + 256 * j);
}
__device__ __forceinline__ void row_ld_bf(Row& r, const bf16_t* p, int lane) {
#pragma unroll
    for (int j = 0; j < 8; ++j) { const u32x2 w = *(const u32x2*)(p + 4 * lane + 256 * j); r.v[j] = (f32x4){bflo(w[0]), bfhi(w[0]), bflo(w[1]), bfhi(w[1])}; }
}
__device__ __forceinline__ float row_ss(const Row& r) { float s = 0.f;
#pragma unroll
    for (int j = 0; j < 8; ++j) s += (r.v[j][0] * r.v[j][0] + r.v[j][1] * r.v[j][1]) + (r.v[j][2] * r.v[j][2] + r.v[j][3] * r.v[j][3]);
    return wave_sum(s); }
template <bool F8 = false>
__device__ __forceinline__ void row_mod_store(const Row& h, float rstd, const LAS float* gs, const LAS float* sh, bf16_t* o, int lane, Row* keep) {
#pragma unroll
    for (int j = 0; j < 8; ++j) { const int c = 4 * lane + 256 * j; const f32x4 gv = *(const LAS f32x4*)(gs + c), hv = *(const LAS f32x4*)(sh + c);
        const f32x4 u = h.v[j] * rstd * gv + hv; if (keep) keep->v[j] = u;
        if (F8) { int w = 0; w = __builtin_amdgcn_cvt_pk_fp8_f32(u[0], u[1], w, false); w = __builtin_amdgcn_cvt_pk_fp8_f32(u[2], u[3], w, true); *(int*)((unsigned char*)o + c) = w; }
        else *(u32x2*)(o + c) = (u32x2){cvt_pk_bf16(u[0], u[1]), cvt_pk_bf16(u[2], u[3])}; }
}
template <int MODE> __device__ __forceinline__ void p_thin(const Frame& F) {
    const int lane = F.lane; float* out = F.a->out;
    LAS float* T_GG = (LAS float*)F.lds; LAS float* T_GS = T_GG + 4096; LAS float* T_SH = T_GS + 4096; LAS float* T_KGS = T_SH + 4096; LAS float* T_KSH = T_KGS + 4096;
    LAS float* wr = T_SH + 4096;
    LAS int* sel = (LAS int*)(F.lds + 122880);
    __syncthreads();
    for (int i = F.tid; i < 2 * D; i += 512) { const int b = i >> 11, c = i & (D - 1);
        if (MODE >= 1) { const int mw = MODE - 1; T_GG[i] = modp(F, mw, 2, b)[c] * normg(F, mw >> 1, mw & 1, 1)[c]; }
        if (MODE <= 3) { T_GS[i] = normg(F, MODE >> 1, MODE & 1, 0)[c] * (1.0f + modp(F, MODE, 1, b)[c]); T_SH[i] = modp(F, MODE, 0, b)[c]; }
        if (MODE == 2) { T_KGS[i] = INF(I_KVNG)[c] * (1.0f + modp(F, 4, 1, b)[c]); T_KSH[i] = modp(F, 4, 0, b)[c]; } }
    if (MODE == 3) { const float* w = INF(I_ROUTER);
        for (int q = F.tid; q < D * 2; q += 512) { const int i = q >> 1, h = q & 1; ((LAS f32x4*)wr)[(((i >> 8) * 4 + (i & 3)) * 2 + h) * 64 + ((i & 255) >> 2)] = *(const f32x4*)(w + i * 8 + 4 * h); } }
    __syncthreads();
    int tst[NEXP];
    if (MODE == 4) { int t = 0;
#pragma unroll
        for (int e = 0; e < NEXP; ++e) { tst[e] = t * 256; t += ((int)F.ctl[CW_CNT + 64 * e] + 255) >> 8; } }
    const int stride = F.G * 8; const int4* TOKv = (const int4*)(F.ws + WS_TOK);
    auto load_in = [&](int m, RowIn& r, const int4& tk) {
        if (MODE <= 1) { const float* p = INF(I_X) + (size_t)m * D;
#pragma unroll
            for (int j = 0; j < 8; ++j) r.xf[j] = *(const f32x4*)(p + 4 * lane + 256 * j); }
        if (MODE == 1) { const float* ss = (const float*)(F.ws + WS_SSO) + (size_t)m * 128; r.s0 = ss[lane]; r.s1 = ss[64 + lane]; }
        if (MODE >= 1 && MODE <= 3) { const bf16_t* p = (const bf16_t*)(F.ws + WS_Y) + (size_t)m * D;
#pragma unroll
            for (int j = 0; j < 8; ++j) r.y[j] = *(const u32x2*)(p + 4 * lane + 256 * j); }
        if (MODE >= 2) { const bf16_t* p = (const bf16_t*)(F.ws + WS_XR) + (size_t)m * D;
#pragma unroll
            for (int j = 0; j < 8; ++j) r.xb[j] = *(const u32x2*)(p + 4 * lane + 256 * j); }
        if (MODE == 4) { r.tk = tk; int o0 = 0, o1 = 0;
#pragma unroll
            for (int e = 0; e < NEXP; ++e) { o0 = ((tk.x & 15) == e) ? tst[e] : o0; o1 = ((tk.y & 15) == e) ? tst[e] : o1; }
            const bf16_t* y0 = (const bf16_t*)(F.ws + B_Y2) + (size_t)(o0 + (tk.x >> 4)) * D; const bf16_t* y1 = (const bf16_t*)(F.ws + B_Y2) + (size_t)(o1 + (tk.y >> 4)) * D;
#pragma unroll
            for (int j = 0; j < 8; ++j) { r.ya[j] = *(const u32x2*)(y0 + 4 * lane + 256 * j); r.y[j] = *(const u32x2*)(y1 + 4 * lane + 256 * j); } }
    };
    RowIn cur, nxt; int4 tkn = make_int4(0, 0, 0, 0);
    { const int m0 = F.bid * 8 + F.wave; int4 tk0 = make_int4(0, 0, 0, 0);
      if (MODE == 4) { if (m0 < M) tk0 = TOKv[m0]; if (m0 + stride < M) tkn = TOKv[m0 + stride]; }
      if (m0 < M) load_in(m0, cur, tk0); }
    for (int m = F.bid * 8 + F.wave; m < M; m += stride) {
        const int b = m >> 13, tb = b * D; Row h;
        { const int mn = m + stride; int4 tkn2 = make_int4(0, 0, 0, 0);
          if (mn < M) { load_in(mn, nxt, tkn); if (MODE == 4 && mn + stride < M) tkn2 = TOKv[mn + stride]; }
          tkn = tkn2; }
#define UNPK(w) ((f32x4){bflo((w)[0]), bfhi((w)[0]), bflo((w)[1]), bfhi((w)[1])})
        if (MODE == 0) {
#pragma unroll
            for (int j = 0; j < 8; ++j) h.v[j] = cur.xf[j]; }
        else {
            Row y; float escale = EPS;
            if (MODE == 4) { const float w0 = __int_as_float(cur.tk.z), w1 = __int_as_float(cur.tk.w);
#pragma unroll
                for (int j = 0; j < 8; ++j) y.v[j] = UNPK(cur.ya[j]) * w0 + UNPK(cur.y[j]) * w1;
            } else {
#pragma unroll
                for (int j = 0; j < 8; ++j) y.v[j] = UNPK(cur.y[j]); }
            if (MODE == 1) { const float so = wave_sum(cur.s0 + cur.s1) * (1.0f / D); escale = EPS * (so + EPS); }
            bf16_t* xr = (bf16_t*)(F.ws + WS_XR) + (size_t)m * D;
#pragma unroll
            for (int j = 0; j < 8; ++j) h.v[j] = (MODE == 1) ? cur.xf[j] : UNPK(cur.xb[j]);
            const float rstd = rsqrtf(row_ss(y) * (1.0f / D) + escale);
#pragma unroll
            for (int j = 0; j < 8; ++j) { const int c = 4 * lane + 256 * j; const f32x4 gg = *(const LAS f32x4*)(T_GG + tb + c);
                h.v[j] = h.v[j] + gg * (y.v[j] * rstd);
                if (MODE == 4) *(f32x4*)(out + (size_t)m * D + c) = h.v[j];
                else *(u32x2*)(xr + c) = (u32x2){cvt_pk_bf16(h.v[j][0], h.v[j][1]), cvt_pk_bf16(h.v[j][2], h.v[j][3])}; }
        }
#undef UNPK
        cur = nxt;
        if (MODE == 4) continue;
        const float rstd = rsqrtf(row_ss(h) * (1.0f / D) + EPS);
        if (MODE == 2) row_mod_store(h, rstd, T_KGS + tb, T_KSH + tb, (bf16_t*)(F.ws + WS_XS) + (size_t)m * D, lane, nullptr);
        Row u;
        if (MODE == 3) row_mod_store<true>(h, rstd, T_GS + tb, T_SH + tb, (bf16_t*)(F.ws + WS_U + (size_t)m * D), lane, &u);
        else row_mod_store(h, rstd, T_GS + tb, T_SH + tb, (bf16_t*)(F.ws + WS_U) + (size_t)m * D, lane, nullptr);
        if (MODE == 3) {
            float lg[NEXP];
#pragma unroll
            for (int e = 0; e < NEXP; ++e) lg[e] = 0.f;
#pragma unroll
            for (int j = 0; j < 8; ++j) { asm volatile("" ::: "memory");
#pragma unroll
                for (int c = 0; c < 4; ++c) { const f32x4 w0 = ((const LAS f32x4*)wr)[((j * 4 + c) * 2 + 0) * 64 + lane], w1 = ((const LAS f32x4*)wr)[((j * 4 + c) * 2 + 1) * 64 + lane]; const float x = u.v[j][c];
                    lg[0] += x * w0[0]; lg[1] += x * w0[1]; lg[2] += x * w0[2]; lg[3] += x * w0[3]; lg[4] += x * w1[0]; lg[5] += x * w1[1]; lg[6] += x * w1[2]; lg[7] += x * w1[3]; } }
#pragma unroll
            for (int e = 0; e < NEXP; ++e) lg[e] = wave_sum(lg[e]);
            int e0 = 0; float v0 = lg[0];
#pragma unroll
            for (int e = 1; e < NEXP; ++e) if (lg[e] > v0) { v0 = lg[e]; e0 = e; }
            int e1 = e0 == 0 ? 1 : 0; float v1 = lg[e1];
#pragma unroll
            for (int e = 0; e < NEXP; ++e) if (e != e0 && lg[e] > v1) { v1 = lg[e]; e1 = e; }
            if (lane == 0) { const float p1 = __expf(v1 - v0), w0 = 1.0f / (1.0f + p1), w1 = p1 * w0;
                const int idx = ((m - F.bid * 8) / (F.G * 8)) * 8 + F.wave;
                sel[2 * idx] = e0; sel[2 * idx + 1] = e1;
                ((int2*)(F.ws + WS_TOK))[2 * (size_t)m + 1] = make_int2(__float_as_int(w0), __float_as_int(w1)); }
        }
    }
    if (MODE == 3) {
        __syncthreads();
        if (F.tid < NEXP) { const int e = F.tid, nIdx = ((M - F.bid * 8 + F.G * 8 - 1) / (F.G * 8)) * 8; int c = 0;
            for (int idx = 0; idx < nIdx; ++idx) { const int m = F.bid * 8 + (idx & 7) + (idx >> 3) * F.G * 8; if (m < M) c += (sel[2 * idx] == e ? 1 : 0) + (sel[2 * idx + 1] == e ? 1 : 0); }
            int r = c ? (int)atomicAdd(F.ctl + CW_CNT + 64 * e, (unsigned)c) : 0;
            int* list = (int*)(F.ws + WS_LIST) + (size_t)e * M; int* tok = (int*)(F.ws + WS_TOK);
            for (int idx = 0; idx < nIdx; ++idx) { const int m = F.bid * 8 + (idx & 7) + (idx >> 3) * F.G * 8; if (m >= M) continue;
                if (sel[2 * idx] == e) { list[r] = m; tok[4 * (size_t)m] = e | (r << 4); ++r; }
                if (sel[2 * idx + 1] == e) { list[r] = m; tok[4 * (size_t)m + 1] = e | (r << 4); ++r; } } }
    }
}

#define MFMA16(X, Y, C) __builtin_amdgcn_mfma_f32_16x16x32_bf16((X), (Y), (C), 0, 0, 0)
__device__ __forceinline__ float expc(float x) { return __expf(fminf(x, 80.0f)); }
__device__ __forceinline__ int hg_tiled(int r, int seg) { return (((r >> 4) * 2 + (seg >> 1)) * 64 + (2 * (seg & 1)) * 16 + (r & 15)) * 8; }
__device__ __forceinline__ void p_hg_chunk(const Frame& F) {
    constexpr int RS = 272, TS = 144;
    LAS unsigned char* QA = F.lds; LAS unsigned char* QB = QA + 64 * RS; LAS unsigned char* KA = QB + 32 * RS; LAS unsigned char* KB = KA + 32 * RS;
    LAS unsigned char* VS = KB + 64 * RS; LAS unsigned char* VT = VS + 64 * RS; LAS unsigned char* PS = VT + 128 * TS; LAS float* TOT = (LAS float*)(PS + 64 * TS);
    const int tid = F.tid, lane = F.lane, w = F.wave, ch = tid & 127, seg = tid >> 7, fr = lane & 15, fq = lane >> 4;
    const _Float16* LFg = (const _Float16*)(F.ws + B_LF); const bf16_t* Qg = (const bf16_t*)(F.ws + B_Q); const bf16_t* VIg = (const bf16_t*)(F.ws + B_VI);
    for (int unit = F.bid; unit < 4096; unit += F.G) {
        const int bh = unit >> 7, c = unit & 127, b = bh >> 4, h = bh & 15, m0 = b * SEQ + 64 * c, k0 = 128 * h;
        float lf[16], qv[16];
#pragma unroll
        for (int i = 0; i < 16; ++i) { const size_t o = (size_t)(m0 + 16 * seg + i) * D + k0 + ch; lf[i] = (float)LFg[o]; qv[i] = bf2f(Qg[o]); }
#pragma unroll
        for (int p = 0; p < 2; ++p) { const int piece = tid + 512 * p, s = piece >> 4, v8 = (piece & 15) * 8; *(LAS u32x4*)(VS + s * RS + v8 * 2) = *(const u32x4*)(VIg + (size_t)(m0 + s) * D + k0 + v8); }
        float bcs[16]; float run = 0.f;
#pragma unroll
        for (int i = 0; i < 16; ++i) { run += lf[i]; bcs[i] = run; }
        TOT[seg * 128 + ch] = run;
        __syncthreads();
        const float t0 = TOT[ch], t1 = TOT[128 + ch], t2 = TOT[256 + ch], t3 = TOT[384 + ch];
        const float pre = seg == 0 ? 0.f : seg == 1 ? t0 : seg == 2 ? t0 + t1 : t0 + t1 + t2, r1 = t0 + t1, bl = r1 + t2 + t3;
        unsigned kh[8];
#pragma unroll
        for (int i = 0; i < 16; i += 2) { float kv[2];
#pragma unroll
            for (int z = 0; z < 2; ++z) { const int t = 16 * seg + i + z; const float bb = bcs[i + z] + pre, kk = 1.0f - __expf(lf[i + z]), q = qv[i + z];
                *(LAS bf16_t*)(QA + t * RS + ch * 2) = f2bf(q * expc(bb));
                if (seg >= 2) *(LAS bf16_t*)(QB + (t - 32) * RS + ch * 2) = f2bf(q * expc(bb - r1));
                if (seg < 2) *(LAS bf16_t*)(KA + t * RS + ch * 2) = f2bf(kk * expc(-bb));
                *(LAS bf16_t*)(KB + t * RS + ch * 2) = f2bf(kk * expc(r1 - bb));
                kv[z] = kk * expc(bl - bb); }
            kh[i >> 1] = cvt_pk_bf16(kv[0], kv[1]); }
        { bf16_t* kt = (bf16_t*)(F.ws + B_KT) + (size_t)unit * 8192 + hg_tiled(ch, seg); *(u32x4*)kt = (u32x4){kh[0], kh[1], kh[2], kh[3]}; *(u32x4*)(kt + 128) = (u32x4){kh[4], kh[5], kh[6], kh[7]}; }
        if (seg == 3) ((float*)(F.ws + B_DEC))[(size_t)unit * 128 + ch] = expc(bl);
        { unsigned vv[8];
#pragma unroll
            for (int i = 0; i < 16; i += 2) { const unsigned lo = *(const LAS bf16_t*)(VS + (16 * seg + i) * RS + ch * 2), hi = *(const LAS bf16_t*)(VS + (16 * seg + i + 1) * RS + ch * 2); vv[i >> 1] = lo | (hi << 16); }
            const u32x4 a = {vv[0], vv[1], vv[2], vv[3]}, bq = {vv[4], vv[5], vv[6], vv[7]};
            *(LAS u32x4*)(VT + ch * TS + 32 * seg) = a; *(LAS u32x4*)(VT + ch * TS + 32 * seg + 16) = bq;
            bf16_t* vt = (bf16_t*)(F.ws + B_VT) + (size_t)unit * 8192 + hg_tiled(ch, seg); *(u32x4*)vt = a; *(u32x4*)(vt + 128) = bq; }
        __syncthreads();
#pragma unroll
        for (int p = 0; p < 2; ++p) { const int piece = tid + 512 * p, ww = piece >> 7, pp = (piece >> 6) & 1, ln = piece & 63, r_ = ln & 15, q_ = ln >> 4;
            const u32x2 lo = *(const LAS u32x2*)(QA + (32 * pp + r_) * RS + (16 * ww + 4 * q_) * 2), hi = *(const LAS u32x2*)(QA + (32 * pp + 16 + r_) * RS + (16 * ww + 4 * q_) * 2);
            *(u32x4*)((bf16_t*)(F.ws + B_QH) + (size_t)unit * 8192 + piece * 8) = (u32x4){lo[0], lo[1], hi[0], hi[1]}; }
        { const int tt = w >> 2, st = w & 3; f32x4 acc = {0.f, 0.f, 0.f, 0.f};
#pragma unroll
            for (int kb = 0; kb < 4; ++kb) acc = MFMA16(*(const LAS bf16x8*)(KB + (16 * st + fr) * RS + (32 * kb + 8 * fq) * 2), *(const LAS bf16x8*)(QB + (16 * tt + fr) * RS + (32 * kb + 8 * fq) * 2), acc);
            const int ta = 32 + 16 * tt + fr, sa = 16 * st + 4 * fq;
#pragma unroll
            for (int j = 0; j < 4; ++j) if (sa + j > ta) acc[j] = 0.f;
            *(LAS u32x2*)(PS + ta * TS + sa * 2) = (u32x2){cvt_pk_bf16(acc[0], acc[1]), cvt_pk_bf16(acc[2], acc[3])}; }
        if (w < 4) { const int tt = w >> 1, st = w & 1; f32x4 acc = {0.f, 0.f, 0.f, 0.f};
#pragma unroll
            for (int kb = 0; kb < 4; ++kb) acc = MFMA16(*(const LAS bf16x8*)(KA + (16 * st + fr) * RS + (32 * kb + 8 * fq) * 2), *(const LAS bf16x8*)(QA + (16 * tt + fr) * RS + (32 * kb + 8 * fq) * 2), acc);
            const int ta = 16 * tt + fr, sa = 16 * st + 4 * fq;
#pragma unroll
            for (int j = 0; j < 4; ++j) if (sa + j > ta) acc[j] = 0.f;
            *(LAS u32x2*)(PS + ta * TS + sa * 2) = (u32x2){cvt_pk_bf16(acc[0], acc[1]), cvt_pk_bf16(acc[2], acc[3])}; }
        __syncthreads();
#pragma unroll
        for (int tt = 0; tt < 4; ++tt) { f32x4 acc = {0.f, 0.f, 0.f, 0.f};
#pragma unroll
            for (int sb = 0; sb < 2; ++sb) if (sb == 0 || tt >= 2) acc = MFMA16(*(const LAS bf16x8*)(VT + (16 * w + fr) * TS + (32 * sb + 8 * fq) * 2), *(const LAS bf16x8*)(PS + (16 * tt + fr) * TS + (32 * sb + 8 * fq) * 2), acc);
            *(u32x2*)((bf16_t*)(F.ws + B_OI) + tm_off(m0 + 16 * tt + fr, k0 + 16 * w + 4 * fq)) = (u32x2){cvt_pk_bf16(acc[0], acc[1]), cvt_pk_bf16(acc[2], acc[3])}; }
        __syncthreads();
    }
}
__device__ __forceinline__ void p_hg_scan(const Frame& F) {
    LAS f32x4* red = (LAS f32x4*)F.lds;
    const int tid = F.tid, lane = F.lane, w = F.wave, fr = lane & 15, fq = lane >> 4;
    const bf16_t* QH = (const bf16_t*)(F.ws + B_QH); const bf16_t* KT = (const bf16_t*)(F.ws + B_KT); const bf16_t* VT = (const bf16_t*)(F.ws + B_VT); const float* DEC = (const float*)(F.ws + B_DEC);
    const bf16_t* OI = (const bf16_t*)(F.ws + B_OI); const bf16_t* GS = (const bf16_t*)(F.ws + B_GS); bf16_t* OG = (bf16_t*)(F.ws + B_OG); float* SSO = (float*)(F.ws + WS_SSO);
    for (int ui = F.bid; ui < 256; ui += F.G) {
        const int unit = (F.G == 256) ? (((ui & 7) * 4 + (ui >> 6)) * 8 + ((ui >> 3) & 7)) : ui;
        const int bh = unit >> 3, vs = unit & 7, b = bh >> 4, h = bh & 15;
        const int tt2 = (tid >> 6) & 3;
        const size_t rowoff = tm_off(b * SEQ + 16 * tt2 + fr, 128 * h + 16 * vs + 4 * fq);
        f32x4 S = {0.f, 0.f, 0.f, 0.f};
        u32x4 qA[2], qB[2]; u32x2 gsA, gsB, oiA, oiB; bf16x8 ktA[2], ktB[2], vtA[2], vtB[2]; f32x4 dA, dB;
#define HG_LOAD(q_, kt_, vt_, d_, oi_, gs_, cc) do { const size_t cu = (size_t)(bh * 128 + (cc)); \
            _Pragma("unroll") for (int pp = 0; pp < 2; ++pp) q_[pp] = *(const u32x4*)(QH + cu * 8192 + ((w * 2 + pp) * 64 + lane) * 8); \
            _Pragma("unroll") for (int sb = 0; sb < 2; ++sb) { kt_[sb] = *(const bf16x8*)(KT + cu * 8192 + ((w * 2 + sb) * 64 + lane) * 8); vt_[sb] = *(const bf16x8*)(VT + cu * 8192 + ((vs * 2 + sb) * 64 + lane) * 8); } \
            d_ = *(const f32x4*)(DEC + cu * 128 + 16 * w + 4 * fq); \
            if (tid < 256) { oi_ = *(const u32x2*)(OI + rowoff + (size_t)(cc) * 131072); gs_ = *(const u32x2*)(GS + rowoff + (size_t)(cc) * 131072); } } while (0)
#define HG_STEP(q_, kt_, vt_, d_, oi_, gs_, cc) do { \
            LAS f32x4* rb = red + ((cc) & 1) * 2048; \
            { const u32x4 sw = {cvt_pk_bf16(S[0], S[1]), cvt_pk_bf16(S[2], S[3]), 0u, 0u}; const bf16x8 Sb = *(const bf16x8*)&sw; \
                _Pragma("unroll") for (int tt = 0; tt < 4; ++tt) { const u32x4 xw = {q_[tt >> 1][2 * (tt & 1)], q_[tt >> 1][2 * (tt & 1) + 1], 0u, 0u}; const f32x4 z = {0.f, 0.f, 0.f, 0.f}; \
                    rb[(w * 4 + tt) * 64 + lane] = MFMA16(Sb, *(const bf16x8*)&xw, z); } }            \
            S = S * d_; S = MFMA16(kt_[0], vt_[0], S); S = MFMA16(kt_[1], vt_[1], S); \
            const u32x2 oiw = oi_; const f32x4 oi = {bflo(oiw[0]), bfhi(oiw[0]), bflo(oiw[1]), bfhi(oiw[1])}; const u32x2 gs = gs_; \
            if ((cc) + 2 < NCH) HG_LOAD(q_, kt_, vt_, d_, oi_, gs_, (cc) + 2); \
            __syncthreads(); \
            if (tid < 256) { f32x4 o = rb[tt2 * 64 + lane]; \
                _Pragma("unroll") for (int ww = 1; ww < 8; ++ww) o += rb[(ww * 4 + tt2) * 64 + lane]; \
                o += oi; float s2 = (o[0] * o[0] + o[1] * o[1]) + (o[2] * o[2] + o[3] * o[3]); s2 += __shfl_xor(s2, 16); s2 += __shfl_xor(s2, 32); \
                *(u32x2*)(OG + rowoff + (size_t)(cc) * 131072) = (u32x2){cvt_pk_bf16(o[0] * bflo(gs[0]), o[1] * bfhi(gs[0])), cvt_pk_bf16(o[2] * bflo(gs[1]), o[3] * bfhi(gs[1]))}; \
                if (fq == 0) SSO[(size_t)(b * SEQ + 64 * (cc) + 16 * tt2 + fr) * 128 + h * 8 + vs] = s2; } } while (0)
        HG_LOAD(qA, ktA, vtA, dA, oiA, gsA, 0);
        HG_LOAD(qB, ktB, vtB, dB, oiB, gsB, 1);
        for (int c = 0; c < NCH; c += 2) { HG_STEP(qA, ktA, vtA, dA, oiA, gsA, c); HG_STEP(qB, ktB, vtB, dB, oiB, gsB, c + 1); }
        __syncthreads();
#undef HG_LOAD
#undef HG_STEP
    }
}

namespace att {
constexpr int KROW = 384, SHM_K = 64 * KROW, SHM_V = 16384, OFF_K = 2 * SHM_V, OFF_WS = OFF_K + 2 * SHM_K;
constexpr float THR = 8.f;
__device__ __forceinline__ int v_rd_base(int lane) { return ((lane & 3) << 3) | (((lane >> 2) & 3) << 6) | (((lane >> 4) & 1) << 5) | (((lane >> 5) & 1) << 8); }
__device__ __forceinline__ int crow(int r, int hi) { return (r & 3) + 8 * (r >> 2) + 4 * hi; }
#define SBAR() __builtin_amdgcn_sched_barrier(0)
__device__ __forceinline__ void mask_tile(f32x16& p0, f32x16& p1, int dq) {
    const float NEG = -__builtin_inff();
#pragma unroll
    for (int r = 0; r < 16; ++r) { const int c = (r & 3) + 8 * (r >> 2); if (dq - c < 0) p0[r] = NEG; if (dq - c - 32 < 0) p1[r] = NEG; }
}
__device__ __forceinline__ void partialSM(f32x16& p0, f32x16& p1, float& m_reg, float& mn, float& alpha) {
    float pmax = p0[0];
#pragma unroll
    for (int r = 1; r < 16; ++r) pmax = fmaxf(pmax, p0[r]);
#pragma unroll
    for (int r = 0; r < 16; ++r) pmax = fmaxf(pmax, p1[r]);
    { auto rr = __builtin_amdgcn_permlane32_swap(__float_as_uint(pmax), __float_as_uint(pmax), false, false); pmax = fmaxf(__uint_as_float(rr[0]), __uint_as_float(rr[1])); }
    constexpr float C2 = 1.4426950408889634f * MLA_SCALE;
    if (__builtin_expect(__all((pmax - m_reg) * MLA_SCALE <= THR), 1)) { mn = m_reg; alpha = 1.f; }
    else { mn = fmaxf(m_reg, pmax); alpha = __builtin_amdgcn_exp2f((m_reg - mn) * C2); m_reg = mn; }
    const float mnL = -mn * C2;
#pragma unroll
    for (int r = 0; r < 16; ++r) p0[r] = __builtin_amdgcn_exp2f(fmaf(p0[r], C2, mnL));
#pragma unroll
    for (int r = 0; r < 16; ++r) p1[r] = __builtin_amdgcn_exp2f(fmaf(p1[r], C2, mnL));
}
__device__ __forceinline__ void finishSM(f32x16& p0, f32x16& p1, float alpha, float& l_reg, bf16x8& pa0, bf16x8& pa1, bf16x8& pa2, bf16x8& pa3) {
    float ps = 0;
#pragma unroll
    for (int r = 0; r < 16; ++r) ps += p0[r];
#pragma unroll
    for (int r = 0; r < 16; ++r) ps += p1[r];
    { auto rr = __builtin_amdgcn_permlane32_swap(__float_as_uint(ps), __float_as_uint(ps), false, false); ps = __uint_as_float(rr[0]) + __uint_as_float(rr[1]); }
    l_reg = l_reg * alpha + ps;
#define PK4(P, B_, OUT) do { unsigned a0 = cvt_pk_bf16(P[B_+0], P[B_+1]), a1 = cvt_pk_bf16(P[B_+2], P[B_+3]); unsigned b0 = cvt_pk_bf16(P[B_+4], P[B_+5]), b1 = cvt_pk_bf16(P[B_+6], P[B_+7]); \
        auto r0 = __builtin_amdgcn_permlane32_swap(a0, b0, false, false); auto r1 = __builtin_amdgcn_permlane32_swap(a1, b1, false, false); \
        u32x4 w_ = {r0[0], r1[0], r0[1], r1[1]}; OUT = *reinterpret_cast<bf16x8*>(&w_); } while (0)
    PK4(p0, 0, pa0); PK4(p0, 8, pa1); PK4(p1, 0, pa2); PK4(p1, 8, pa3);
#undef PK4
}
#define KRD2(dst0, dst1, j, imm) do { asm volatile("ds_read_b128 %0, %1 offset:%2" : "=&v"(dst0) : "v"(kb[j]), "i"(imm) : "memory"); \
                                      asm volatile("ds_read_b128 %0, %1 offset:%2" : "=&v"(dst1) : "v"(kb[j]), "i"((imm) + 32 * KROW) : "memory"); } while (0)
#define LGK(n) asm volatile("s_waitcnt lgkmcnt(%0)" :: "i"(n) : "memory")
template <int KB> __device__ __forceinline__ void qkt(f32x16& p0, f32x16& p1, const int (&kb)[4], const bf16x8* qr) {
    p0 = f32x16{}; p1 = f32x16{};
    bf16x8 ka[4], kc[4];
#define KIMM(d0) (KB * SHM_K + ((d0) >> 2) * 128)
    KRD2(ka[0], kc[0], 0, KIMM(0)); KRD2(ka[1], kc[1], 1, KIMM(1)); KRD2(ka[2], kc[2], 2, KIMM(2));
#define QK_STEP(d0) do { if ((d0) + 3 < 12) KRD2(ka[((d0) + 3) & 3], kc[((d0) + 3) & 3], ((d0) + 3) & 3, KIMM((d0) + 3)); \
        LGK(((d0) + 3 < 12) ? 6 : 2 * (11 - (d0))); SBAR(); \
        p0 = __builtin_amdgcn_mfma_f32_32x32x16_bf16(ka[(d0) & 3], qr[d0], p0, 0, 0, 0); p1 = __builtin_amdgcn_mfma_f32_32x32x16_bf16(kc[(d0) & 3], qr[d0], p1, 0, 0, 0); } while (0)
    QK_STEP(0); QK_STEP(1); QK_STEP(2); QK_STEP(3); QK_STEP(4); QK_STEP(5); QK_STEP(6); QK_STEP(7); QK_STEP(8); QK_STEP(9); QK_STEP(10); QK_STEP(11);
#undef QK_STEP
#undef KIMM
}
#define TRRD(dst, off) asm volatile("ds_read_b64_tr_b16 %0, %1 offset:%2" : "=&v"(dst) : "v"(vb0), "i"(off) : "memory")
#define VRD8(L, H, d0, VB_) do { constexpr int b_ = (VB_) * SHM_V + (d0) * 512; TRRD(L[0], b_); TRRD(H[0], b_ + 2048); TRRD(L[1], b_ + 4096); TRRD(H[1], b_ + 6144); TRRD(L[2], b_ + 8192); TRRD(H[2], b_ + 10240); TRRD(L[3], b_ + 12288); TRRD(H[3], b_ + 14336); } while (0)
#define PVMM(L, H, d0) do { \
        o[d0] = __builtin_amdgcn_mfma_f32_32x32x16_bf16(pa0, (bf16x8){L[0][0], L[0][1], L[0][2], L[0][3], H[0][0], H[0][1], H[0][2], H[0][3]}, o[d0], 0, 0, 0); \
        o[d0] = __builtin_amdgcn_mfma_f32_32x32x16_bf16(pa1, (bf16x8){L[1][0], L[1][1], L[1][2], L[1][3], H[1][0], H[1][1], H[1][2], H[1][3]}, o[d0], 0, 0, 0); \
        o[d0] = __builtin_amdgcn_mfma_f32_32x32x16_bf16(pa2, (bf16x8){L[2][0], L[2][1], L[2][2], L[2][3], H[2][0], H[2][1], H[2][2], H[2][3]}, o[d0], 0, 0, 0); \
        o[d0] = __builtin_amdgcn_mfma_f32_32x32x16_bf16(pa3, (bf16x8){L[3][0], L[3][1], L[3][2], L[3][3], H[3][0], H[3][1], H[3][2], H[3][3]}, o[d0], 0, 0, 0); } while (0)
__device__ __forceinline__ void block(const Frame& F, int bh, int qb) {
    LAS unsigned char* lds = F.lds;
    int lane = F.lane; asm volatile("" : "+v"(lane));
    const int tid = F.tid, wid = F.wave, r32 = lane & 31, hi = lane >> 5, b = bh >> 4, h = bh & 15;
    const bf16_t* KN = (const bf16_t*)(F.ws + B_KN) + (size_t)bh * SEQ * 128; const bf16_t* VV = (const bf16_t*)(F.ws + B_V) + (size_t)bh * SEQ * 128;
    const bf16_t* KR = (const bf16_t*)(F.ws + B_KR) + (size_t)b * SEQ * 64;
    const bf16_t* QN = (const bf16_t*)(F.ws + B_QN) + (size_t)bh * SEQ * 128; const bf16_t* QR = (const bf16_t*)(F.ws + B_QR) + (size_t)bh * SEQ * 64;
    const int q0 = qb * 256, NT = (q0 + 256) / 64, qlo = q0 + wid * 32, qm = qlo + r32 - 4 * hi;
    bf16x8 qr[12];
    { const size_t row = (size_t)(qlo + r32);
#pragma unroll
      for (int d0 = 0; d0 < 8; ++d0) qr[d0] = *(const bf16x8*)(QN + row * 128 + d0 * 16 + hi * 8);
#pragma unroll
      for (int d0 = 0; d0 < 4; ++d0) qr[8 + d0] = *(const bf16x8*)(QR + row * 64 + d0 * 16 + hi * 8); }
    unsigned koff[3], kstr[3], voff[2];
    const unsigned oKN = (unsigned)(B_KN + (size_t)bh * SEQ * 128 * 2), oKR = (unsigned)(B_KR + (size_t)b * SEQ * 64 * 2), oV = (unsigned)(B_V + (size_t)bh * SEQ * 128 * 2);
#pragma unroll
    for (int i = 0; i < 3; ++i) { const int p = (wid * 3 + i) * 64 + lane, r = p / 24, cs = p - r * 24, c = cs ^ ((r >> 1) & 7);
        if (c < 16) { koff[i] = oKN + (unsigned)(r * 128 + 8 * c) * 2u; kstr[i] = 64 * 128 * 2; } else { koff[i] = oKR + (unsigned)(r * 64 + 8 * (c - 16)) * 2u; kstr[i] = 64 * 64 * 2; } }
#pragma unroll
    for (int i = 0; i < 2; ++i) { const int s_ = (wid * 2 + i) * 64 + lane, sub = s_ >> 5, w_ = s_ & 31, kk = (sub >> 2) * 8 + (w_ >> 2), c = (sub & 3) * 32 + (w_ & 3) * 8, k = (kk & ~0xC) | ((kk & 4) << 1) | ((kk & 8) >> 1);
        voff[i] = oV + (unsigned)(k * 128 + c) * 2u; }
    const char* wsb = (const char*)F.ws;
#define A_DMA(t, bf) do { \
        _Pragma("unroll") for (int i = 0; i < 3; ++i) __builtin_amdgcn_global_load_lds((const unsigned*)(wsb + (koff[i] + (unsigned)(t) * kstr[i])), (LAS unsigned*)(lds + OFF_K + (bf) * SHM_K + (wid * 3 + i) * 1024), 16, 0, 0); \
        _Pragma("unroll") for (int i = 0; i < 2; ++i) __builtin_amdgcn_global_load_lds((const unsigned*)(wsb + (voff[i] + (unsigned)(t) * (64u * 128u * 2u))), (LAS unsigned*)(lds + (bf) * SHM_V + (wid * 2 + i) * 1024), 16, 0, 0); } while (0)
    int kb[4];
#pragma unroll
    for (int j = 0; j < 4; ++j) kb[j] = (int)(uintptr_t)lds + OFF_K + r32 * KROW + (((2 * j + hi) ^ ((r32 >> 1) & 7)) << 4);
    const int vb0 = (int)(uintptr_t)lds + v_rd_base(lane);
    LAS float* wsl = (LAS float*)(lds + OFF_WS) + wid * 64; LAS float* li_l = wsl; LAS float* al_l = wsl + 32;
    float m_reg = -1e30f, l_reg = 0.f; f32x16 o[4] = {};
    A_DMA(0, 0);
#define A_STEP(t, VB) do { \
        asm volatile("s_waitcnt vmcnt(0)" ::: "memory"); __syncthreads(); \
        if ((t) + 1 < NT) A_DMA((t) + 1, (VB) ^ 1); \
        const int kb_ = (t) * 64; \
        if (kb_ <= qlo + 31) { f32x16 p0, p1; float mn, alpha; bf16x8 pa0, pa1, pa2, pa3; s16x4 la[4], ha[4], lb[4], hb[4]; \
            qkt<VB>(p0, p1, kb, qr); \
            VRD8(la, ha, 0, VB); SBAR(); \
            if (kb_ + 63 > qlo) { asm volatile("; diagonal tile" ::: "memory"); mask_tile(p0, p1, qm - kb_); } \
            partialSM(p0, p1, m_reg, mn, alpha); \
            if (__any(alpha < 1.f)) { if (hi == 0) al_l[r32] = alpha; asm volatile("s_waitcnt lgkmcnt(0)" ::: "memory"); \
                _Pragma("unroll") for (int d_ = 0; d_ < 4; ++d_) _Pragma("unroll") for (int r = 0; r < 16; ++r) o[d_][r] *= al_l[crow(r, hi)]; } \
            finishSM(p0, p1, alpha, l_reg, pa0, pa1, pa2, pa3); SBAR(); \
            VRD8(lb, hb, 1, VB); LGK(8); SBAR(); PVMM(la, ha, 0); SBAR(); \
            VRD8(la, ha, 2, VB); LGK(8); SBAR(); PVMM(lb, hb, 1); SBAR(); \
            VRD8(lb, hb, 3, VB); LGK(8); SBAR(); PVMM(la, ha, 2); SBAR(); \
            LGK(0); SBAR(); PVMM(lb, hb, 3); } } while (0)
    for (int t = 0; t < NT; t += 2) { A_STEP(t, 0); A_STEP(t + 1, 1); }
    if (hi == 0) li_l[r32] = l_reg; asm volatile("s_waitcnt lgkmcnt(0)" ::: "memory");
    bf16_t* Ow = (bf16_t*)(F.ws + B_O) + (size_t)(b * SEQ + qlo) * D + h * 128;
#pragma unroll
    for (int r = 0; r < 16; ++r) { const int orow = crow(r, hi); const float rl = __builtin_amdgcn_rcpf(li_l[orow]);
#pragma unroll
        for (int d0 = 0; d0 < 4; ++d0) { const float v = o[d0][r] * rl; const float vn = __shfl_xor(v, 1);
            if ((r32 & 1) == 0) *(unsigned*)(Ow + (size_t)orow * D + d0 * 32 + r32) = cvt_pk_bf16(v, vn); } }
    __syncthreads();
#undef A_DMA
#undef A_STEP
}
#undef SBAR
#undef KRD2
#undef LGK
#undef TRRD
#undef VRD8
#undef PVMM
}
__device__ __forceinline__ void p_attn(const Frame& F) {
    const int nIt = (F.G == 256) ? 4 : (1024 - F.bid + F.G - 1) / F.G;
    for (int n = 0; n < nIt; ++n) {
        int bh, qb;
        if (F.G == 256) { const int xcd = F.bid & 7, k = F.bid >> 3, x = k & 15; bh = xcd * 4 + (n >> 1) * 2 + (k >> 4); qb = (n & 1) ? 31 - x : x; }
        else { const int L = F.bid + n * F.G; bh = L >> 5; qb = L & 31; }
        att::block(F, bh, qb);
        if (((((F.bid >> 3) + n) & 3) == 0 || nIt != 4) && !F.probe_rep) conv_moe_part(F, nIt == 4 ? 0 : n, nIt == 4 ? 1 : nIt);
        __syncthreads();
    }
}

constexpr int N_PHASES = 18;
__global__ void __launch_bounds__(512, 2) fwd_kernel(Args args) {
    extern __shared__ __attribute__((aligned(16))) unsigned char lds_raw[];
    Frame F; F.lds = (LAS unsigned char*)lds_raw; F.tid = threadIdx.x; F.lane = F.tid & 63; F.wave = __builtin_amdgcn_readfirstlane(F.tid >> 6); F.G = gridDim.x; F.bid = blockIdx.x;
    F.a = &args; F.ws = args.ws; F.ctl = (unsigned*)(args.ws + WS_CTL);
    volatile LAS unsigned* MISC = (volatile LAS unsigned*)(F.lds + MISC_OFF);
    if (F.tid < 64) MISC[F.tid] = 0u;
    __syncthreads();
    XcdBarrier bar; bar.bar = F.ctl + CW_BAR; bar.x = 0; bar.st = MISC + 8;
    if (MK_N_LAUNCHES == 1) bar = xcd_barrier_post(F.ctl + CW_BAR, MISC + 8);
    const int lo = args.ph_lo, hi = args.ph_hi & 0xffff; F.probe_rep = (args.ph_hi >> 16) != 0;
#define IN(k) (lo <= (k) && (k) < hi)
#ifndef PROBE_REPEAT
#define PROBE_REPEAT (-1)
#endif
#define NREP(k) ((k) == PROBE_REPEAT ? 2 : 1)
#define SEAM(k) do { if (IN(k) && IN((k) + 1)) xcd_barrier(bar); } while (0)
    const char* ws = (const char*)F.ws;
    if (IN(0)) for (int rep_ = 0; rep_ < NREP(0); ++rep_) { if (rep_) xcd_barrier(bar); p_mod(F); } SEAM(0);
    if (IN(1)) for (int rep_ = 0; rep_ < NREP(1); ++rep_) { if (rep_) xcd_barrier(bar); p_conv(F); __syncthreads(); p_thin<0>(F); } SEAM(1);
    if (IN(2)) for (int rep_ = 0; rep_ < NREP(2); ++rep_) { if (rep_) xcd_barrier(bar); pg8::DualOrder S{ws + WS_U, ws + W_IN, ws + WS_U, ws + W_IN, 64, 32, 0, D, F.G, F.bid};
        EpiHgIn E{(bf16_t*)(F.ws + B_Q), (float*)(F.ws + B_LF), (bf16_t*)(F.ws + B_VI), (bf16_t*)(F.ws + B_GS), (const float*)(F.ws + WS_LB), INF(I_HGONG)};
        pg8::gemm_phase(F.lds, D, S, E); } SEAM(2);
    if (IN(3)) for (int rep_ = 0; rep_ < NREP(3); ++rep_) { if (rep_) xcd_barrier(bar); p_hg_chunk(F); } SEAM(3);
    if (IN(4)) for (int rep_ = 0; rep_ < NREP(4); ++rep_) { if (rep_) xcd_barrier(bar); p_hg_scan(F); } SEAM(4);
    if (IN(5)) for (int rep_ = 0; rep_ < NREP(5); ++rep_) { if (rep_) xcd_barrier(bar); pg8::DualOrder S{ws + B_OG, ws + W_OUT, ws + B_OG, ws + W_OUT, 64, 8, 0, D, F.G, F.bid, true}; EpiBf16 E{(bf16_t*)(F.ws + WS_Y), D}; pg8::gemm_phase(F.lds, D, S, E); } SEAM(5);
    if (IN(6)) for (int rep_ = 0; rep_ < NREP(6); ++rep_) { if (rep_) xcd_barrier(bar); p_thin<1>(F); } SEAM(6);
    if (IN(7)) for (int rep_ = 0; rep_ < NREP(7); ++rep_) { if (rep_) xcd_barrier(bar); pg8::DualOrder S{ws + WS_U, ws + W_GU, ws + WS_U, ws + W_GU, 64, 44, 0, D, F.G, F.bid}; EpiGU E{(bf16_t*)(F.ws + B_ACT)}; pg8::gemm_phase(F.lds, D, S, E); } SEAM(7);
    if (IN(8)) for (int rep_ = 0; rep_ < NREP(8); ++rep_) { if (rep_) xcd_barrier(bar); pg8::DualOrder S{ws + B_ACT, ws + W_DN, ws + B_ACT, ws + W_DN, 64, 8, 0, DFF, F.G, F.bid}; EpiBf16 E{(bf16_t*)(F.ws + WS_Y), D}; pg8::gemm_phase(F.lds, DFF, S, E); } SEAM(8);
    if (IN(9)) for (int rep_ = 0; rep_ < NREP(9); ++rep_) { if (rep_) xcd_barrier(bar); p_thin<2>(F); } SEAM(9);
    if (IN(10)) for (int rep_ = 0; rep_ < NREP(10); ++rep_) { if (rep_) xcd_barrier(bar); pg8::DualOrder S{ws + WS_XS, ws + W_LAT, ws + WS_U, ws + W_LAT + (size_t)768 * D * 2, 64, 3, 2, D, F.G, F.bid};
        EpiLat E{(bf16_t*)(F.ws + B_CKV), (bf16_t*)(F.ws + B_QLAT), (bf16_t*)(F.ws + B_KR), (float*)(F.ws + WS_SSC), (float*)(F.ws + WS_SSQ), (const float*)(F.ws + WS_COS), (const float*)(F.ws + WS_SIN)};
        pg8::gemm_phase(F.lds, D, S, E); } SEAM(10);
    if (IN(11)) for (int rep_ = 0; rep_ < NREP(11); ++rep_) { if (rep_) xcd_barrier(bar); pg8::DualOrder S{ws + B_CKV, ws + W_KVQ, ws + B_QLAT, ws + W_KVQ + (size_t)4096 * 512 * 2, 64, 16, 12, 512, F.G, F.bid};
        EpiKvQ E{(bf16_t*)(F.ws + B_KN), (bf16_t*)(F.ws + B_V), (bf16_t*)(F.ws + B_QN), (bf16_t*)(F.ws + B_QR), (const float*)(F.ws + WS_SSC), (const float*)(F.ws + WS_SSQ), (const float*)(F.ws + WS_COS), (const float*)(F.ws + WS_SIN)};
        pg8::gemm_phase(F.lds, 512, S, E); } SEAM(11);
    if (IN(12)) for (int rep_ = 0; rep_ < NREP(12); ++rep_) { if (rep_) xcd_barrier(bar); p_attn(F); } SEAM(12);
    if (IN(13)) for (int rep_ = 0; rep_ < NREP(13); ++rep_) { if (rep_) xcd_barrier(bar); pg8::DualOrder S{ws + B_O, ws + W_O, ws + B_O, ws + W_O, 64, 8, 0, D, F.G, F.bid}; EpiBf16 E{(bf16_t*)(F.ws + WS_Y), D}; pg8::gemm_phase(F.lds, D, S, E); } SEAM(13);
    if (IN(14)) for (int rep_ = 0; rep_ < NREP(14); ++rep_) { if (rep_) xcd_barrier(bar); p_thin<3>(F); } SEAM(14);
    if (IN(15)) for (int rep_ = 0; rep_ < NREP(15); ++rep_) { if (rep_) xcd_barrier(bar); pg8::MoeOrder<true> S; S.A = ws + WS_U; S.W = ws + W_MGU; S.wstride = (size_t)2 * DFF * D; S.list = (const int*)(ws + WS_LIST); S.nN = 44; S.rb = D; S.G = F.G; S.c = F.bid; S.init(F.ctl);
        EpiGU8 E{F.ws + B_ACT2}; pg8::gemm_phase<EpiGU8, pg8::MoeOrder<true>, true>(F.lds, D, S, E); } SEAM(15);
    if (IN(16)) for (int rep_ = 0; rep_ < NREP(16); ++rep_) { if (rep_) xcd_barrier(bar); pg8::MoeOrder<false> S; S.A = ws + B_ACT2; S.W = ws + W_MDN; S.wstride = (size_t)D * DFF; S.list = nullptr; S.nN = 8; S.rb = DFF; S.G = F.G; S.c = F.bid; S.init(F.ctl);
        EpiBf16 E{(bf16_t*)(F.ws + B_Y2), D}; pg8::gemm_phase<EpiBf16, pg8::MoeOrder<false>, true>(F.lds, DFF, S, E); } SEAM(16);
    if (IN(17)) for (int rep_ = 0; rep_ < NREP(17); ++rep_) { if (rep_) xcd_barrier(bar); p_thin<4>(F); }
#undef IN
#undef SEAM
}

extern "C" void kernel_launch(void* const* d_in, const int* in_sizes, int n_in, void* d_out, int out_size, void* d_ws, size_t ws_size, hipStream_t stream) {
    static int grid = 0;
    if (grid == 0) {
        if (n_in != 25 || out_size != M * D || ws_size < WS_NEED) { fprintf(stderr, "kernel_launch: expected 25 inputs, out %d, ws >= %zu; got n_in %d out %d ws %zu\n", M * D, (size_t)WS_NEED, n_in, out_size, ws_size); grid = -1; return; }
        int dev = 0, cus = 0;
        if (hipGetDevice(&dev) != hipSuccess || hipDeviceGetAttribute(&cus, hipDeviceAttributeMultiprocessorCount, dev) != hipSuccess) { grid = -1; return; }
        if (hipFuncSetAttribute((const void*)fwd_kernel, hipFuncAttributeMaxDynamicSharedMemorySize, LDS_BYTES) != hipSuccess) { fprintf(stderr, "kernel_launch: hipFuncSetAttribute failed\n"); grid = -1; return; }
        int per_cu = 0;
        if (hipOccupancyMaxActiveBlocksPerMultiprocessor(&per_cu, (const void*)fwd_kernel, 512, LDS_BYTES) != hipSuccess || per_cu < 1) { fprintf(stderr, "kernel_launch: occupancy query reports %d\n", per_cu); (void)hipGetLastError(); }
        grid = cus;
    }
    if (grid < 0) return;
    (void)hipMemsetAsync((char*)d_ws + WS_CTL, 0, CTL_BYTES, stream);
    Args a{};
    for (int i = 0; i < 25; ++i) a.in[i] = d_in[i];
    a.out = (float*)d_out; a.ws = (unsigned char*)d_ws;
    if (MK_N_LAUNCHES == 1) { a.ph_lo = 0; a.ph_hi = N_PHASES; hipLaunchKernelGGL(fwd_kernel, dim3(grid), dim3(512), LDS_BYTES, stream, a); }
    else for (int p = 0; p < N_PHASES; ++p) { a.ph_lo = p; a.ph_hi = p + 1; hipLaunchKernelGGL(fwd_kernel, dim3(grid), dim3(512), LDS_BYTES, stream, a);
#if defined(PROBE_HOST_REPEAT)
        if (p == PROBE_HOST_REPEAT) { a.ph_hi |= 1 << 16; hipLaunchKernelGGL(fwd_kernel, dim3(grid), dim3(512), LDS_BYTES, stream, a); }
#endif
    }
    const hipError_t le = hipPeekAtLastError();
    if (le != hipSuccess) fprintf(stderr, "kernel_launch: launch failed: %s\n", hipGetErrorName(le));
}
```

```cpp
#include <hip/hip_runtime.h>
#include <cstdio>
#include <cstdint>

#ifndef MK_N_LAUNCHES
#define MK_N_LAUNCHES 1
#endif

#define LAS __attribute__((address_space(3)))
#define GAS __attribute__((address_space(1)))
typedef unsigned short bf16_t;
typedef short bf16x8 __attribute__((ext_vector_type(8)));
typedef short s16x4 __attribute__((ext_vector_type(4)));
typedef float f32x4 __attribute__((ext_vector_type(4)));
typedef float f32x2 __attribute__((ext_vector_type(2)));
typedef float f32x16 __attribute__((ext_vector_type(16)));
typedef unsigned u32x4 __attribute__((ext_vector_type(4)));
typedef unsigned u32x2 __attribute__((ext_vector_type(2)));

constexpr int D = 2048, BATCH = 2, SEQ = 8192, M = BATCH * SEQ;
constexpr int HG_H = 16, HG_K = 128, HG_C = 64, NCH = SEQ / HG_C;
constexpr int MLA_H = 16, QLORA = 512, KVLORA = 512, NOPE = 128, ROPE = 64, VH = 128;
constexpr int DFF = 5632, NEXP = 8;
constexpr float EPS = 1e-6f;
constexpr float MLA_SCALE = 0.07216878364870322f;
constexpr int NMOD = 4 * 6144 + 4096;
constexpr int MOE_MAXT = 136;
constexpr int MOE_ROWS = MOE_MAXT * 256;

constexpr size_t MiB = 1ull << 20;
constexpr size_t WS_CTL = 0;
constexpr size_t CTL_BYTES = 1 * MiB;
constexpr size_t WS_MOD = 1 * MiB;
constexpr size_t WS_LB = WS_MOD + 256 * 1024;
constexpr size_t WS_COS = 2 * MiB;
constexpr size_t WS_SIN = 4 * MiB;
constexpr size_t WS_SSO = 6 * MiB;
constexpr size_t WS_SSC = 14 * MiB;
constexpr size_t WS_SSQ = 15 * MiB;
constexpr size_t WS_TOK = 16 * MiB;
constexpr size_t WS_LIST = 17 * MiB;
constexpr size_t WS_W = 18 * MiB;
constexpr size_t W_IN = WS_W;
constexpr size_t W_OUT = W_IN + (size_t)8192 * 2048 * 2;
constexpr size_t W_GU = W_OUT + (size_t)2048 * 2048 * 2;
constexpr size_t W_DN = W_GU + (size_t)11264 * 2048 * 2;
constexpr size_t W_LAT = W_DN + (size_t)2048 * 5632 * 2;
constexpr size_t W_KVQ = W_LAT + (size_t)1280 * 2048 * 2;
constexpr size_t W_O = W_KVQ + (size_t)7168 * 512 * 2;
constexpr size_t W_MGU = W_O + (size_t)2048 * 2048 * 2;
constexpr size_t W_MDN = W_MGU + (size_t)8 * 11264 * 2048 * 2;
constexpr size_t W_END = W_MDN + (size_t)8 * 2048 * 5632 * 2;
constexpr size_t WS_U = (W_END + MiB - 1) / MiB * MiB;
constexpr size_t WS_XS = WS_U + (size_t)M * D * 2;
constexpr size_t WS_Y = WS_XS + (size_t)M * D * 2;
constexpr size_t WS_XR = WS_Y + (size_t)M * D * 2;
constexpr size_t WS_BIG = WS_Y + (size_t)M * D * 4;
constexpr size_t B_Q = WS_BIG;
constexpr size_t B_LF = B_Q + (size_t)M * D * 2;
constexpr size_t B_VI = B_LF + (size_t)M * D * 4;
constexpr size_t B_GS = B_VI + (size_t)M * D * 2;
constexpr size_t B_QH = B_GS + (size_t)M * D * 2;
constexpr size_t B_KT = B_QH + (size_t)M * D * 2;
constexpr size_t B_VT = B_KT + (size_t)M * D * 2;
constexpr size_t B_DEC = B_VT + (size_t)M * D * 2;
constexpr size_t B_OI = B_DEC + (size_t)4096 * 128 * 4;
constexpr size_t B_OG = B_Q;
constexpr size_t B_HG_END = B_OI + (size_t)M * D * 4;
constexpr size_t B_ACT = WS_BIG;
constexpr size_t B_CKV = WS_BIG;
constexpr size_t B_QLAT = B_CKV + (size_t)M * 512 * 2;
constexpr size_t B_KR = B_QLAT + (size_t)M * 512 * 2;
constexpr size_t B_KN = B_KR + (size_t)M * 64 * 2;
constexpr size_t B_V = B_KN + (size_t)M * D * 2;
constexpr size_t B_QN = B_V + (size_t)M * D * 2;
constexpr size_t B_QR = B_QN + (size_t)M * D * 2;
constexpr size_t B_O = B_QR + (size_t)M * 1024 * 2;
constexpr size_t B_MLA_END = B_O + (size_t)M * D * 2;
constexpr size_t B_ACT2 = WS_BIG;
constexpr size_t B_Y2 = B_ACT2 + (size_t)MOE_ROWS * DFF * 2;
constexpr size_t B_MOE_END = B_Y2 + (size_t)MOE_ROWS * D * 4;
constexpr size_t WS_NEED = (B_HG_END > B_MOE_END ? (B_HG_END > B_MLA_END ? B_HG_END : B_MLA_END) : (B_MOE_END > B_MLA_END ? B_MOE_END : B_MLA_END));

constexpr int CW_BAR = 4096;
constexpr int CW_CNT = 16384;
constexpr int LDS_BYTES = 147456;
constexpr int MISC_OFF = 131072 + 8192;

typedef __bf16 bf16x2_t __attribute__((ext_vector_type(2)));
__device__ __forceinline__ unsigned cvt_pk_bf16(float lo, float hi) { const f32x2 v = {lo, hi}; return __builtin_bit_cast(unsigned, __builtin_convertvector(v, bf16x2_t)); }
__device__ __forceinline__ float bf2f(bf16_t v) { return __uint_as_float(((unsigned)v) << 16); }
__device__ __forceinline__ float bflo(unsigned w) { return __uint_as_float(w << 16); }
__device__ __forceinline__ float bfhi(unsigned w) { return __uint_as_float(w & 0xffff0000u); }
__device__ __forceinline__ bf16_t f2bf(float f) { return (bf16_t)(cvt_pk_bf16(f, 0.f) & 0xffffu); }
__device__ __forceinline__ float wave_sum(float v) {
    v += __builtin_bit_cast(float, __builtin_amdgcn_update_dpp(0, __builtin_bit_cast(int, v), 0xB1, 0xf, 0xf, false));
    v += __builtin_bit_cast(float, __builtin_amdgcn_update_dpp(0, __builtin_bit_cast(int, v), 0x4E, 0xf, 0xf, false));
    v += __builtin_bit_cast(float, __builtin_amdgcn_update_dpp(0, __builtin_bit_cast(int, v), 0x141, 0xf, 0xf, false));
    v += __builtin_bit_cast(float, __builtin_amdgcn_update_dpp(0, __builtin_bit_cast(int, v), 0x140, 0xf, 0xf, false));
    { auto r = __builtin_amdgcn_permlane16_swap(__float_as_uint(v), __float_as_uint(v), false, false); v = __uint_as_float(r[0]) + __uint_as_float(r[1]); }
    { auto r = __builtin_amdgcn_permlane32_swap(__float_as_uint(v), __float_as_uint(v), false, false); v = __uint_as_float(r[0]) + __uint_as_float(r[1]); }
    return v;
}
__device__ __forceinline__ float sigmoidf_(float x) { return __builtin_amdgcn_rcpf(1.0f + __builtin_amdgcn_exp2f(x * -1.4426950408889634f)); }
__device__ __forceinline__ float siluf_(float x) { return x * __builtin_amdgcn_rcpf(1.0f + __builtin_amdgcn_exp2f(x * -1.4426950408889634f)); }

#define XB_TMO      128
#define XB_XCNT(j)  (256  + 64 * (j))
#define XB_XSUB(j)  (1280 + 64 * (j))
#define XB_XGEN(j)  (2304 + 64 * (j))
#define XB_TOP      3328
#define XB_TOPGEN   3392
#define XCD_BAR_WORDS 3456
#define XB_SPIN_CAP (1u << 22)

__device__ __forceinline__ unsigned xb_ld(unsigned* p)              { return __hip_atomic_load(p, __ATOMIC_RELAXED, __HIP_MEMORY_SCOPE_AGENT); }
__device__ __forceinline__ unsigned xb_add(unsigned* p, unsigned v) { return __hip_atomic_fetch_add(p, v, __ATOMIC_RELAXED, __HIP_MEMORY_SCOPE_AGENT); }
__device__ __forceinline__ unsigned xb_xcc_id() { return (unsigned)__builtin_amdgcn_s_getreg((3 << 11) | 20) & 0xFu; }
#define XB_SPIN(cond, bar) do { unsigned _sp = 0; while (cond) { __builtin_amdgcn_s_sleep(1); \
    if ((++_sp & 255u) == 0u) { if (xb_ld(&(bar)[XB_TMO])) break; if (_sp > XB_SPIN_CAP) { atomicAdd(&(bar)[XB_TMO], 1u); break; } } } } while (0)

struct XcdBarrier { unsigned* bar; unsigned x; volatile LAS unsigned* st; };

__device__ __forceinline__ XcdBarrier xcd_barrier_post(unsigned* bar, volatile LAS unsigned* st) {
    XcdBarrier b; b.bar = bar; b.x = xb_xcc_id(); b.st = st;
    if (threadIdx.x == 0) (void)xb_add(&bar[XB_XCNT(b.x)], 1u);
    return b;
}
__device__ __forceinline__ void xcd_barrier_complete(unsigned* bar, unsigned x, unsigned& nloc, unsigned& nx) {
    const unsigned G = gridDim.x * gridDim.y * gridDim.z;
    unsigned sum, cnt, mine, sp = 0u;
    for (;;) {
        sum = 0u; cnt = 0u; mine = 0u;
#pragma unroll
        for (unsigned j = 0; j < 16; ++j) { const unsigned c = xb_ld(&bar[XB_XCNT(j)]); sum += c; cnt += (c > 0u) ? 1u : 0u; mine = (j == x) ? c : mine; }
        if (sum == G) break;
        __builtin_amdgcn_s_sleep(1);
        if ((++sp & 255u) == 0u) { if (xb_ld(&bar[XB_TMO])) break; if (sp > XB_SPIN_CAP) { atomicAdd(&bar[XB_TMO], 1u); break; } }
    }
    nloc = mine > 0u ? mine : 1u; nx = cnt > 0u ? cnt : 1u;
}
__device__ __forceinline__ void xcd_barrier(const XcdBarrier& b) {
    asm volatile("s_waitcnt vmcnt(0)" ::: "memory");
    __syncthreads();
    if (threadIdx.x == 0) {
        unsigned* bar = b.bar;
        __builtin_amdgcn_s_waitcnt(0);
        unsigned nloc = b.st[0], nx = b.st[1];
        if (nloc == 0u) { xcd_barrier_complete(bar, b.x, nloc, nx); b.st[0] = nloc; b.st[1] = nx; }
        const unsigned old = xb_add(&bar[XB_XSUB(b.x)], 1u);
        const unsigned gen = old / nloc;
        if (old + 1u == (gen + 1u) * nloc) {
            __builtin_amdgcn_fence(__ATOMIC_RELEASE, "agent");
            asm volatile("s_waitcnt vmcnt(0)" ::: "memory");
            const unsigned og = xb_add(&bar[XB_TOP], 1u);
            const unsigned tg = og / nx;
            if (og + 1u == (tg + 1u) * nx) xb_add(&bar[XB_TOPGEN], 1u);
            else XB_SPIN(xb_ld(&bar[XB_TOPGEN]) == tg, bar);
            __builtin_amdgcn_fence(__ATOMIC_ACQUIRE, "agent");
            xb_add(&bar[XB_XGEN(b.x)], 1u);
            asm volatile("s_waitcnt vmcnt(0)" ::: "memory");
        } else {
            XB_SPIN(xb_ld(&bar[XB_XGEN(b.x)]) == gen, bar);
            __builtin_amdgcn_fence(__ATOMIC_ACQUIRE, "agent");
            asm volatile("s_waitcnt vmcnt(0)" ::: "memory");
        }
    }
    __syncthreads();
}

namespace pg8 {
constexpr int BM = 256, BK = 64, HALF = 128, HTB = HALF * BK * 2, STAGE_BYTES = 8 * HTB, NXCD = 8, WGM = 8;
__device__ __forceinline__ int lds_byte(int r, int c) { const int st = (r >> 4) * 2 + (c >> 5), rr = r & 15, cc = c & 31, ob = rr * 64 + cc * 2; return st * 1024 + (ob ^ (((ob >> 9) & 1) << 5)); }
__device__ __forceinline__ void stage_rc(int b, int& R, int& C) { const int st = b / 1024, sb = b % 1024, swz = sb ^ (((sb >> 9) & 1) << 5); R = (st >> 1) * 16 + swz / 64; C = (st & 1) * 32 + (swz % 64) / 2; }
__device__ __forceinline__ int perm32(int rho) { const int n = rho >> 4, i = rho & 15; return 8 * (i >> 2) + 4 * n + (i & 3); }

struct Unit { const char* a; const char* b; int pm, pn, e, nv; };

__device__ __forceinline__ void tile_of(int L, int nM, int nN, int& pm, int& pn) {
    const int nwg = nM * nN; int wgid = L;
    { const int q = nwg / NXCD, r = nwg % NXCD, xcd = wgid % NXCD, off = wgid / NXCD; wgid = (xcd < r ? xcd * (q + 1) : r * (q + 1) + (xcd - r) * q) + off; }
    const int nig = WGM * nN, gid = wgid / nig, fm = gid * WGM, gsz = (nM - fm) < WGM ? (nM - fm) : WGM;
    pm = fm + ((wgid % nig) % gsz); pn = (wgid % nig) / gsz;
}
struct DualOrder {
    static constexpr bool GATHER = false;
    const char *A1, *B1, *A2, *B2; int nM, nN1, nN2, K, G, c; bool tmA = false;
    __device__ __forceinline__ bool next(int i, Unit& u) const {
        const int nN = nN1 + nN2; const long L = (long)i * G + c; if (L >= (long)nM * nN) return false;
        int pm, pn; tile_of((int)L, nM, nN, pm, pn);
        const size_t tstep = (size_t)BM * K * 2;
        if (pn < nN1) { u.e = 0; u.pn = pn; u.a = A1 + pm * tstep; u.b = B1 + pn * tstep; }
        else { u.e = 1; u.pn = pn - nN1; u.a = A2 + pm * tstep; u.b = B2 + (pn - nN1) * tstep; }
        u.pm = pm; u.nv = 256; return true;
    }
    __device__ __forceinline__ const int* rows(const Unit&) const { return nullptr; }
};
template <bool GATHER_> struct MoeOrder {
    static constexpr bool GATHER = GATHER_;
    static constexpr bool tmA = false;
    const char* A; const char* W; size_t wstride; const int* list; int nT, nN, rb  , G, c; int tstart[NEXP + 1]; int cnt[NEXP];
    __device__ __forceinline__ void init(const unsigned* ctl) {
        int t = 0;
#pragma unroll
        for (int e = 0; e < NEXP; ++e) { const int n = (int)ctl[CW_CNT + 64 * e]; cnt[e] = n; tstart[e] = t; t += (n + 255) >> 8; }
        tstart[NEXP] = t; nT = t;
    }
    __device__ __forceinline__ bool next(int i, Unit& u) const {
        const long L = (long)i * G + c; if (L >= (long)nT * nN) return false;
        int pm, pn; tile_of((int)L, nT, nN, pm, pn);
        int e = 0;
#pragma unroll
        for (int j = 1; j < NEXP; ++j) e += (pm >= tstart[j]) ? 1 : 0;
        int ce = 0, ts = 0;
#pragma unroll
        for (int j = 0; j < NEXP; ++j) { ce = (j == e) ? cnt[j] : ce; ts = (j == e) ? tstart[j] : ts; }
        u.e = e; u.pm = pm; u.pn = pn; const int left = ce - (pm - ts) * 256; u.nv = left < 256 ? left : 256;
        u.a = GATHER ? A : A + (size_t)pm * BM * rb; u.b = W + (size_t)e * wstride + (size_t)pn * BM * rb;
        return true;
    }
    __device__ __forceinline__ const int* rows(const Unit& u) const { int ts = 0;
#pragma unroll
        for (int j = 0; j < NEXP; ++j) ts = (j == u.e) ? tstart[j] : ts;
        return list + (size_t)u.e * M + (u.pm - ts) * 256; }
};

typedef int i32x4 __attribute__((ext_vector_type(4)));
typedef int i32x8 __attribute__((ext_vector_type(8)));
constexpr float W8_SCALE = 128.0f; constexpr int W8_EXP = 0x78787878, ONE_EXP = 0x7f7f7f7f;
template <class Epi, class Sched, bool FP8 = false>
__device__ __forceinline__ void gemm_phase(LAS unsigned char* lds, const int Kel, const Sched& S, const Epi& E) {
    const int K = FP8 ? Kel / 2 : Kel;
    const int tid = threadIdx.x, wid = __builtin_amdgcn_readfirstlane(tid >> 6), lane = tid & 63, wr = wid >> 2, wc = wid & 3, fr = lane & 15, fq = lane >> 4;
    const int nt = K / BK;
    unsigned vA[2][2], vB[2]; int Rr[2], Cc[2];
#pragma unroll
    for (int i = 0; i < 2; ++i) { int R, C; stage_rc(tid * 16 + i * 8192, R, C); Rr[i] = R; Cc[i] = C; const int Rb = Epi::PERM ? ((R & ~31) + perm32(R & 31)) : R;
        vB[i] = (unsigned)(Rb * K + C) * 2u; }
    const size_t kstep = (size_t)(BK * 2), kstepA = S.tmA ? (size_t)8192 : kstep;
    const size_t hstep = (size_t)HALF * K * 2;
    const unsigned ldsw = (unsigned)wid * 1024u;
    const int aoff = lds_byte(wr * 64 + fr, fq * 8), boff = lds_byte(wc * 32 + fr, fq * 8);
#define PG8_SA(b, h) (((b) * 2 + (h)) * HTB)
#define PG8_SB(b, h) ((4 + (b) * 2 + (h)) * HTB)
#define PG8_STAGE2(bufoff, gbase, v0, v1) do { \
        __builtin_amdgcn_global_load_lds((const unsigned*)((const char*)(gbase) + (v0)), (LAS unsigned*)(lds + (bufoff) + ldsw), 16, 0, 0); \
        __builtin_amdgcn_global_load_lds((const unsigned*)((const char*)(gbase) + (v1)), (LAS unsigned*)(lds + (bufoff) + ldsw + 8192), 16, 0, 0); } while (0)
#define PG8_STAGEB(bufoff, gbase) PG8_STAGE2(bufoff, gbase, vB[0], vB[1])
#define PG8_LD8(p) __builtin_shufflevector(*(const LAS i32x4*)(p), *(const LAS i32x4*)((p) + 1024), 0, 1, 2, 3, 4, 5, 6, 7)
#define PG8_LDA(dst, b, h) do { if constexpr (FP8) { _Pragma("unroll") for (int m = 0; m < 4; ++m) dst##8[m] = PG8_LD8(lds + PG8_SA(b, h) + aoff + m * 2048); } \
        else { _Pragma("unroll") for (int m = 0; m < 4; ++m) _Pragma("unroll") for (int k = 0; k < 2; ++k) dst[m][k] = *(const LAS bf16x8*)(lds + PG8_SA(b, h) + aoff + m * 2048 + k * 1024); } } while (0)
#define PG8_LDB(dst, b, h) do { if constexpr (FP8) { _Pragma("unroll") for (int n = 0; n < 2; ++n) dst##8[n] = PG8_LD8(lds + PG8_SB(b, h) + boff + n * 2048); } \
        else { _Pragma("unroll") for (int n = 0; n < 2; ++n) _Pragma("unroll") for (int k = 0; k < 2; ++k) dst[n][k] = *(const LAS bf16x8*)(lds + PG8_SB(b, h) + boff + n * 2048 + k * 1024); } } while (0)
#define PG8_MMA(ai, bj, At, Bt) do { __builtin_amdgcn_s_setprio(1); _Pragma("unroll") for (int m = 0; m < 4; ++m) _Pragma("unroll") for (int n = 0; n < 2; ++n) { \
        if constexpr (FP8) asm volatile("v_mfma_scale_f32_16x16x128_f8f6f4 %0, %1, %2, %0, %3, %4 op_sel_hi:[0,0,0]" : "+v"(acc[ai][bj][m][n]) : "v"(Bt##8[n]), "v"(At##8[m]), "v"(sc_w8), "v"(sc_one)); \
        else { _Pragma("unroll") for (int k = 0; k < 2; ++k) acc[ai][bj][m][n] = __builtin_amdgcn_mfma_f32_16x16x32_bf16(Bt[n][k], At[m][k], acc[ai][bj][m][n], 0, 0, 0); } } \
        __builtin_amdgcn_s_setprio(0); } while (0)
#define PG8_WAIT_V(n) asm volatile("s_waitcnt vmcnt(" #n ")" ::: "memory")
#define PG8_WAIT_L(n) asm volatile("s_waitcnt lgkmcnt(" #n ")" ::: "memory")
#define PG8_BAR __builtin_amdgcn_s_barrier()
#define PG8_SCHED __builtin_amdgcn_sched_barrier(0)
    Unit cur, nxt; int ui = 0;
    if (!S.next(0, cur)) return;
    if constexpr (Sched::GATHER) { const int* rl = S.rows(cur);
#pragma unroll
        for (int h = 0; h < 2; ++h)
#pragma unroll
            for (int i = 0; i < 2; ++i) { const int j = Rr[i] + 128 * h; const int tok = (j < cur.nv) ? rl[j] : 0; vA[h][i] = (unsigned)(tok * K + Cc[i]) * 2u; } }
    else {
#pragma unroll
        for (int h = 0; h < 2; ++h)
#pragma unroll
            for (int i = 0; i < 2; ++i) { const int row = Rr[i] + 128 * h; vA[h][i] = S.tmA ? (unsigned)((row >> 6) * 262144 + (Cc[i] >> 4) * 2048 + (row & 63) * 32 + (Cc[i] & 15) * 2) : (unsigned)(row * K + Cc[i]) * 2u; } }
    LAS unsigned char* idx_lds = lds + STAGE_BYTES + wid * 1024;
    f32x4 acc[2][2][4][2];
#pragma unroll
    for (int a = 0; a < 2; ++a)
#pragma unroll
        for (int b = 0; b < 2; ++b)
#pragma unroll
            for (int m = 0; m < 4; ++m)
#pragma unroll
                for (int n = 0; n < 2; ++n) acc[a][b][m][n] = (f32x4){0.f, 0.f, 0.f, 0.f};
    bf16x8 At[4][2], B0[2][2], B1[2][2]; i32x8 At8[4], B08[2], B18[2];
    int sc_w8 = W8_EXP, sc_one = ONE_EXP; asm volatile("" : "+v"(sc_w8), "+v"(sc_one));
    const char* cA = cur.a; const char* cB = cur.b;
    PG8_STAGEB(PG8_SB(0, 0), cB); PG8_STAGEB(PG8_SB(0, 1), cB + hstep); PG8_STAGE2(PG8_SA(0, 0), cA, vA[0][0], vA[0][1]); PG8_STAGE2(PG8_SA(0, 1), cA, vA[1][0], vA[1][1]);
    if (wr == 1) PG8_BAR;
    PG8_WAIT_V(2); PG8_BAR;
    PG8_STAGEB(PG8_SB(1, 0), cB + kstep); PG8_STAGE2(PG8_SA(1, 0), cA + kstepA, vA[0][0], vA[0][1]); PG8_STAGEB(PG8_SB(1, 1), cB + hstep + kstep);
    PG8_WAIT_V(6); PG8_BAR;
    for (;;) {
        const bool has_next = S.next(ui + 1, nxt);
        const char* nA = has_next ? nxt.a : cA; const char* nB = has_next ? nxt.b : cB;
        for (int t = 0; t < nt; t += 2) {
            const bool last = (t == nt - 2);
            if constexpr (Sched::GATHER) { if (t == nt - 6 && has_next) { const int* rl = S.rows(nxt);
#pragma unroll
                for (int h = 0; h < 2; ++h)
#pragma unroll
                    for (int i = 0; i < 2; ++i) __builtin_amdgcn_global_load_lds((const unsigned*)(rl + Rr[i] + 128 * h), (LAS unsigned*)(idx_lds + (h * 2 + i) * 256), 4, 0, 0); } }
            const char* a1 = cA + (size_t)(t + 1) * kstepA;
            const char* a2 = last ? nA : cA + (size_t)(t + 2) * kstepA; const char* b2 = last ? nB : cB + (size_t)(t + 2) * kstep;
            const char* a3 = a2 + kstepA; const char* b3 = b2 + kstep;
            PG8_LDB(B0, 0, 0); PG8_LDB(B1, 0, 1); PG8_SCHED; PG8_LDA(At, 0, 0); PG8_STAGE2(PG8_SA(1, 1), a1, vA[1][0], vA[1][1]);
            if constexpr (Sched::GATHER) { if (last && has_next) {
#pragma unroll
                for (int h = 0; h < 2; ++h)
#pragma unroll
                    for (int i = 0; i < 2; ++i) { const int j = Rr[i] + 128 * h; const int tok = *(const LAS int*)(idx_lds + (h * 2 + i) * 256 + lane * 4); vA[h][i] = (unsigned)(((j < nxt.nv) ? tok : 0) * K + Cc[i]) * 2u; } } }
            PG8_WAIT_V(8); PG8_WAIT_L(0); PG8_BAR; PG8_MMA(0, 0, At, B0); PG8_MMA(0, 1, At, B1); PG8_BAR; PG8_SCHED;
            PG8_LDA(At, 0, 1); PG8_STAGEB(PG8_SB(0, 0), b2); PG8_STAGEB(PG8_SB(0, 1), b2 + hstep); PG8_STAGE2(PG8_SA(0, 0), a2, vA[0][0], vA[0][1]);
            PG8_WAIT_V(8); PG8_WAIT_L(0); PG8_BAR; PG8_MMA(1, 0, At, B0); PG8_MMA(1, 1, At, B1); PG8_BAR; PG8_SCHED;
            PG8_LDB(B0, 1, 0); PG8_LDB(B1, 1, 1); PG8_SCHED; PG8_LDA(At, 1, 0); PG8_STAGE2(PG8_SA(0, 1), a2, vA[1][0], vA[1][1]);
            PG8_WAIT_V(8); PG8_WAIT_L(0); PG8_BAR; PG8_MMA(0, 0, At, B0); PG8_MMA(0, 1, At, B1); PG8_BAR; PG8_SCHED;
            PG8_LDA(At, 1, 1); PG8_STAGEB(PG8_SB(1, 0), b3); PG8_STAGEB(PG8_SB(1, 1), b3 + hstep); PG8_STAGE2(PG8_SA(1, 0), a3, vA[0][0], vA[0][1]);
            PG8_WAIT_V(8); PG8_WAIT_L(0); PG8_BAR; PG8_MMA(1, 0, At, B0); PG8_MMA(1, 1, At, B1); PG8_BAR; PG8_SCHED;
        }
        if (wr == 0) PG8_BAR;
        if constexpr (FP8) asm volatile("s_nop 15\n\ts_nop 15" ::: "memory");
        E(acc, cur, wr, wc, fr, fq);
        if (!has_next) break;
#pragma unroll
        for (int a = 0; a < 2; ++a)
#pragma unroll
            for (int b = 0; b < 2; ++b)
#pragma unroll
                for (int m = 0; m < 4; ++m)
#pragma unroll
                    for (int n = 0; n < 2; ++n) acc[a][b][m][n] = (f32x4){0.f, 0.f, 0.f, 0.f};
        cur = nxt; cA = nA; cB = nB; ++ui;
        if (wr == 1) PG8_BAR;
    }
    PG8_WAIT_V(0);
    PG8_BAR;
#undef PG8_SA
#undef PG8_SB
#undef PG8_STAGE2
#undef PG8_STAGEB
#undef PG8_LDA
#undef PG8_LD8
#undef PG8_LDB
#undef PG8_MMA
#undef PG8_WAIT_V
#undef PG8_WAIT_L
#undef PG8_BAR
#undef PG8_SCHED
}
}
using pg8::Unit;

__device__ __forceinline__ size_t tm_off(int m, int ch) { return ((((size_t)(m >> 6) * 128 + (ch >> 4)) * 64 + (m & 63)) * 16 + (ch & 15)); }
typedef f32x4 Acc[2][2][4][2];
__device__ __forceinline__ u32x4 pack8(f32x4 a, f32x4 b) { return (u32x4){cvt_pk_bf16(a[0], a[1]), cvt_pk_bf16(a[2], a[3]), cvt_pk_bf16(b[0], b[1]), cvt_pk_bf16(b[2], b[3])}; }

__device__ __forceinline__ u32x2 pack8_fp8(f32x4 a, f32x4 b) { int w0 = 0, w1 = 0;
    w0 = __builtin_amdgcn_cvt_pk_fp8_f32(a[0], a[1], w0, false); w0 = __builtin_amdgcn_cvt_pk_fp8_f32(a[2], a[3], w0, true);
    w1 = __builtin_amdgcn_cvt_pk_fp8_f32(b[0], b[1], w1, false); w1 = __builtin_amdgcn_cvt_pk_fp8_f32(b[2], b[3], w1, true); return (u32x2){(unsigned)w0, (unsigned)w1}; }
struct EpiHgIn {
    static constexpr bool PERM = true;
    bf16_t* Q; float* LF; bf16_t* VI; bf16_t* GS; const float* lb; const float* gn;
    __device__ __forceinline__ void operator()(const Acc& acc, const Unit& u, int wr, int wc, int fr, int fq) const {
        const int type = u.pn >> 3, row0 = u.pm * 256 + wr * 64 + fr, col0 = (u.pn & 7) * 256 + wc * 32 + 8 * fq;
        if (type == 0 || type == 2) { bf16_t* O = type == 0 ? Q : VI;
#pragma unroll
            for (int ai = 0; ai < 2; ++ai)
#pragma unroll
                for (int m = 0; m < 4; ++m) { bf16_t* rowp = O + (size_t)(row0 + ai * 128 + m * 16) * D + col0;
#pragma unroll
                    for (int bj = 0; bj < 2; ++bj) *(u32x4*)(rowp + bj * 128) = pack8(acc[ai][bj][m][0], acc[ai][bj][m][1]); }
        } else if (type == 1) {
#pragma unroll
            for (int bj = 0; bj < 2; ++bj) { const f32x4 l0 = *(const f32x4*)(lb + col0 + bj * 128), l1 = *(const f32x4*)(lb + col0 + bj * 128 + 4);
#pragma unroll
                for (int ai = 0; ai < 2; ++ai)
#pragma unroll
                    for (int m = 0; m < 4; ++m) { _Float16* rowp = (_Float16*)LF + (size_t)(row0 + ai * 128 + m * 16) * D + col0 + bj * 128; f32x4 o0, o1;
#pragma unroll
                        for (int j = 0; j < 4; ++j) { o0[j] = __builtin_amdgcn_logf(1.f - (1.f - l0[j]) * sigmoidf_(-acc[ai][bj][m][0][j])) * 0.6931471805599453f; o1[j] = __builtin_amdgcn_logf(1.f - (1.f - l1[j]) * sigmoidf_(-acc[ai][bj][m][1][j])) * 0.6931471805599453f; }
                        typedef _Float16 h8 __attribute__((ext_vector_type(8)));
                        *(h8*)rowp = (h8){(_Float16)o0[0], (_Float16)o0[1], (_Float16)o0[2], (_Float16)o0[3], (_Float16)o1[0], (_Float16)o1[1], (_Float16)o1[2], (_Float16)o1[3]}; } }
        } else {
#pragma unroll
            for (int bj = 0; bj < 2; ++bj) { const f32x4 g0 = *(const f32x4*)(gn + col0 + bj * 128), g1 = *(const f32x4*)(gn + col0 + bj * 128 + 4);
#pragma unroll
                for (int ai = 0; ai < 2; ++ai)
#pragma unroll
                    for (int m = 0; m < 4; ++m) { bf16_t* rowp = GS + tm_off(row0 + ai * 128 + m * 16, col0 + bj * 128); f32x4 o0, o1;
#pragma unroll
                        for (int j = 0; j < 4; ++j) { o0[j] = siluf_(acc[ai][bj][m][0][j]) * g0[j]; o1[j] = siluf_(acc[ai][bj][m][1][j]) * g1[j]; }
                        *(u32x4*)rowp = pack8(o0, o1); } }
        }
    }
};
struct EpiNull {
    static constexpr bool PERM = false;
    __device__ __forceinline__ void operator()(const Acc& acc, const Unit& u, int wr, int wc, int fr, int fq) const {
#pragma unroll
        for (int ai = 0; ai < 2; ++ai)
#pragma unroll
            for (int bj = 0; bj < 2; ++bj)
#pragma unroll
                for (int m = 0; m < 4; ++m)
#pragma unroll
                    for (int n = 0; n < 2; ++n) asm volatile("" :: "v"(acc[ai][bj][m][n]));
    }
};
struct EpiF32 {
    static constexpr bool PERM = false;
    float* C; int ldc;
    __device__ __forceinline__ void operator()(const Acc& acc, const Unit& u, int wr, int wc, int fr, int fq) const {
        const int row0 = u.pm * 256 + wr * 64 + fr, col0 = u.pn * 256 + wc * 32 + 4 * fq;
#pragma unroll
        for (int ai = 0; ai < 2; ++ai)
#pragma unroll
            for (int m = 0; m < 4; ++m) { float* rowp = C + (size_t)(row0 + ai * 128 + m * 16) * ldc + col0;
#pragma unroll
                for (int bj = 0; bj < 2; ++bj)
#pragma unroll
                    for (int n = 0; n < 2; ++n) *(f32x4*)(rowp + bj * 128 + n * 16) = acc[ai][bj][m][n]; }
    }
};
struct EpiBf16 {
    static constexpr bool PERM = true;
    bf16_t* C; int ldc;
    __device__ __forceinline__ void operator()(const Acc& acc, const Unit& u, int wr, int wc, int fr, int fq) const {
        const int row0 = u.pm * 256 + wr * 64 + fr, col0 = u.pn * 256 + wc * 32 + 8 * fq;
#pragma unroll
        for (int ai = 0; ai < 2; ++ai)
#pragma unroll
            for (int m = 0; m < 4; ++m) { bf16_t* rowp = C + (size_t)(row0 + ai * 128 + m * 16) * ldc + col0;
#pragma unroll
                for (int bj = 0; bj < 2; ++bj) *(u32x4*)(rowp + bj * 128) = pack8(acc[ai][bj][m][0], acc[ai][bj][m][1]); }
    }
};
struct EpiGU {
    static constexpr bool PERM = true;
    bf16_t* ACT;
    __device__ __forceinline__ void operator()(const Acc& acc, const Unit& u, int wr, int wc, int fr, int fq) const {
        const int row0 = u.pm * 256 + wr * 64 + fr, col0 = u.pn * 128 + wc * 32 + 8 * fq;
#pragma unroll
        for (int ai = 0; ai < 2; ++ai)
#pragma unroll
            for (int m = 0; m < 4; ++m) { f32x4 o0, o1;
#pragma unroll
                for (int j = 0; j < 4; ++j) { o0[j] = siluf_(acc[ai][0][m][0][j]) * acc[ai][1][m][0][j]; o1[j] = siluf_(acc[ai][0][m][1][j]) * acc[ai][1][m][1][j]; }
                *(u32x4*)(ACT + (size_t)(row0 + ai * 128 + m * 16) * DFF + col0) = pack8(o0, o1); }
    }
};
struct EpiGU8 {
    static constexpr bool PERM = true;
    unsigned char* ACT;
    __device__ __forceinline__ void operator()(const Acc& acc, const Unit& u, int wr, int wc, int fr, int fq) const {
        const int row0 = u.pm * 256 + wr * 64 + fr, col0 = u.pn * 128 + wc * 32 + 8 * fq;
#pragma unroll
        for (int ai = 0; ai < 2; ++ai)
#pragma unroll
            for (int m = 0; m < 4; ++m) { f32x4 o0, o1;
#pragma unroll
                for (int j = 0; j < 4; ++j) { o0[j] = __builtin_amdgcn_fmed3f(siluf_(acc[ai][0][m][0][j]) * acc[ai][1][m][0][j], -448.f, 448.f); o1[j] = __builtin_amdgcn_fmed3f(siluf_(acc[ai][0][m][1][j]) * acc[ai][1][m][1][j], -448.f, 448.f); }
                *(u32x2*)(ACT + (size_t)(row0 + ai * 128 + m * 16) * DFF + col0) = pack8_fp8(o0, o1); }
    }
};
struct EpiLat {
    static constexpr bool PERM = true;
    bf16_t* CKV; bf16_t* QLAT; bf16_t* KR; float* SSC; float* SSQ; const float* COS; const float* SIN;
    __device__ __forceinline__ void operator()(const Acc& acc, const Unit& u, int wr, int wc, int fr, int fq) const {
        const int row0 = u.pm * 256 + wr * 64 + fr;
        if (u.e == 0 && u.pn == 2) {
            if (wc < 2) { const int j = 16 * wc + 4 * fq;
#pragma unroll
                for (int ai = 0; ai < 2; ++ai)
#pragma unroll
                    for (int m = 0; m < 4; ++m) { const int r = row0 + ai * 128 + m * 16; const f32x4 c = *(const f32x4*)(COS + (size_t)r * 32 + j), s = *(const f32x4*)(SIN + (size_t)r * 32 + j);
                        const f32x4 x1 = acc[ai][0][m][0], x2 = acc[ai][0][m][1]; const f32x4 o1 = x1 * c - x2 * s, o2 = x2 * c + x1 * s;
                        *(u32x2*)(KR + (size_t)r * 64 + j) = (u32x2){cvt_pk_bf16(o1[0], o1[1]), cvt_pk_bf16(o1[2], o1[3])};
                        *(u32x2*)(KR + (size_t)r * 64 + 32 + j) = (u32x2){cvt_pk_bf16(o2[0], o2[1]), cvt_pk_bf16(o2[2], o2[3])}; } }
            return;
        }
        bf16_t* O = u.e == 0 ? CKV : QLAT; float* SS = u.e == 0 ? SSC : SSQ;
        const int col0 = u.pn * 256 + wc * 32 + 8 * fq;
#pragma unroll
        for (int ai = 0; ai < 2; ++ai)
#pragma unroll
            for (int m = 0; m < 4; ++m) { const int r = row0 + ai * 128 + m * 16; float s = 0.f;
#pragma unroll
                for (int bj = 0; bj < 2; ++bj) { const f32x4 a = acc[ai][bj][m][0], b = acc[ai][bj][m][1];
                    s += (a[0] * a[0] + a[1] * a[1]) + (a[2] * a[2] + a[3] * a[3]) + (b[0] * b[0] + b[1] * b[1]) + (b[2] * b[2] + b[3] * b[3]);
                    *(u32x4*)(O + (size_t)r * 512 + col0 + bj * 128) = pack8(a, b); }
                s += __shfl_xor(s, 16); s += __shfl_xor(s, 32);
                if (fq == 0) SS[(size_t)r * 8 + u.pn * 4 + wc] = s; }
    }
};
struct EpiKvQ {
    static constexpr bool PERM = true;
    bf16_t* KN; bf16_t* V; bf16_t* QN; bf16_t* QR; const float* SSC; const float* SSQ; const float* COS; const float* SIN;
    __device__ __forceinline__ void operator()(const Acc& acc, const Unit& u, int wr, int wc, int fr, int fq) const {
        const int row0 = u.pm * 256 + wr * 64 + fr; const float* SS = u.e == 0 ? SSC : SSQ;
#pragma unroll
        for (int ai = 0; ai < 2; ++ai)
#pragma unroll
            for (int m = 0; m < 4; ++m) { const int r = row0 + ai * 128 + m * 16, b = r >> 13, s = r & (SEQ - 1);
                const f32x4 p0 = *(const f32x4*)(SS + (size_t)r * 8), p1 = *(const f32x4*)(SS + (size_t)r * 8 + 4);
                const float rstd = rsqrtf(((p0[0] + p0[1]) + (p0[2] + p0[3]) + (p1[0] + p1[1]) + (p1[2] + p1[3])) * (1.0f / 512.0f) + EPS);
                if (u.e == 0) { const size_t o = ((size_t)(b * MLA_H + u.pn) * SEQ + s) * 128 + wc * 32 + 8 * fq;
                    *(u32x4*)(KN + o) = pack8(acc[ai][0][m][0] * rstd, acc[ai][0][m][1] * rstd); *(u32x4*)(V + o) = pack8(acc[ai][1][m][0] * rstd, acc[ai][1][m][1] * rstd); }
                else if (u.pn < 8) {
#pragma unroll
                    for (int bj = 0; bj < 2; ++bj) { const size_t o = ((size_t)(b * MLA_H + 2 * u.pn + bj) * SEQ + s) * 128 + wc * 32 + 8 * fq;
                        *(u32x4*)(QN + o) = pack8(acc[ai][bj][m][0] * rstd, acc[ai][bj][m][1] * rstd); } }
                else { const int j = 16 * (wc & 1) + 4 * fq; const f32x4 c = *(const f32x4*)(COS + (size_t)r * 32 + j), sn = *(const f32x4*)(SIN + (size_t)r * 32 + j);
#pragma unroll
                    for (int bj = 0; bj < 2; ++bj) { const int head = 4 * (u.pn - 8) + 2 * bj + (wc >> 1); const size_t o = ((size_t)(b * MLA_H + head) * SEQ + s) * 64 + j;
                        const f32x4 x1 = acc[ai][bj][m][0] * rstd, x2 = acc[ai][bj][m][1] * rstd; const f32x4 o1 = x1 * c - x2 * sn, o2 = x2 * c + x1 * sn;
                        *(u32x2*)(QR + o) = (u32x2){cvt_pk_bf16(o1[0], o1[1]), cvt_pk_bf16(o1[2], o1[3])};
                        *(u32x2*)(QR + o + 32) = (u32x2){cvt_pk_bf16(o2[0], o2[1]), cvt_pk_bf16(o2[2], o2[3])}; } }
            }
    }
};

struct Args { const void* in[25]; float* out; unsigned char* ws; int ph_lo, ph_hi; };
enum { I_X = 0, I_C, I_POS, I_ADAW, I_ADAB, I_NORMG, I_HGWIN, I_HGLB, I_HGONG, I_HGWOUT, I_KVNG, I_KVADAW, I_KVADAB, I_WKVA, I_KVNORMG, I_WKVB, I_WQA, I_QNORMG, I_WQB, I_WO,
       I_FGU, I_FDN, I_ROUTER, I_MGU, I_MDN };
struct Frame { LAS unsigned char* lds; int tid, lane, wave, G, bid; const Args* a; unsigned char* ws; unsigned* ctl; bool probe_rep; };
#define INF(k) ((const float*)F.a->in[k])

__device__ __forceinline__ const float* modp(const Frame& F, int which, int part, int b) { return (const float*)(F.ws + WS_MOD) + (size_t)b * NMOD + (which < 4 ? which * 6144 : 24576) + part * 2048; }
__device__ __forceinline__ const float* normg(const Frame& F, int layer, int sub, int which) { return INF(I_NORMG) + ((layer * 2 + sub) * 2 + which) * 2048; }

__device__ __forceinline__ void p_mod(const Frame& F) {
    LAS float* scv = (LAS float*)F.lds;
    LAS float* red = (LAS float*)(F.lds + 16384);
    for (int it = F.bid; it < 224; it += F.G) {
        __syncthreads();
        for (int i = F.tid; i < 2 * D; i += 512) scv[i] = siluf_(INF(I_C)[i]);
        __syncthreads();
        const float* W; const float* bias; int N, col0, obase;
        if (it < 192) { const int mi = it / 48; W = INF(I_ADAW) + (size_t)mi * D * 6144; bias = INF(I_ADAB) + mi * 6144; N = 6144; col0 = (it % 48) * 128; obase = mi * 6144; }
        else { W = INF(I_KVADAW); bias = INF(I_KVADAB); N = 4096; col0 = (it - 192) * 128; obase = 24576; }
        const int half = F.lane >> 5, cq = F.lane & 31;
        const float* wp = W + (size_t)(256 * F.wave + half) * N + col0 + 4 * cq;
        f32x4 a0 = {0.f, 0.f, 0.f, 0.f}, a1 = a0;
#pragma unroll 16
        for (int i = 0; i < 128; ++i) { const f32x4 v = *(const f32x4*)(wp + (size_t)(2 * i) * N); const int k = 256 * F.wave + 2 * i + half; a0 += v * scv[k]; a1 += v * scv[D + k]; }
        const int slot = F.wave * 2 + half;
        *(LAS f32x4*)(red + (slot * 2 + 0) * 128 + 4 * cq) = a0; *(LAS f32x4*)(red + (slot * 2 + 1) * 128 + 4 * cq) = a1;
        __syncthreads();
        if (F.tid < 256) { const int b = F.tid >> 7, col = F.tid & 127; float s = bias[col0 + col];
#pragma unroll
            for (int p = 0; p < 16; ++p) s += red[(p * 2 + b) * 128 + col];
            ((float*)(F.ws + WS_MOD))[(size_t)b * NMOD + obase + col0 + col] = s; }
    }
    const int gtid = F.bid * 512 + F.tid, gn = F.G * 512;
    for (int i = gtid; i < D; i += gn) { const float l0 = INF(I_HGLB)[i], l1 = INF(I_HGLB)[D + i]; ((float*)(F.ws + WS_LB))[i] = 1.0f / (1.0f + expf(l1 - l0)); }
    for (int p = gtid; p < M * 32; p += gn) { const int m = p >> 5, j = p & 31; const float pos = (float)((const int*)F.a->in[I_POS])[m];
        const float inv = 1.0f / powf(10000.0f, (float)(2 * j) / 64.0f); const float ang = pos * inv; float s_, c_; sincosf(ang, &s_, &c_);
        ((float*)(F.ws + WS_COS))[p] = c_; ((float*)(F.ws + WS_SIN))[p] = s_; }
}

__device__ __forceinline__ int rope_dest(int p) { return 32 * ((p >> 4) & 1) + 8 * ((p >> 2) & 3) + 4 * (p >> 5) + (p & 3); }
__device__ __forceinline__ int dest_row(int kind, int c) {
    if (kind == 0) return c;
    if (kind == 1) { const int b = c >= DFF ? 1 : 0, j = c - b * DFF; return (j >> 7) * 256 + b * 128 + (j & 127); }
    if (kind == 2) return c < 512 ? c : 512 + rope_dest(c - 512);
    const int h = c / 192, j = c - h * 192; return j < 128 ? h * 128 + j : 2048 + h * 64 + rope_dest(j - 128);
}
__device__ __forceinline__ void conv_item(const float* W, int K, int N, bf16_t* WT, int kind, const float* gsc, LAS float* scr, int item, int lane) {
    const int nblk = N / 32, kb = item / nblk, nb = item % nblk, k0 = 64 * kb, n0 = 32 * nb;
#pragma unroll 8
    for (int i = 0; i < 32; ++i) { const int kk = 2 * i + (lane >> 5); float v = W[(size_t)(k0 + kk) * N + n0 + (lane & 31)]; if (gsc) v *= gsc[k0 + kk]; scr[kk * 33 + (lane & 31)] = v; }
    asm volatile("s_waitcnt lgkmcnt(0)" ::: "memory");
    const int c = lane & 7;
#pragma unroll
    for (int j = 0; j < 4; ++j) { const int n = (lane >> 3) + 8 * j; const LAS float* s = scr + (8 * c) * 33 + n;
        u32x4 o; o.x = cvt_pk_bf16(s[0 * 33], s[1 * 33]); o.y = cvt_pk_bf16(s[2 * 33], s[3 * 33]); o.z = cvt_pk_bf16(s[4 * 33], s[5 * 33]); o.w = cvt_pk_bf16(s[6 * 33], s[7 * 33]);
        *(u32x4*)(WT + (size_t)dest_row(kind, n0 + n) * K + k0 + 8 * c) = o; }
    asm volatile("s_waitcnt lgkmcnt(0)" ::: "memory");
}
__device__ __forceinline__ void conv_item8(const float* W, int K, int N, unsigned char* WT, int kind, LAS float* scr, int item, int lane) {
    const int nblk = N / 32, kb = item / nblk, nb = item % nblk, k0 = 64 * kb, n0 = 32 * nb;
#pragma unroll 8
    for (int i = 0; i < 32; ++i) { const int kk = 2 * i + (lane >> 5); scr[kk * 33 + (lane & 31)] = W[(size_t)(k0 + kk) * N + n0 + (lane & 31)] * pg8::W8_SCALE; }
    asm volatile("s_waitcnt lgkmcnt(0)" ::: "memory");
    const int c = lane & 7;
#pragma unroll
    for (int j = 0; j < 4; ++j) { const int n = (lane >> 3) + 8 * j; const LAS float* s = scr + (8 * c) * 33 + n;
        const f32x4 a = {s[0 * 33], s[1 * 33], s[2 * 33], s[3 * 33]}, b = {s[4 * 33], s[5 * 33], s[6 * 33], s[7 * 33]};
        *(u32x2*)(WT + (size_t)dest_row(kind, n0 + n) * K + k0 + 8 * c) = pack8_fp8(a, b); }
    asm volatile("s_waitcnt lgkmcnt(0)" ::: "memory");
}
constexpr int MOE_I_GU = (D / 64) * (2 * DFF / 128), MOE_I_DN = (DFF / 64) * (D / 128), MOE_I_E = MOE_I_GU + MOE_I_DN, MOE_ITEMS = NEXP * MOE_I_E;
__device__ __forceinline__ void conv_moe_item(const Frame& F, int g) {
    const int lane = F.lane, nq = lane & 31, half = lane >> 5; const int e = g / MOE_I_E; int r = g - e * MOE_I_E;
    const float* W; unsigned char* dst; int K, N, kind;
    if (r < MOE_I_GU) { W = INF(I_MGU) + (size_t)e * D * 2 * DFF; K = D; N = 2 * DFF; dst = F.ws + W_MGU + (size_t)e * 2 * DFF * D; kind = 1; }
    else { r -= MOE_I_GU; W = INF(I_MDN) + (size_t)e * DFF * D; K = DFF; N = D; dst = F.ws + W_MDN + (size_t)e * D * DFF; kind = 0; }
    const int nkb = K / 64, nb = r / nkb, kb = r - nb * nkb, k0 = 64 * kb, n0 = 128 * nb;
    const float* wp = W + (size_t)(k0 + 32 * half) * N + n0 + 4 * nq; f32x4 v[32];
#pragma unroll
    for (int i = 0; i < 32; ++i) v[i] = *(const f32x4*)(wp + (size_t)i * N);
    LAS unsigned char* t = F.lds + F.wave * 16384;
#pragma unroll
    for (int j = 0; j < 4; ++j)
#pragma unroll
        for (int c = 0; c < 4; ++c) { const f32x4 a = (f32x4){v[8 * c][j], v[8 * c + 1][j], v[8 * c + 2][j], v[8 * c + 3][j]} * pg8::W8_SCALE, b = (f32x4){v[8 * c + 4][j], v[8 * c + 5][j], v[8 * c + 6][j], v[8 * c + 7][j]} * pg8::W8_SCALE;
            *(LAS u32x2*)(t + (4 * nq + j) * 72 + 32 * half + 8 * c) = pack8_fp8(a, b); }
    asm volatile("s_waitcnt lgkmcnt(0)" ::: "memory");
    const int c8 = lane & 7;
#pragma unroll
    for (int jj = 0; jj < 16; ++jj) { const int n = (lane >> 3) + 8 * jj;
        *(u32x2*)(dst + (size_t)dest_row(kind, n0 + n) * K + k0 + 8 * c8) = *(const LAS u32x2*)(t + n * 72 + 8 * c8); }
    asm volatile("s_waitcnt lgkmcnt(0)" ::: "memory");
}
__device__ __forceinline__ void conv_moe_part(const Frame& F, int part, int nparts) {
    const int gw = F.bid * 8 + F.wave, NGW = F.G * 8, per = (MOE_ITEMS + NGW - 1) / NGW, chunk = (per + nparts - 1) / nparts;
    const int k0 = part * chunk, k1 = (k0 + chunk < per) ? k0 + chunk : per;
    for (int k = k0; k < k1; ++k) { const int g = gw + k * NGW; if (g < MOE_ITEMS) conv_moe_item(F, g); }
}
__device__ __forceinline__ void p_conv(const Frame& F) {
    LAS float* scr = (LAS float*)(F.lds + F.wave * 16384);
    const long gw = (long)F.bid * 8 + F.wave, NGW = (long)F.G * 8;
    struct Mt { const float* W; int K, N; size_t dst; int kind; const float* g; };
    auto run = [&](const float* W, int K, int N, size_t dst, int kind, const float* g) { const long n = (long)(K / 64) * (N / 32);
        for (long it = gw; it < n; it += NGW) conv_item(W, K, N, (bf16_t*)(F.ws + dst), kind, g, scr, (int)it, F.lane); };
    run(INF(I_HGWIN), D, 8192, W_IN, 0, nullptr);
    run(INF(I_HGWOUT), D, D, W_OUT, 0, nullptr);
    run(INF(I_FGU), D, 2 * DFF, W_GU, 1, nullptr);
    run(INF(I_FDN), DFF, D, W_DN, 0, nullptr);
    run(INF(I_WKVA), D, 576, W_LAT, 2, nullptr);
    run(INF(I_WQA), D, 512, W_LAT + (size_t)768 * D * 2, 0, nullptr);
    run(INF(I_WKVB), 512, 4096, W_KVQ, 0, INF(I_KVNORMG));
    run(INF(I_WQB), 512, 3072, W_KVQ + (size_t)4096 * 512 * 2, 3, INF(I_QNORMG));
    run(INF(I_WO), D, D, W_O, 0, nullptr);
}

struct Row { f32x4 v[8]; };
struct RowIn { u32x2 y[8], ya[8], xb[8]; f32x4 xf[8]; float s0, s1; int4 tk; };
__device__ __forceinline__ void row_ld(Row& r, const float* p, int lane) {
#pragma unroll
    for (int j = 0; j < 8; ++j) r.v[j] = *(const f32x4*)(p + 4 * lane + 256 * j);
}
__device__ __forceinline__ void row_ld_bf(Row& r, const bf16_t* p, int lane) {
#pragma unroll
    for (int j = 0; j < 8; ++j) { const u32x2 w = *(const u32x2*)(p + 4 * lane + 256 * j); r.v[j] = (f32x4){bflo(w[0]), bfhi(w[0]), bflo(w[1]), bfhi(w[1])}; }
}
__device__ __forceinline__ float row_ss(const Row& r) { float s = 0.f;
#pragma unroll
    for (int j = 0; j < 8; ++j) s += (r.v[j][0] * r.v[j][0] + r.v[j][1] * r.v[j][1]) + (r.v[j][2] * r.v[j][2] + r.v[j][3] * r.v[j][3]);
    return wave_sum(s); }
template <bool F8 = false>
__device__ __forceinline__ void row_mod_store(const Row& h, float rstd, const LAS float* gs, const LAS float* sh, bf16_t* o, int lane, Row* keep) {
#pragma unroll
    for (int j = 0; j < 8; ++j) { const int c = 4 * lane + 256 * j; const f32x4 gv = *(const LAS f32x4*)(gs + c), hv = *(const LAS f32x4*)(sh + c);
        const f32x4 u = h.v[j] * rstd * gv + hv; if (keep) keep->v[j] = u;
        if (F8) { int w = 0; w = __builtin_amdgcn_cvt_pk_fp8_f32(u[0], u[1], w, false); w = __builtin_amdgcn_cvt_pk_fp8_f32(u[2], u[3], w, true); *(int*)((unsigned char*)o + c) = w; }
        else *(u32x2*)(o + c) = (u32x2){cvt_pk_bf16(u[0], u[1]), cvt_pk_bf16(u[2], u[3])}; }
}
template <int MODE> __device__ __forceinline__ void p_thin(const Frame& F) {
    const int lane = F.lane; float* out = F.a->out;
    LAS float* T_GG = (LAS float*)F.lds; LAS float* T_GS = T_GG + 4096; LAS float* T_SH = T_GS + 4096; LAS float* T_KGS = T_SH + 4096; LAS float* T_KSH = T_KGS + 4096;
    LAS float* wr = T_SH + 4096;
    LAS int* sel = (LAS int*)(F.lds + 122880);
    __syncthreads();
#pragma unroll
    for (int i = F.tid; i < 2 * D; i += 512) { const int b = i >> 11, c = i & (D - 1);
        if (MODE >= 1) { const int mw = MODE - 1; T_GG[i] = modp(F, mw, 2, b)[c] * normg(F, mw >> 1, mw & 1, 1)[c]; }
        if (MODE <= 3) { T_GS[i] = normg(F, MODE >> 1, MODE & 1, 0)[c] * (1.0f + modp(F, MODE, 1, b)[c]); T_SH[i] = modp(F, MODE, 0, b)[c]; }
        if (MODE == 2) { T_KGS[i] = INF(I_KVNG)[c] * (1.0f + modp(F, 4, 1, b)[c]); T_KSH[i] = modp(F, 4, 0, b)[c]; } }
    if (MODE == 3) { const float* w = INF(I_ROUTER);
#pragma unroll
        for (int q = F.tid; q < D * 2; q += 512) { const int i = q >> 1, h = q & 1; ((LAS f32x4*)wr)[(((i >> 8) * 4 + (i & 3)) * 2 + h) * 64 + ((i & 255) >> 2)] = *(const f32x4*)(w + i * 8 + 4 * h); } }
    __syncthreads();
    int tst[NEXP];
    if (MODE == 4) { int t = 0;
#pragma unroll
        for (int e = 0; e < NEXP; ++e) { tst[e] = t * 256; t += ((int)F.ctl[CW_CNT + 64 * e] + 255) >> 8; } }
    const int stride = F.G * 8; const int4* TOKv = (const int4*)(F.ws + WS_TOK);
    auto load_in = [&](int m, RowIn& r, const int4& tk) {
        if (MODE <= 1) { const float* p = INF(I_X) + (size_t)m * D;
#pragma unroll
            for (int j = 0; j < 8; ++j) r.xf[j] = *(const f32x4*)(p + 4 * lane + 256 * j); }
        if (MODE == 1) { const float* ss = (const float*)(F.ws + WS_SSO) + (size_t)m * 128; r.s0 = ss[lane]; r.s1 = ss[64 + lane]; }
        if (MODE >= 1 && MODE <= 3) { const bf16_t* p = (const bf16_t*)(F.ws + WS_Y) + (size_t)m * D;
#pragma unroll
            for (int j = 0; j < 8; ++j) r.y[j] = *(const u32x2*)(p + 4 * lane + 256 * j); }
        if (MODE >= 2) { const bf16_t* p = (const bf16_t*)(F.ws + WS_XR) + (size_t)m * D;
#pragma unroll
            for (int j = 0; j < 8; ++j) r.xb[j] = *(const u32x2*)(p + 4 * lane + 256 * j); }
        if (MODE == 4) { r.tk = tk; int o0 = 0, o1 = 0;
#pragma unroll
            for (int e = 0; e < NEXP; ++e) { o0 = ((tk.x & 15) == e) ? tst[e] : o0; o1 = ((tk.y & 15) == e) ? tst[e] : o1; }
            const bf16_t* y0 = (const bf16_t*)(F.ws + B_Y2) + (size_t)(o0 + (tk.x >> 4)) * D; const bf16_t* y1 = (const bf16_t*)(F.ws + B_Y2) + (size_t)(o1 + (tk.y >> 4)) * D;
#pragma unroll
            for (int j = 0; j < 8; ++j) { r.ya[j] = *(const u32x2*)(y0 + 4 * lane + 256 * j); r.y[j] = *(const u32x2*)(y1 + 4 * lane + 256 * j); } }
    };
    RowIn cur, nxt; int4 tkn = make_int4(0, 0, 0, 0);
    { const int m0 = F.bid * 8 + F.wave; int4 tk0 = make_int4(0, 0, 0, 0);
      if (MODE == 4) { if (m0 < M) tk0 = TOKv[m0]; if (m0 + stride < M) tkn = TOKv[m0 + stride]; }
      if (m0 < M) load_in(m0, cur, tk0); }
    for (int m = F.bid * 8 + F.wave; m < M; m += stride) {
        const int b = m >> 13, tb = b * D; Row h;
        { const int mn = m + stride; int4 tkn2 = make_int4(0, 0, 0, 0);
          if (mn < M) { load_in(mn, nxt, tkn); if (MODE == 4 && mn + stride < M) tkn2 = TOKv[mn + stride]; }
          tkn = tkn2; }
#define UNPK(w) ((f32x4){bflo((w)[0]), bfhi((w)[0]), bflo((w)[1]), bfhi((w)[1])})
        if (MODE == 0) {
#pragma unroll
            for (int j = 0; j < 8; ++j) h.v[j] = cur.xf[j]; }
        else {
            Row y; float escale = EPS;
            if (MODE == 4) { const float w0 = __int_as_float(cur.tk.z), w1 = __int_as_float(cur.tk.w);
#pragma unroll
                for (int j = 0; j < 8; ++j) y.v[j] = UNPK(cur.ya[j]) * w0 + UNPK(cur.y[j]) * w1;
            } else {
#pragma unroll
                for (int j = 0; j < 8; ++j) y.v[j] = UNPK(cur.y[j]); }
            if (MODE == 1) { const float so = wave_sum(cur.s0 + cur.s1) * (1.0f / D); escale = EPS * (so + EPS); }
            bf16_t* xr = (bf16_t*)(F.ws + WS_XR) + (size_t)m * D;
#pragma unroll
            for (int j = 0; j < 8; ++j) h.v[j] = (MODE == 1) ? cur.xf[j] : UNPK(cur.xb[j]);
            const float rstd = rsqrtf(row_ss(y) * (1.0f / D) + escale);
#pragma unroll
            for (int j = 0; j < 8; ++j) { const int c = 4 * lane + 256 * j; const f32x4 gg = *(const LAS f32x4*)(T_GG + tb + c);
                h.v[j] = h.v[j] + gg * (y.v[j] * rstd);
                if (MODE == 4) *(f32x4*)(out + (size_t)m * D + c) = h.v[j];
                else *(u32x2*)(xr + c) = (u32x2){cvt_pk_bf16(h.v[j][0], h.v[j][1]), cvt_pk_bf16(h.v[j][2], h.v[j][3])}; }
        }
#undef UNPK
        cur = nxt;
        if (MODE == 4) continue;
        const float rstd = rsqrtf(row_ss(h) * (1.0f / D) + EPS);
        if (MODE == 2) row_mod_store(h, rstd, T_KGS + tb, T_KSH + tb, (bf16_t*)(F.ws + WS_XS) + (size_t)m * D, lane, nullptr);
        Row u;
        if (MODE == 3) row_mod_store<true>(h, rstd, T_GS + tb, T_SH + tb, (bf16_t*)(F.ws + WS_U + (size_t)m * D), lane, &u);
        else row_mod_store(h, rstd, T_GS + tb, T_SH + tb, (bf16_t*)(F.ws + WS_U) + (size_t)m * D, lane, nullptr);
        if (MODE == 3) {
            float lg[NEXP];
#pragma unroll
            for (int e = 0; e < NEXP; ++e) lg[e] = 0.f;
#pragma unroll
            for (int j = 0; j < 8; ++j) { asm volatile("" ::: "memory");
#pragma unroll
                for (int c = 0; c < 4; ++c) { const f32x4 w0 = ((const LAS f32x4*)wr)[((j * 4 + c) * 2 + 0) * 64 + lane], w1 = ((const LAS f32x4*)wr)[((j * 4 + c) * 2 + 1) * 64 + lane]; const float x = u.v[j][c];
                    lg[0] += x * w0[0]; lg[1] += x * w0[1]; lg[2] += x * w0[2]; lg[3] += x * w0[3]; lg[4] += x * w1[0]; lg[5] += x * w1[1]; lg[6] += x * w1[2]; lg[7] += x * w1[3]; } }
#pragma unroll
            for (int e = 0; e < NEXP; ++e) lg[e] = wave_sum(lg[e]);
            int e0 = 0; float v0 = lg[0];
#pragma unroll
            for (int e = 1; e < NEXP; ++e) if (lg[e] > v0) { v0 = lg[e]; e0 = e; }
            int e1 = e0 == 0 ? 1 : 0; float v1 = lg[e1];
#pragma unroll
            for (int e = 0; e < NEXP; ++e) if (e != e0 && lg[e] > v1) { v1 = lg[e]; e1 = e; }
            if (lane == 0) { const float p1 = __expf(v1 - v0), w0 = 1.0f / (1.0f + p1), w1 = p1 * w0;
                const int idx = ((m - F.bid * 8) / (F.G * 8)) * 8 + F.wave;
                sel[2 * idx] = e0; sel[2 * idx + 1] = e1;
                ((int2*)(F.ws + WS_TOK))[2 * (size_t)m + 1] = make_int2(__float_as_int(w0), __float_as_int(w1)); }
        }
    }
    if (MODE == 3) {
        __syncthreads();
        if (F.tid < NEXP) { const int e = F.tid, nIdx = ((M - F.bid * 8 + F.G * 8 - 1) / (F.G * 8)) * 8; int c = 0;
            for (int idx = 0; idx < nIdx; ++idx) { const int m = F.bid * 8 + (idx & 7) + (idx >> 3) * F.G * 8; if (m < M) c += (sel[2 * idx] == e ? 1 : 0) + (sel[2 * idx + 1] == e ? 1 : 0); }
            int r = c ? (int)atomicAdd(F.ctl + CW_CNT + 64 * e, (unsigned)c) : 0;
            int* list = (int*)(F.ws + WS_LIST) + (size_t)e * M; int* tok = (int*)(F.ws + WS_TOK);
            for (int idx = 0; idx < nIdx; ++idx) { const int m = F.bid * 8 + (idx & 7) + (idx >> 3) * F.G * 8; if (m >= M) continue;
                if (sel[2 * idx] == e) { list[r] = m; tok[4 * (size_t)m] = e | (r << 4); ++r; }
                if (sel[2 * idx + 1] == e) { list[r] = m; tok[4 * (size_t)m + 1] = e | (r << 4); ++r; } } }
    }
}

#define MFMA16(X, Y, C) __builtin_amdgcn_mfma_f32_16x16x32_bf16((X), (Y), (C), 0, 0, 0)
__device__ __forceinline__ float expc(float x) { return __expf(fminf(x, 80.0f)); }
__device__ __forceinline__ int hg_tiled(int r, int seg) { return (((r >> 4) * 2 + (seg >> 1)) * 64 + (2 * (seg & 1)) * 16 + (r & 15)) * 8; }
__device__ __forceinline__ void p_hg_chunk(const Frame& F) {
    constexpr int RS = 272, TS = 144;
    LAS unsigned char* QA = F.lds; LAS unsigned char* QB = QA + 64 * RS; LAS unsigned char* KA = QB + 32 * RS; LAS unsigned char* KB = KA + 32 * RS;
    LAS unsigned char* VS = KB + 64 * RS; LAS unsigned char* VT = VS + 64 * RS; LAS unsigned char* PS = VT + 128 * TS; LAS float* TOT = (LAS float*)(PS + 64 * TS);
    const int tid = F.tid, lane = F.lane, w = F.wave, ch = tid & 127, seg = tid >> 7, fr = lane & 15, fq = lane >> 4;
    const _Float16* LFg = (const _Float16*)(F.ws + B_LF); const bf16_t* Qg = (const bf16_t*)(F.ws + B_Q); const bf16_t* VIg = (const bf16_t*)(F.ws + B_VI);
    for (int unit = F.bid; unit < 4096; unit += F.G) {
        const int bh = unit >> 7, c = unit & 127, b = bh >> 4, h = bh & 15, m0 = b * SEQ + 64 * c, k0 = 128 * h;
        float lf[16], qv[16];
#pragma unroll
        for (int i = 0; i < 16; ++i) { const size_t o = (size_t)(m0 + 16 * seg + i) * D + k0 + ch; lf[i] = (float)LFg[o]; qv[i] = bf2f(Qg[o]); }
#pragma unroll
        for (int p = 0; p < 2; ++p) { const int piece = tid + 512 * p, s = piece >> 4, v8 = (piece & 15) * 8; *(LAS u32x4*)(VS + s * RS + v8 * 2) = *(const u32x4*)(VIg + (size_t)(m0 + s) * D + k0 + v8); }
        float bcs[16]; float run = 0.f;
#pragma unroll
        for (int i = 0; i < 16; ++i) { run += lf[i]; bcs[i] = run; }
        TOT[seg * 128 + ch] = run;
        __syncthreads();
        const float t0 = TOT[ch], t1 = TOT[128 + ch], t2 = TOT[256 + ch], t3 = TOT[384 + ch];
        const float pre = seg == 0 ? 0.f : seg == 1 ? t0 : seg == 2 ? t0 + t1 : t0 + t1 + t2, r1 = t0 + t1, bl = r1 + t2 + t3;
        unsigned kh[8];
#pragma unroll
        for (int i = 0; i < 16; i += 2) { float kv[2];
#pragma unroll
            for (int z = 0; z < 2; ++z) { const int t = 16 * seg + i + z; const float bb = bcs[i + z] + pre, kk = 1.0f - __expf(lf[i + z]), q = qv[i + z];
                *(LAS bf16_t*)(QA + t * RS + ch * 2) = f2bf(q * expc(bb));
                if (seg >= 2) *(LAS bf16_t*)(QB + (t - 32) * RS + ch * 2) = f2bf(q * expc(bb - r1));
                if (seg < 2) *(LAS bf16_t*)(KA + t * RS + ch * 2) = f2bf(kk * expc(-bb));
                *(LAS bf16_t*)(KB + t * RS + ch * 2) = f2bf(kk * expc(r1 - bb));
                kv[z] = kk * expc(bl - bb); }
            kh[i >> 1] = cvt_pk_bf16(kv[0], kv[1]); }
        { bf16_t* kt = (bf16_t*)(F.ws + B_KT) + (size_t)unit * 8192 + hg_tiled(ch, seg); *(u32x4*)kt = (u32x4){kh[0], kh[1], kh[2], kh[3]}; *(u32x4*)(kt + 128) = (u32x4){kh[4], kh[5], kh[6], kh[7]}; }
        if (seg == 3) ((float*)(F.ws + B_DEC))[(size_t)unit * 128 + ch] = expc(bl);
        { unsigned vv[8];
#pragma unroll
            for (int i = 0; i < 16; i += 2) { const unsigned lo = *(const LAS bf16_t*)(VS + (16 * seg + i) * RS + ch * 2), hi = *(const LAS bf16_t*)(VS + (16 * seg + i + 1) * RS + ch * 2); vv[i >> 1] = lo | (hi << 16); }
            const u32x4 a = {vv[0], vv[1], vv[2], vv[3]}, bq = {vv[4], vv[5], vv[6], vv[7]};
            *(LAS u32x4*)(VT + ch * TS + 32 * seg) = a; *(LAS u32x4*)(VT + ch * TS + 32 * seg + 16) = bq;
            bf16_t* vt = (bf16_t*)(F.ws + B_VT) + (size_t)unit * 8192 + hg_tiled(ch, seg); *(u32x4*)vt = a; *(u32x4*)(vt + 128) = bq; }
        __syncthreads();
#pragma unroll
        for (int p = 0; p < 2; ++p) { const int piece = tid + 512 * p, ww = piece >> 7, pp = (piece >> 6) & 1, ln = piece & 63, r_ = ln & 15, q_ = ln >> 4;
            const u32x2 lo = *(const LAS u32x2*)(QA + (32 * pp + r_) * RS + (16 * ww + 4 * q_) * 2), hi = *(const LAS u32x2*)(QA + (32 * pp + 16 + r_) * RS + (16 * ww + 4 * q_) * 2);
            *(u32x4*)((bf16_t*)(F.ws + B_QH) + (size_t)unit * 8192 + piece * 8) = (u32x4){lo[0], lo[1], hi[0], hi[1]}; }
        { const int tt = w >> 2, st = w & 3; f32x4 acc = {0.f, 0.f, 0.f, 0.f};
#pragma unroll
            for (int kb = 0; kb < 4; ++kb) acc = MFMA16(*(const LAS bf16x8*)(KB + (16 * st + fr) * RS + (32 * kb + 8 * fq) * 2), *(const LAS bf16x8*)(QB + (16 * tt + fr) * RS + (32 * kb + 8 * fq) * 2), acc);
            const int ta = 32 + 16 * tt + fr, sa = 16 * st + 4 * fq;
#pragma unroll
            for (int j = 0; j < 4; ++j) if (sa + j > ta) acc[j] = 0.f;
            *(LAS u32x2*)(PS + ta * TS + sa * 2) = (u32x2){cvt_pk_bf16(acc[0], acc[1]), cvt_pk_bf16(acc[2], acc[3])}; }
        if (w < 4) { const int tt = w >> 1, st = w & 1; f32x4 acc = {0.f, 0.f, 0.f, 0.f};
#pragma unroll
            for (int kb = 0; kb < 4; ++kb) acc = MFMA16(*(const LAS bf16x8*)(KA + (16 * st + fr) * RS + (32 * kb + 8 * fq) * 2), *(const LAS bf16x8*)(QA + (16 * tt + fr) * RS + (32 * kb + 8 * fq) * 2), acc);
            const int ta = 16 * tt + fr, sa = 16 * st + 4 * fq;
#pragma unroll
            for (int j = 0; j < 4; ++j) if (sa + j > ta) acc[j] = 0.f;
            *(LAS u32x2*)(PS + ta * TS + sa * 2) = (u32x2){cvt_pk_bf16(acc[0], acc[1]), cvt_pk_bf16(acc[2], acc[3])}; }
        __syncthreads();
#pragma unroll
        for (int tt = 0; tt < 4; ++tt) { f32x4 acc = {0.f, 0.f, 0.f, 0.f};
#pragma unroll
            for (int sb = 0; sb < 2; ++sb) if (sb == 0 || tt >= 2) acc = MFMA16(*(const LAS bf16x8*)(VT + (16 * w + fr) * TS + (32 * sb + 8 * fq) * 2), *(const LAS bf16x8*)(PS + (16 * tt + fr) * TS + (32 * sb + 8 * fq) * 2), acc);
            *(u32x2*)((bf16_t*)(F.ws + B_OI) + tm_off(m0 + 16 * tt + fr, k0 + 16 * w + 4 * fq)) = (u32x2){cvt_pk_bf16(acc[0], acc[1]), cvt_pk_bf16(acc[2], acc[3])}; }
        __syncthreads();
    }
}
__device__ __forceinline__ void p_hg_scan(const Frame& F) {
    LAS f32x4* red = (LAS f32x4*)F.lds;
    const int tid = F.tid, lane = F.lane, w = F.wave, fr = lane & 15, fq = lane >> 4;
    const bf16_t* QH = (const bf16_t*)(F.ws + B_QH); const bf16_t* KT = (const bf16_t*)(F.ws + B_KT); const bf16_t* VT = (const bf16_t*)(F.ws + B_VT); const float* DEC = (const float*)(F.ws + B_DEC);
    const bf16_t* OI = (const bf16_t*)(F.ws + B_OI); const bf16_t* GS = (const bf16_t*)(F.ws + B_GS); bf16_t* OG = (bf16_t*)(F.ws + B_OG); float* SSO = (float*)(F.ws + WS_SSO);
    for (int ui = F.bid; ui < 256; ui += F.G) {
        const int unit = (F.G == 256) ? (((ui & 7) * 4 + (ui >> 6)) * 8 + ((ui >> 3) & 7)) : ui;
        const int bh = unit >> 3, vs = unit & 7, b = bh >> 4, h = bh & 15;
        const int tt2 = (tid >> 6) & 3;
        const size_t rowoff = tm_off(b * SEQ + 16 * tt2 + fr, 128 * h + 16 * vs + 4 * fq);
        f32x4 S = {0.f, 0.f, 0.f, 0.f};
        u32x4 qA[2], qB[2]; u32x2 gsA, gsB, oiA, oiB; bf16x8 ktA[2], ktB[2], vtA[2], vtB[2]; f32x4 dA, dB;
#define HG_LOAD(q_, kt_, vt_, d_, oi_, gs_, cc) do { const size_t cu = (size_t)(bh * 128 + (cc)); \
            _Pragma("unroll") for (int pp = 0; pp < 2; ++pp) q_[pp] = *(const u32x4*)(QH + cu * 8192 + ((w * 2 + pp) * 64 + lane) * 8); \
            _Pragma("unroll") for (int sb = 0; sb < 2; ++sb) { kt_[sb] = *(const bf16x8*)(KT + cu * 8192 + ((w * 2 + sb) * 64 + lane) * 8); vt_[sb] = *(const bf16x8*)(VT + cu * 8192 + ((vs * 2 + sb) * 64 + lane) * 8); } \
            d_ = *(const f32x4*)(DEC + cu * 128 + 16 * w + 4 * fq); \
            if (tid < 256) { oi_ = *(const u32x2*)(OI + rowoff + (size_t)(cc) * 131072); gs_ = *(const u32x2*)(GS + rowoff + (size_t)(cc) * 131072); } } while (0)
#define HG_STEP(q_, kt_, vt_, d_, oi_, gs_, cc) do { \
            LAS f32x4* rb = red + ((cc) & 1) * 2048; \
            { const u32x4 sw = {cvt_pk_bf16(S[0], S[1]), cvt_pk_bf16(S[2], S[3]), 0u, 0u}; const bf16x8 Sb = *(const bf16x8*)&sw; \
                _Pragma("unroll") for (int tt = 0; tt < 4; ++tt) { const u32x4 xw = {q_[tt >> 1][2 * (tt & 1)], q_[tt >> 1][2 * (tt & 1) + 1], 0u, 0u}; const f32x4 z = {0.f, 0.f, 0.f, 0.f}; \
                    rb[(w * 4 + tt) * 64 + lane] = MFMA16(Sb, *(const bf16x8*)&xw, z); } }            \
            S = S * d_; S = MFMA16(kt_[0], vt_[0], S); S = MFMA16(kt_[1], vt_[1], S); \
            const u32x2 oiw = oi_; const f32x4 oi = {bflo(oiw[0]), bfhi(oiw[0]), bflo(oiw[1]), bfhi(oiw[1])}; const u32x2 gs = gs_; \
            if ((cc) + 2 < NCH) HG_LOAD(q_, kt_, vt_, d_, oi_, gs_, (cc) + 2); \
            __syncthreads(); \
            if (tid < 256) { f32x4 o = rb[tt2 * 64 + lane]; \
                _Pragma("unroll") for (int ww = 1; ww < 8; ++ww) o += rb[(ww * 4 + tt2) * 64 + lane]; \
                o += oi; float s2 = (o[0] * o[0] + o[1] * o[1]) + (o[2] * o[2] + o[3] * o[3]); s2 += __shfl_xor(s2, 16); s2 += __shfl_xor(s2, 32); \
                *(u32x2*)(OG + rowoff + (size_t)(cc) * 131072) = (u32x2){cvt_pk_bf16(o[0] * bflo(gs[0]), o[1] * bfhi(gs[0])), cvt_pk_bf16(o[2] * bflo(gs[1]), o[3] * bfhi(gs[1]))}; \
                if (fq == 0) SSO[(size_t)(b * SEQ + 64 * (cc) + 16 * tt2 + fr) * 128 + h * 8 + vs] = s2; } } while (0)
        HG_LOAD(qA, ktA, vtA, dA, oiA, gsA, 0);
        HG_LOAD(qB, ktB, vtB, dB, oiB, gsB, 1);
        for (int c = 0; c < NCH; c += 2) { HG_STEP(qA, ktA, vtA, dA, oiA, gsA, c); HG_STEP(qB, ktB, vtB, dB, oiB, gsB, c + 1); }
        __syncthreads();
#undef HG_LOAD
#undef HG_STEP
    }
}

namespace att {
constexpr int KROW = 384, SHM_K = 64 * KROW, SHM_V = 16384, OFF_K = 2 * SHM_V, OFF_WS = OFF_K + 2 * SHM_K;
constexpr float THR = 8.f;
__device__ __forceinline__ int v_rd_base(int lane) { return ((lane & 3) << 3) | (((lane >> 2) & 3) << 6) | (((lane >> 4) & 1) << 5) | (((lane >> 5) & 1) << 8); }
__device__ __forceinline__ int crow(int r, int hi) { return (r & 3) + 8 * (r >> 2) + 4 * hi; }
#define SBAR() __builtin_amdgcn_sched_barrier(0)
__device__ __forceinline__ void mask_tile(f32x16& p0, f32x16& p1, int dq) {
    const float NEG = -__builtin_inff();
#pragma unroll
    for (int r = 0; r < 16; ++r) { const int c = (r & 3) + 8 * (r >> 2); if (dq - c < 0) p0[r] = NEG; if (dq - c - 32 < 0) p1[r] = NEG; }
}
__device__ __forceinline__ void partialSM(f32x16& p0, f32x16& p1, float& m_reg, float& mn, float& alpha) {
    float pmax = p0[0];
#pragma unroll
    for (int r = 1; r < 16; ++r) pmax = fmaxf(pmax, p0[r]);
#pragma unroll
    for (int r = 0; r < 16; ++r) pmax = fmaxf(pmax, p1[r]);
    { auto rr = __builtin_amdgcn_permlane32_swap(__float_as_uint(pmax), __float_as_uint(pmax), false, false); pmax = fmaxf(__uint_as_float(rr[0]), __uint_as_float(rr[1])); }
    constexpr float C2 = 1.4426950408889634f * MLA_SCALE;
    if (__builtin_expect(__all((pmax - m_reg) * MLA_SCALE <= THR), 1)) { mn = m_reg; alpha = 1.f; }
    else { mn = fmaxf(m_reg, pmax); alpha = __builtin_amdgcn_exp2f((m_reg - mn) * C2); m_reg = mn; }
    const float mnL = -mn * C2;
#pragma unroll
    for (int r = 0; r < 16; ++r) p0[r] = __builtin_amdgcn_exp2f(fmaf(p0[r], C2, mnL));
#pragma unroll
    for (int r = 0; r < 16; ++r) p1[r] = __builtin_amdgcn_exp2f(fmaf(p1[r], C2, mnL));
}
__device__ __forceinline__ void finishSM(f32x16& p0, f32x16& p1, float alpha, float& l_reg, bf16x8& pa0, bf16x8& pa1, bf16x8& pa2, bf16x8& pa3) {
    float ps = 0;
#pragma unroll
    for (int r = 0; r < 16; ++r) ps += p0[r];
#pragma unroll
    for (int r = 0; r < 16; ++r) ps += p1[r];
    { auto rr = __builtin_amdgcn_permlane32_swap(__float_as_uint(ps), __float_as_uint(ps), false, false); ps = __uint_as_float(rr[0]) + __uint_as_float(rr[1]); }
    l_reg = l_reg * alpha + ps;
#define PK4(P, B_, OUT) do { unsigned a0 = cvt_pk_bf16(P[B_+0], P[B_+1]), a1 = cvt_pk_bf16(P[B_+2], P[B_+3]); unsigned b0 = cvt_pk_bf16(P[B_+4], P[B_+5]), b1 = cvt_pk_bf16(P[B_+6], P[B_+7]); \
        auto r0 = __builtin_amdgcn_permlane32_swap(a0, b0, false, false); auto r1 = __builtin_amdgcn_permlane32_swap(a1, b1, false, false); \
        u32x4 w_ = {r0[0], r1[0], r0[1], r1[1]}; OUT = *reinterpret_cast<bf16x8*>(&w_); } while (0)
    PK4(p0, 0, pa0); PK4(p0, 8, pa1); PK4(p1, 0, pa2); PK4(p1, 8, pa3);
#undef PK4
}
#define KRD2(dst0, dst1, j, imm) do { asm volatile("ds_read_b128 %0, %1 offset:%2" : "=&v"(dst0) : "v"(kb[j]), "i"(imm) : "memory"); \
                                      asm volatile("ds_read_b128 %0, %1 offset:%2" : "=&v"(dst1) : "v"(kb[j]), "i"((imm) + 32 * KROW) : "memory"); } while (0)
#define LGK(n) asm volatile("s_waitcnt lgkmcnt(%0)" :: "i"(n) : "memory")
template <int KB> __device__ __forceinline__ void qkt(f32x16& p0, f32x16& p1, const int (&kb)[4], const bf16x8* qr) {
    p0 = f32x16{}; p1 = f32x16{};
    bf16x8 ka[4], kc[4];
#define KIMM(d0) (KB * SHM_K + ((d0) >> 2) * 128)
    KRD2(ka[0], kc[0], 0, KIMM(0)); KRD2(ka[1], kc[1], 1, KIMM(1)); KRD2(ka[2], kc[2], 2, KIMM(2));
#define QK_STEP(d0) do { if ((d0) + 3 < 12) KRD2(ka[((d0) + 3) & 3], kc[((d0) + 3) & 3], ((d0) + 3) & 3, KIMM((d0) + 3)); \
        LGK(((d0) + 3 < 12) ? 6 : 2 * (11 - (d0))); SBAR(); \
        p0 = __builtin_amdgcn_mfma_f32_32x32x16_bf16(ka[(d0) & 3], qr[d0], p0, 0, 0, 0); p1 = __builtin_amdgcn_mfma_f32_32x32x16_bf16(kc[(d0) & 3], qr[d0], p1, 0, 0, 0); } while (0)
    QK_STEP(0); QK_STEP(1); QK_STEP(2); QK_STEP(3); QK_STEP(4); QK_STEP(5); QK_STEP(6); QK_STEP(7); QK_STEP(8); QK_STEP(9); QK_STEP(10); QK_STEP(11);
#undef QK_STEP
#undef KIMM
}
#define TRRD(dst, off) asm volatile("ds_read_b64_tr_b16 %0, %1 offset:%2" : "=&v"(dst) : "v"(vb0), "i"(off) : "memory")
#define VRD8(L, H, d0, VB_) do { constexpr int b_ = (VB_) * SHM_V + (d0) * 512; TRRD(L[0], b_); TRRD(H[0], b_ + 2048); TRRD(L[1], b_ + 4096); TRRD(H[1], b_ + 6144); TRRD(L[2], b_ + 8192); TRRD(H[2], b_ + 10240); TRRD(L[3], b_ + 12288); TRRD(H[3], b_ + 14336); } while (0)
#define PVMM(L, H, d0) do { \
        o[d0] = __builtin_amdgcn_mfma_f32_32x32x16_bf16(pa0, (bf16x8){L[0][0], L[0][1], L[0][2], L[0][3], H[0][0], H[0][1], H[0][2], H[0][3]}, o[d0], 0, 0, 0); \
        o[d0] = __builtin_amdgcn_mfma_f32_32x32x16_bf16(pa1, (bf16x8){L[1][0], L[1][1], L[1][2], L[1][3], H[1][0], H[1][1], H[1][2], H[1][3]}, o[d0], 0, 0, 0); \
        o[d0] = __builtin_amdgcn_mfma_f32_32x32x16_bf16(pa2, (bf16x8){L[2][0], L[2][1], L[2][2], L[2][3], H[2][0], H[2][1], H[2][2], H[2][3]}, o[d0], 0, 0, 0); \
        o[d0] = __builtin_amdgcn_mfma_f32_32x32x16_bf16(pa3, (bf16x8){L[3][0], L[3][1], L[3][2], L[3][3], H[3][0], H[3][1], H[3][2], H[3][3]}, o[d0], 0, 0, 0); } while (0)
__device__ __forceinline__ void block(const Frame& F, int bh, int qb) {
    LAS unsigned char* lds = F.lds;
    int lane = F.lane; asm volatile("" : "+v"(lane));
    const int tid = F.tid, wid = F.wave, r32 = lane & 31, hi = lane >> 5, b = bh >> 4, h = bh & 15;
    const bf16_t* KN = (const bf16_t*)(F.ws + B_KN) + (size_t)bh * SEQ * 128; const bf16_t* VV = (const bf16_t*)(F.ws + B_V) + (size_t)bh * SEQ * 128;
    const bf16_t* KR = (const bf16_t*)(F.ws + B_KR) + (size_t)b * SEQ * 64;
    const bf16_t* QN = (const bf16_t*)(F.ws + B_QN) + (size_t)bh * SEQ * 128; const bf16_t* QR = (const bf16_t*)(F.ws + B_QR) + (size_t)bh * SEQ * 64;
    const int q0 = qb * 256, NT = (q0 + 256) / 64, qlo = q0 + wid * 32, qm = qlo + r32 - 4 * hi;
    bf16x8 qr[12];
    { const size_t row = (size_t)(qlo + r32);
#pragma unroll
      for (int d0 = 0; d0 < 8; ++d0) qr[d0] = *(const bf16x8*)(QN + row * 128 + d0 * 16 + hi * 8);
#pragma unroll
      for (int d0 = 0; d0 < 4; ++d0) qr[8 + d0] = *(const bf16x8*)(QR + row * 64 + d0 * 16 + hi * 8); }
    unsigned koff[3], kstr[3], voff[2];
    const unsigned oKN = (unsigned)(B_KN + (size_t)bh * SEQ * 128 * 2), oKR = (unsigned)(B_KR + (size_t)b * SEQ * 64 * 2), oV = (unsigned)(B_V + (size_t)bh * SEQ * 128 * 2);
#pragma unroll
    for (int i = 0; i < 3; ++i) { const int p = (wid * 3 + i) * 64 + lane, r = p / 24, cs = p - r * 24, c = cs ^ ((r >> 1) & 7);
        if (c < 16) { koff[i] = oKN + (unsigned)(r * 128 + 8 * c) * 2u; kstr[i] = 64 * 128 * 2; } else { koff[i] = oKR + (unsigned)(r * 64 + 8 * (c - 16)) * 2u; kstr[i] = 64 * 64 * 2; } }
#pragma unroll
    for (int i = 0; i < 2; ++i) { const int s_ = (wid * 2 + i) * 64 + lane, sub = s_ >> 5, w_ = s_ & 31, kk = (sub >> 2) * 8 + (w_ >> 2), c = (sub & 3) * 32 + (w_ & 3) * 8, k = (kk & ~0xC) | ((kk & 4) << 1) | ((kk & 8) >> 1);
        voff[i] = oV + (unsigned)(k * 128 + c) * 2u; }
    const char* wsb = (const char*)F.ws;
#define A_DMA(t, bf) do { \
        _Pragma("unroll") for (int i = 0; i < 3; ++i) __builtin_amdgcn_global_load_lds((const unsigned*)(wsb + (koff[i] + (unsigned)(t) * kstr[i])), (LAS unsigned*)(lds + OFF_K + (bf) * SHM_K + (wid * 3 + i) * 1024), 16, 0, 0); \
        _Pragma("unroll") for (int i = 0; i < 2; ++i) __builtin_amdgcn_global_load_lds((const unsigned*)(wsb + (voff[i] + (unsigned)(t) * (64u * 128u * 2u))), (LAS unsigned*)(lds + (bf) * SHM_V + (wid * 2 + i) * 1024), 16, 0, 0); } while (0)
    int kb[4];
#pragma unroll
    for (int j = 0; j < 4; ++j) kb[j] = (int)(uintptr_t)lds + OFF_K + r32 * KROW + (((2 * j + hi) ^ ((r32 >> 1) & 7)) << 4);
    const int vb0 = (int)(uintptr_t)lds + v_rd_base(lane);
    LAS float* wsl = (LAS float*)(lds + OFF_WS) + wid * 64; LAS float* li_l = wsl; LAS float* al_l = wsl + 32;
    float m_reg = -1e30f, l_reg = 0.f; f32x16 o[4] = {};
    A_DMA(0, 0);
#define A_STEP(t, VB) do { \
        asm volatile("s_waitcnt vmcnt(0)" ::: "memory"); __syncthreads(); \
        if ((t) + 1 < NT) A_DMA((t) + 1, (VB) ^ 1); \
        const int kb_ = (t) * 64; \
        if (kb_ <= qlo + 31) { f32x16 p0, p1; float mn, alpha; bf16x8 pa0, pa1, pa2, pa3; s16x4 la[4], ha[4], lb[4], hb[4]; \
            qkt<VB>(p0, p1, kb, qr); \
            VRD8(la, ha, 0, VB); SBAR(); \
            if (kb_ + 63 > qlo) { asm volatile("; diagonal tile" ::: "memory"); mask_tile(p0, p1, qm - kb_); } \
            partialSM(p0, p1, m_reg, mn, alpha); \
            if (__any(alpha < 1.f)) { if (hi == 0) al_l[r32] = alpha; asm volatile("s_waitcnt lgkmcnt(0)" ::: "memory"); \
                _Pragma("unroll") for (int d_ = 0; d_ < 4; ++d_) _Pragma("unroll") for (int r = 0; r < 16; ++r) o[d_][r] *= al_l[crow(r, hi)]; } \
            finishSM(p0, p1, alpha, l_reg, pa0, pa1, pa2, pa3); SBAR(); \
            VRD8(lb, hb, 1, VB); LGK(8); SBAR(); PVMM(la, ha, 0); SBAR(); \
            VRD8(la, ha, 2, VB); LGK(8); SBAR(); PVMM(lb, hb, 1); SBAR(); \
            VRD8(lb, hb, 3, VB); LGK(8); SBAR(); PVMM(la, ha, 2); SBAR(); \
            LGK(0); SBAR(); PVMM(lb, hb, 3); } } while (0)
    for (int t = 0; t < NT; t += 2) { A_STEP(t, 0); A_STEP(t + 1, 1); }
    if (hi == 0) li_l[r32] = l_reg; asm volatile("s_waitcnt lgkmcnt(0)" ::: "memory");
    bf16_t* Ow = (bf16_t*)(F.ws + B_O) + (size_t)(b * SEQ + qlo) * D + h * 128;
#pragma unroll
    for (int r = 0; r < 16; ++r) { const int orow = crow(r, hi); const float rl = __builtin_amdgcn_rcpf(li_l[orow]);
#pragma unroll
        for (int d0 = 0; d0 < 4; ++d0) { const float v = o[d0][r] * rl; const float vn = __shfl_xor(v, 1);
            if ((r32 & 1) == 0) *(unsigned*)(Ow + (size_t)orow * D + d0 * 32 + r32) = cvt_pk_bf16(v, vn); } }
    __syncthreads();
#undef A_DMA
#undef A_STEP
}
#undef SBAR
#undef KRD2
#undef LGK
#undef TRRD
#undef VRD8
#undef PVMM
}
__device__ __forceinline__ void p_attn(const Frame& F) {
    const int nIt = (F.G == 256) ? 4 : (1024 - F.bid + F.G - 1) / F.G;
    for (int n = 0; n < nIt; ++n) {
        int bh, qb;
        if (F.G == 256) { const int xcd = F.bid & 7, k = F.bid >> 3, x = k & 15; bh = xcd * 4 + (n >> 1) * 2 + (k >> 4); qb = (n & 1) ? 31 - x : x; }
        else { const int L = F.bid + n * F.G; bh = L >> 5; qb = L & 31; }
        att::block(F, bh, qb);
        if (((((F.bid >> 3) + n) & 3) == 0 || nIt != 4) && !F.probe_rep) conv_moe_part(F, nIt == 4 ? 0 : n, nIt == 4 ? 1 : nIt);
        __syncthreads();
    }
}

constexpr int N_PHASES = 18;
__global__ void __launch_bounds__(512, 2) fwd_kernel(Args args) {
    extern __shared__ __attribute__((aligned(16))) unsigned char lds_raw[];
    Frame F; F.lds = (LAS unsigned char*)lds_raw; F.tid = threadIdx.x; F.lane = F.tid & 63; F.wave = __builtin_amdgcn_readfirstlane(F.tid >> 6); F.G = gridDim.x; F.bid = blockIdx.x;
    F.a = &args; F.ws = args.ws; F.ctl = (unsigned*)(args.ws + WS_CTL);
    volatile LAS unsigned* MISC = (volatile LAS unsigned*)(F.lds + MISC_OFF);
    if (F.tid < 64) MISC[F.tid] = 0u;
    __syncthreads();
    XcdBarrier bar; bar.bar = F.ctl + CW_BAR; bar.x = 0; bar.st = MISC + 8;
    if (MK_N_LAUNCHES == 1) bar = xcd_barrier_post(F.ctl + CW_BAR, MISC + 8);
    const int lo = args.ph_lo, hi = args.ph_hi & 0xffff; F.probe_rep = (args.ph_hi >> 16) != 0;
#define IN(k) (lo <= (k) && (k) < hi)
#ifndef PROBE_REPEAT
#define PROBE_REPEAT (-1)
#endif
#define NREP(k) ((k) == PROBE_REPEAT ? 2 : 1)
#define SEAM(k) do { if (IN(k) && IN((k) + 1)) xcd_barrier(bar); } while (0)
    const char* ws = (const char*)F.ws;
    if (IN(0)) for (int rep_ = 0; rep_ < NREP(0); ++rep_) { if (rep_) xcd_barrier(bar); p_mod(F); } SEAM(0);
    if (IN(1)) for (int rep_ = 0; rep_ < NREP(1); ++rep_) { if (rep_) xcd_barrier(bar); p_conv(F); __syncthreads(); p_thin<0>(F); } SEAM(1);
    if (IN(2)) for (int rep_ = 0; rep_ < NREP(2); ++rep_) { if (rep_) xcd_barrier(bar); pg8::DualOrder S{ws + WS_U, ws + W_IN, ws + WS_U, ws + W_IN, 64, 32, 0, D, F.G, F.bid};
        EpiHgIn E{(bf16_t*)(F.ws + B_Q), (float*)(F.ws + B_LF), (bf16_t*)(F.ws + B_VI), (bf16_t*)(F.ws + B_GS), (const float*)(F.ws + WS_LB), INF(I_HGONG)};
        pg8::gemm_phase(F.lds, D, S, E); } SEAM(2);
    if (IN(3)) for (int rep_ = 0; rep_ < NREP(3); ++rep_) { if (rep_) xcd_barrier(bar); p_hg_chunk(F); } SEAM(3);
    if (IN(4)) for (int rep_ = 0; rep_ < NREP(4); ++rep_) { if (rep_) xcd_barrier(bar); p_hg_scan(F); } SEAM(4);
    if (IN(5)) for (int rep_ = 0; rep_ < NREP(5); ++rep_) { if (rep_) xcd_barrier(bar); pg8::DualOrder S{ws + B_OG, ws + W_OUT, ws + B_OG, ws + W_OUT, 64, 8, 0, D, F.G, F.bid, true}; EpiBf16 E{(bf16_t*)(F.ws + WS_Y), D}; pg8::gemm_phase(F.lds, D, S, E); } SEAM(5);
    if (IN(6)) for (int rep_ = 0; rep_ < NREP(6); ++rep_) { if (rep_) xcd_barrier(bar); p_thin<1>(F); } SEAM(6);
    if (IN(7)) for (int rep_ = 0; rep_ < NREP(7); ++rep_) { if (rep_) xcd_barrier(bar); pg8::DualOrder S{ws + WS_U, ws + W_GU, ws + WS_U, ws + W_GU, 64, 44, 0, D, F.G, F.bid}; EpiGU E{(bf16_t*)(F.ws + B_ACT)}; pg8::gemm_phase(F.lds, D, S, E); } SEAM(7);
    if (IN(8)) for (int rep_ = 0; rep_ < NREP(8); ++rep_) { if (rep_) xcd_barrier(bar); pg8::DualOrder S{ws + B_ACT, ws + W_DN, ws + B_ACT, ws + W_DN, 64, 8, 0, DFF, F.G, F.bid}; EpiBf16 E{(bf16_t*)(F.ws + WS_Y), D}; pg8::gemm_phase(F.lds, DFF, S, E); } SEAM(8);
    if (IN(9)) for (int rep_ = 0; rep_ < NREP(9); ++rep_) { if (rep_) xcd_barrier(bar); p_thin<2>(F); } SEAM(9);
    if (IN(10)) for (int rep_ = 0; rep_ < NREP(10); ++rep_) { if (rep_) xcd_barrier(bar); pg8::DualOrder S{ws + WS_XS, ws + W_LAT, ws + WS_U, ws + W_LAT + (size_t)768 * D * 2, 64, 3, 2, D, F.G, F.bid};
        EpiLat E{(bf16_t*)(F.ws + B_CKV), (bf16_t*)(F.ws + B_QLAT), (bf16_t*)(F.ws + B_KR), (float*)(F.ws + WS_SSC), (float*)(F.ws + WS_SSQ), (const float*)(F.ws + WS_COS), (const float*)(F.ws + WS_SIN)};
        pg8::gemm_phase(F.lds, D, S, E); } SEAM(10);
    if (IN(11)) for (int rep_ = 0; rep_ < NREP(11); ++rep_) { if (rep_) xcd_barrier(bar); pg8::DualOrder S{ws + B_CKV, ws + W_KVQ, ws + B_QLAT, ws + W_KVQ + (size_t)4096 * 512 * 2, 64, 16, 12, 512, F.G, F.bid};
        EpiKvQ E{(bf16_t*)(F.ws + B_KN), (bf16_t*)(F.ws + B_V), (bf16_t*)(F.ws + B_QN), (bf16_t*)(F.ws + B_QR), (const float*)(F.ws + WS_SSC), (const float*)(F.ws + WS_SSQ), (const float*)(F.ws + WS_COS), (const float*)(F.ws + WS_SIN)};
        pg8::gemm_phase(F.lds, 512, S, E); } SEAM(11);
    if (IN(12)) for (int rep_ = 0; rep_ < NREP(12); ++rep_) { if (rep_) xcd_barrier(bar); p_attn(F); } SEAM(12);
    if (IN(13)) for (int rep_ = 0; rep_ < NREP(13); ++rep_) { if (rep_) xcd_barrier(bar); pg8::DualOrder S{ws + B_O, ws + W_O, ws + B_O, ws + W_O, 64, 8, 0, D, F.G, F.bid}; EpiBf16 E{(bf16_t*)(F.ws + WS_Y), D}; pg8::gemm_phase(F.lds, D, S, E); } SEAM(13);
    if (IN(14)) for (int rep_ = 0; rep_ < NREP(14); ++rep_) { if (rep_) xcd_barrier(bar); p_thin<3>(F); } SEAM(14);
    if (IN(15)) for (int rep_ = 0; rep_ < NREP(15); ++rep_) { if (rep_) xcd_barrier(bar); pg8::MoeOrder<true> S; S.A = ws + WS_U; S.W = ws + W_MGU; S.wstride = (size_t)2 * DFF * D; S.list = (const int*)(ws + WS_LIST); S.nN = 44; S.rb = D; S.G = F.G; S.c = F.bid; S.init(F.ctl);
        EpiGU8 E{F.ws + B_ACT2}; pg8::gemm_phase<EpiGU8, pg8::MoeOrder<true>, true>(F.lds, D, S, E); } SEAM(15);
    if (IN(16)) for (int rep_ = 0; rep_ < NREP(16); ++rep_) { if (rep_) xcd_barrier(bar); pg8::MoeOrder<false> S; S.A = ws + B_ACT2; S.W = ws + W_MDN; S.wstride = (size_t)D * DFF; S.list = nullptr; S.nN = 8; S.rb = DFF; S.G = F.G; S.c = F.bid; S.init(F.ctl);
        EpiBf16 E{(bf16_t*)(F.ws + B_Y2), D}; pg8::gemm_phase<EpiBf16, pg8::MoeOrder<false>, true>(F.lds, DFF, S, E); } SEAM(16);
    if (IN(17)) for (int rep_ = 0; rep_ < NREP(17); ++rep_) { if (rep_) xcd_barrier(bar); p_thin<4>(F); }
#undef IN
#undef SEAM
}

extern "C" void kernel_launch(void* const* d_in, const int* in_sizes, int n_in, void* d_out, int out_size, void* d_ws, size_t ws_size, hipStream_t stream) {
    static int grid = 0;
    if (grid == 0) {
        if (n_in != 25 || out_size != M * D || ws_size < WS_NEED) { fprintf(stderr, "kernel_launch: expected 25 inputs, out %d, ws >= %zu; got n_in %d out %d ws %zu\n", M * D, (size_t)WS_NEED, n_in, out_size, ws_size); grid = -1; return; }
        int dev = 0, cus = 0;
        if (hipGetDevice(&dev) != hipSuccess || hipDeviceGetAttribute(&cus, hipDeviceAttributeMultiprocessorCount, dev) != hipSuccess) { grid = -1; return; }
        if (hipFuncSetAttribute((const void*)fwd_kernel, hipFuncAttributeMaxDynamicSharedMemorySize, LDS_BYTES) != hipSuccess) { fprintf(stderr, "kernel_launch: hipFuncSetAttribute failed\n"); grid = -1; return; }
        int per_cu = 0;
        if (hipOccupancyMaxActiveBlocksPerMultiprocessor(&per_cu, (const void*)fwd_kernel, 512, LDS_BYTES) != hipSuccess || per_cu < 1) { fprintf(stderr, "kernel_launch: occupancy query reports %d\n", per_cu); (void)hipGetLastError(); }
        grid = cus;
    }
    if (grid < 0) return;
    (void)hipMemsetAsync((char*)d_ws + WS_CTL, 0, CTL_BYTES, stream);
    Args a{};
    for (int i = 0; i < 25; ++i) a.in[i] = d_in[i];
    a.out = (float*)d_out; a.ws = (unsigned char*)d_ws;
    if (MK_N_LAUNCHES == 1) { a.ph_lo = 0; a.ph_hi = N_PHASES; hipLaunchKernelGGL(fwd_kernel, dim3(grid), dim3(512), LDS_BYTES, stream, a); }
    else for (int p = 0; p < N_PHASES; ++p) { a.ph_lo = p; a.ph_hi = p + 1; hipLaunchKernelGGL(fwd_kernel, dim3(grid), dim3(512), LDS_BYTES, stream, a);
#if defined(PROBE_HOST_REPEAT)
        if (p == PROBE_HOST_REPEAT) { a.ph_hi |= 1 << 16; hipLaunchKernelGGL(fwd_kernel, dim3(grid), dim3(512), LDS_BYTES, stream, a); }
#endif
    }
    const hipError_t le = hipPeekAtLastError();
    if (le != hipSuccess) fprintf(stderr, "kernel_launch: launch failed: %s\n", hipGetErrorName(le));
}
```
